# Optimizing an MI355X kernel written in HIP

```python
import jax, jax.numpy as jnp
from jax import lax
import numpy as np

D_MODEL = 4096
BATCH = 4
SEQ = 2048
DEPTH = 1

EPS = 1e-6
MOBA_HEAD_DIM = 128
MOBA_HEADS = D_MODEL // 256
MOBA_WIDTH = MOBA_HEADS * MOBA_HEAD_DIM
MOBA_BLOCK = 256
MOBA_TOPK = 3
MOBA_QCHUNK = 16
ROPE_THETA = 10000.0
GLA_HEADS = D_MODEL // 512
GLA_K_WIDTH = D_MODEL // 2
GLA_V_WIDTH = D_MODEL
GLA_DK = GLA_K_WIDTH // GLA_HEADS
GLA_DV = GLA_V_WIDTH // GLA_HEADS
GLA_GATE_RANK = 16
GLA_GATE_TAU = 16.0
GLA_CHUNK = 64
D_FF = -(-8 * D_MODEL // (3 * 256)) * 256
IN_SPLITS = (MOBA_WIDTH, MOBA_WIDTH, MOBA_WIDTH,
             GLA_K_WIDTH, GLA_K_WIDTH, GLA_V_WIDTH,
             GLA_V_WIDTH, GLA_GATE_RANK,
             D_MODEL, D_MODEL)
IN_COLS = sum(IN_SPLITS)

kernel_name = "moba_gla_parallel_gated_hybrid"


def _rmsnorm(x, g):
    xf = x.astype(jnp.float32)
    y = xf * lax.rsqrt(jnp.mean(xf * xf, axis=-1, keepdims=True) + EPS)
    return (y * g.astype(jnp.float32)).astype(x.dtype)


def _split_cols(u, sizes):
    idx = [int(v) for v in np.cumsum(sizes)[:-1]]
    return jnp.split(u, idx, axis=-1)


def _rope(x, pos):
    d = x.shape[-1]
    half = d // 2
    inv_freq = ROPE_THETA ** (-jnp.arange(half, dtype=jnp.float32) / half)
    ang = pos.astype(jnp.float32)[:, None] * inv_freq[None, :]
    cos = jnp.cos(ang)[None, :, None, :]
    sin = jnp.sin(ang)[None, :, None, :]
    xf = x.astype(jnp.float32)
    x1, x2 = xf[..., :half], xf[..., half:]
    out = jnp.concatenate([x1 * cos - x2 * sin, x2 * cos + x1 * sin], axis=-1)
    return out.astype(x.dtype)


def _moba_attention(q, k, v):
    B, S, H, D = q.shape
    s_pad = -(-S // MOBA_BLOCK) * MOBA_BLOCK
    pad = ((0, 0), (0, s_pad - S), (0, 0), (0, 0))
    q, k, v = [jnp.pad(t, pad).transpose(0, 2, 1, 3) for t in (q, k, v)]
    nb = s_pad // MOBA_BLOCK
    scale = D ** -0.5
    kb = k.reshape(B, H, nb, MOBA_BLOCK, D)
    vb = v.reshape(B, H, nb, MOBA_BLOCK, D)

    kmean = jnp.mean(kb.astype(jnp.float32), axis=3)
    gate = jnp.einsum('bhsd,bhnd->bhsn', q.astype(jnp.float32), kmean)
    q_blk = jnp.arange(s_pad) // MOBA_BLOCK
    past = jnp.arange(nb)[None, :] < q_blk[:, None]
    gate = jnp.where(past[None, None], gate, -jnp.inf)
    k_sel = min(MOBA_TOPK, nb)
    top_val, top_idx = lax.top_k(gate, k_sel)
    top_ok = jnp.isfinite(top_val)

    n_chunks = s_pad // MOBA_QCHUNK
    qc = q.reshape(B, H, n_chunks, MOBA_QCHUNK, D).transpose(2, 0, 1, 3, 4)
    idx_c = top_idx.reshape(B, H, n_chunks, MOBA_QCHUNK, k_sel).transpose(2, 0, 1, 3, 4)
    ok_c = top_ok.reshape(B, H, n_chunks, MOBA_QCHUNK, k_sel).transpose(2, 0, 1, 3, 4)
    b_ix = jnp.arange(B)[:, None, None, None]
    h_ix = jnp.arange(H)[None, :, None, None]

    def chunk(args):
        c, qi, ii, oki = args
        q0 = c * MOBA_QCHUNK
        own = q0 // MOBA_BLOCK
        k_g = kb[b_ix, h_ix, ii]
        v_g = vb[b_ix, h_ix, ii]
        s_sel = jnp.einsum('bhqd,bhqtkd->bhqtk', qi, k_g).astype(jnp.float32) * scale
        s_sel = jnp.where(oki[..., None], s_sel, -jnp.inf)
        s_sel = s_sel.reshape(B, H, MOBA_QCHUNK, k_sel * MOBA_BLOCK)
        k_own = lax.dynamic_index_in_dim(kb, own, axis=2, keepdims=False)
        v_own = lax.dynamic_index_in_dim(vb, own, axis=2, keepdims=False)
        s_own = jnp.einsum('bhqd,bhkd->bhqk', qi, k_own).astype(jnp.float32) * scale
        qpos = q0 + jnp.arange(MOBA_QCHUNK)
        kpos = own * MOBA_BLOCK + jnp.arange(MOBA_BLOCK)
        s_own = jnp.where((kpos[None, :] <= qpos[:, None])[None, None], s_own, -jnp.inf)
        p = jax.nn.softmax(jnp.concatenate([s_sel, s_own], axis=-1), axis=-1).astype(v.dtype)
        p_sel = p[..., :k_sel * MOBA_BLOCK].reshape(B, H, MOBA_QCHUNK, k_sel, MOBA_BLOCK)
        p_own = p[..., k_sel * MOBA_BLOCK:]
        return (jnp.einsum('bhqtk,bhqtkd->bhqd', p_sel, v_g)
                + jnp.einsum('bhqk,bhkd->bhqd', p_own, v_own))

    o = lax.map(chunk, (jnp.arange(n_chunks), qc, idx_c, ok_c))
    o = o.transpose(1, 0, 3, 2, 4).reshape(B, s_pad, H * D)
    return o[:, :S]


def _gla(q, k, v, log_a):
    B, S, H, DK = q.shape
    DV = v.shape[-1]
    nc = S // GLA_CHUNK

    def chunked(t):
        return t.astype(jnp.float32).reshape(B, nc, GLA_CHUNK, H, t.shape[-1]).transpose(1, 0, 3, 2, 4)

    qc = chunked(q) * (DK ** -0.5)
    kc = chunked(k)
    vc = chunked(v)
    bcum = jnp.cumsum(chunked(log_a), axis=3)
    b_last = bcum[:, :, :, -1:, :]
    q_dec = qc * jnp.exp(bcum)
    k_inv = kc * jnp.exp(-bcum)
    k_to_end = kc * jnp.exp(b_last - bcum)
    causal = jnp.tril(jnp.ones((GLA_CHUNK, GLA_CHUNK), dtype=bool))
    attn = jnp.einsum('nbhid,nbhjd->nbhij', q_dec, k_inv)
    attn = jnp.where(causal, attn, 0.0)
    o_intra = jnp.einsum('nbhij,nbhjv->nbhiv', attn, vc)

    def step(state, inp):
        q_d, k_e, v_c, dl = inp
        o = jnp.einsum('bhid,bhdv->bhiv', q_d, state)
        state = jnp.exp(dl)[:, :, 0, :, None] * state + jnp.einsum('bhjd,bhjv->bhdv', k_e, v_c)
        return state, o

    s0 = jnp.zeros((B, H, DK, DV), jnp.float32)
    _, o_inter = lax.scan(step, s0, (q_dec, k_to_end, vc, b_last))
    o = o_intra + o_inter
    return o.transpose(1, 0, 3, 2, 4).reshape(B, S, H, DV)


def _mixer(h, w_in, gla_gate_up, gla_gate_bias, gla_out_norm_g,
           w_branch_moba, w_branch_gla, w_out):
    B, S, _ = h.shape
    u = h @ w_in
    mq, mk, mv, gq, gk, gv, gr, ga_down, g_moba, g_gla = _split_cols(u, IN_SPLITS)
    pos = jnp.arange(S)
    mq = _rope(mq.reshape(B, S, MOBA_HEADS, MOBA_HEAD_DIM), pos)
    mk = _rope(mk.reshape(B, S, MOBA_HEADS, MOBA_HEAD_DIM), pos)
    mv = mv.reshape(B, S, MOBA_HEADS, MOBA_HEAD_DIM)
    y_moba = _moba_attention(mq, mk, mv) @ w_branch_moba
    log_a = jax.nn.log_sigmoid((ga_down @ gla_gate_up + gla_gate_bias).astype(jnp.float32)) / GLA_GATE_TAU
    o = _gla(gq.reshape(B, S, GLA_HEADS, GLA_DK),
             gk.reshape(B, S, GLA_HEADS, GLA_DK),
             gv.reshape(B, S, GLA_HEADS, GLA_DV),
             log_a.reshape(B, S, GLA_HEADS, GLA_DK)).astype(h.dtype)
    o = _rmsnorm(o, gla_out_norm_g).reshape(B, S, GLA_V_WIDTH) * jax.nn.silu(gr)
    y_gla = o @ w_branch_gla
    merged = jax.nn.sigmoid(g_moba) * y_moba + jax.nn.sigmoid(g_gla) * y_gla
    return merged @ w_out


def _swiglu(h, w_gate, w_up, w_down):
    return (jax.nn.silu(h @ w_gate) * (h @ w_up)) @ w_down


def setup_inputs(seed: int = 0) -> dict:
    key = jax.random.key(seed)
    ks = jax.random.split(key, 16)
    f32 = jnp.float32

    def dense(k, fan_in, fan_out):
        return jax.random.normal(k, (DEPTH, fan_in, fan_out), f32) * fan_in ** -0.5

    def gain(k, n):
        return 1.0 + 0.02 * jax.random.normal(k, (DEPTH, n), f32)

    return {
        "x": jax.random.normal(ks[0], (BATCH, SEQ, D_MODEL), f32),
        "pre_mix_norm_g": gain(ks[1], D_MODEL),
        "w_in": dense(ks[2], D_MODEL, IN_COLS),
        "gla_gate_up": dense(ks[3], GLA_GATE_RANK, GLA_K_WIDTH),
        "gla_gate_bias": 0.1 * jax.random.normal(ks[4], (DEPTH, GLA_K_WIDTH), f32),
        "gla_out_norm_g": gain(ks[5], GLA_DV),
        "w_branch_moba": dense(ks[6], MOBA_WIDTH, D_MODEL),
        "w_branch_gla": dense(ks[7], GLA_V_WIDTH, D_MODEL),
        "w_out": dense(ks[8], D_MODEL, D_MODEL),
        "post_mix_norm_g": gain(ks[9], D_MODEL),
        "pre_ffn_norm_g": gain(ks[10], D_MODEL),
        "w_ffn_gate": dense(ks[11], D_MODEL, D_FF),
        "w_ffn_up": dense(ks[12], D_MODEL, D_FF),
        "w_ffn_down": dense(ks[13], D_FF, D_MODEL),
        "post_ffn_norm_g": gain(ks[14], D_MODEL),
    }


def reference(x, pre_mix_norm_g, w_in, gla_gate_up, gla_gate_bias, gla_out_norm_g,
              w_branch_moba, w_branch_gla, w_out, post_mix_norm_g, pre_ffn_norm_g,
              w_ffn_gate, w_ffn_up, w_ffn_down, post_ffn_norm_g):
    for layer in range(DEPTH):
        h = _rmsnorm(x, pre_mix_norm_g[layer])
        y = _mixer(h, w_in[layer], gla_gate_up[layer], gla_gate_bias[layer],
                   gla_out_norm_g[layer], w_branch_moba[layer], w_branch_gla[layer],
                   w_out[layer])
        x = x + _rmsnorm(y, post_mix_norm_g[layer])
        h = _rmsnorm(x, pre_ffn_norm_g[layer])
        y = _swiglu(h, w_ffn_gate[layer], w_ffn_up[layer], w_ffn_down[layer])
        x = x + _rmsnorm(y, post_ffn_norm_g[layer])
    return x
```

```cpp
#include <hip/hip_runtime.h>
#include <cstdio>
#include <cstdint>
#include <cstring>
namespace pg8 {
#define PG8_LAS __attribute__((address_space(3)))
typedef unsigned short bf16_t;
typedef short bf16x8 __attribute__((ext_vector_type(8)));
typedef float f32x4 __attribute__((ext_vector_type(4)));
typedef unsigned u32x4 __attribute__((ext_vector_type(4)));
constexpr int BM = 256, BK = 64, HALF = 128, HTB = HALF * BK * 2  , STAGE_BYTES = 8 * HTB, NXCD = 8, WGM = 8;

__host__ __device__ __forceinline__ int lds_byte(int r, int c) { const int st = (r >> 4) * 2 + (c >> 5), rr = r & 15, cc = c & 31, ob = rr * 64 + cc * 2; return st * 1024 + (ob ^ (((ob >> 9) & 1) << 5)); }
__host__ __device__ __forceinline__ void stage_rc(int b, int& R, int& C) { const int st = b / 1024, sb = b % 1024, swz = sb ^ (((sb >> 9) & 1) << 5); R = (st >> 1) * 16 + swz / 64; C = (st & 1) * 32 + (swz % 64) / 2; }
__host__ __device__ __forceinline__ int perm32(int rho) { const int n = rho >> 4, i = rho & 15; return 8 * (i >> 2) + 4 * n + (i & 3); }

struct Unit { int pm, pn; };
struct Gemm { const bf16_t* A; const bf16_t* Bt; int M, N, K; };

struct StaticOrder {
    int nM, nN, nwg, G, c;
    __host__ __device__ void init(int M, int N, int G_, int c_) { nM = M / BM; nN = N / BM; nwg = nM * nN; G = G_; c = c_; }
    __host__ __device__ bool next(int i, Unit& u) const {
        const long L = (long)i * G + c; if (L >= nwg) return false;
        int wgid = (int)L; { const int q = nwg / NXCD, r = nwg % NXCD, xcd = wgid % NXCD, off = wgid / NXCD; wgid = (xcd < r ? xcd * (q + 1) : r * (q + 1) + (xcd - r) * q) + off; }
        const int nig = WGM * nN, gid = wgid / nig, fm = gid * WGM, gsz = (nM - fm) < WGM ? (nM - fm) : WGM;
        u.pm = fm + ((wgid % nig) % gsz); u.pn = (wgid % nig) / gsz; return true;
    }
    __device__ __forceinline__ void a_ready(const Unit&) const {}
    __device__ __forceinline__ void done(const Unit&) const {}
};
__device__ __forceinline__ unsigned cvt_pk_bf16(float lo, float hi) { unsigned r; asm volatile("v_cvt_pk_bf16_f32 %0, %1, %2" : "=v"(r) : "v"(lo), "v"(hi)); return r; }
typedef float f32x2 __attribute__((ext_vector_type(2)));
struct EpiF32 {
    static constexpr bool PERM = false, AFTER_DRAIN = false;
    float* C; int ldc; const float* bias;
    __device__ __forceinline__ void operator()(const f32x4 (&acc)[2][2][4][2], const Unit& u, int wr, int wc, int fr, int fq) const {
        const int row0 = u.pm * BM + wr * 64 + fr, col0 = u.pn * BM + wc * 32 + 4 * fq;
        f32x4 bv[2][2];
#pragma unroll
        for (int bj = 0; bj < 2; ++bj)
#pragma unroll
            for (int n = 0; n < 2; ++n) bv[bj][n] = bias ? *(const f32x4*)(bias + col0 + bj * HALF + n * 16) : (f32x4){0.f, 0.f, 0.f, 0.f};
#pragma unroll
        for (int ai = 0; ai < 2; ++ai)
#pragma unroll
            for (int m = 0; m < 4; ++m) { float* rowp = C + (size_t)(row0 + ai * HALF + m * 16) * ldc + col0;
#pragma unroll
                for (int bj = 0; bj < 2; ++bj)
#pragma unroll
                    for (int n = 0; n < 2; ++n) *(f32x4*)(rowp + bj * HALF + n * 16) = acc[ai][bj][m][n] + bv[bj][n]; }
    }
};
template <class Epi, class Sched, bool ALIGN_EPI = false, bool SP2 = false>
__device__ __forceinline__ void gemm_phase(PG8_LAS unsigned char* lds, const Gemm g, const Sched& S, const Epi& E) {
    const int tid = threadIdx.x, wid = __builtin_amdgcn_readfirstlane(tid >> 6), lane = tid & 63, wr = wid >> 2, wc = wid & 3, fr = lane & 15, fq = lane >> 4;
    const int K = g.K, nt = K / BK;
    unsigned voffA[2], voffB[2];
#pragma unroll
    for (int i = 0; i < 2; ++i) { int R, C; stage_rc(tid * 16 + i * 8192, R, C); const int Rb = Epi::PERM ? ((R & ~31) + perm32(R & 31)) : R;
        voffA[i] = (unsigned)(R * K + C) * 2u; voffB[i] = (unsigned)(Rb * K + C) * 2u; }
    const size_t kstep = (size_t)(BK * 2);
    const size_t hstep = (size_t)HALF * K * 2;
    const size_t tstep = 2 * hstep;
    const unsigned ldsw = (unsigned)wid * 1024u;
    const int aoff = lds_byte(wr * 64 + fr, fq * 8), boff = lds_byte(wc * 32 + fr, fq * 8);
#define PG8_SA(b, h) (((b) * 2 + (h)) * HTB)
#define PG8_SB(b, h) ((4 + (b) * 2 + (h)) * HTB)
#define PG8_STAGE(bufoff, gbase, voff) do { _Pragma("unroll") for (int _i = 0; _i < 2; ++_i) \
        __builtin_amdgcn_global_load_lds((const unsigned*)((const char*)(gbase) + (voff)[_i]), (PG8_LAS unsigned*)(lds + (bufoff) + ldsw + _i * 8192), 16, 0, 0); } while (0)
#define PG8_LDA(dst, b, h) do { _Pragma("unroll") for (int m = 0; m < 4; ++m) _Pragma("unroll") for (int k = 0; k < 2; ++k) dst[m][k] = *(const PG8_LAS bf16x8*)(lds + PG8_SA(b, h) + aoff + m * 2048 + k * 1024); } while (0)
#define PG8_LDB(dst, b, h) do { _Pragma("unroll") for (int n = 0; n < 2; ++n) _Pragma("unroll") for (int k = 0; k < 2; ++k) dst[n][k] = *(const PG8_LAS bf16x8*)(lds + PG8_SB(b, h) + boff + n * 2048 + k * 1024); } while (0)
#define PG8_MMA(ai, bj, At, Bt) do { __builtin_amdgcn_s_setprio(1); _Pragma("unroll") for (int m = 0; m < 4; ++m) _Pragma("unroll") for (int n = 0; n < 2; ++n) _Pragma("unroll") for (int k = 0; k < 2; ++k) \
        acc[ai][bj][m][n] = __builtin_amdgcn_mfma_f32_16x16x32_bf16(Bt[n][k], At[m][k], acc[ai][bj][m][n], 0, 0, 0); __builtin_amdgcn_s_setprio(0); } while (0)
#define PG8_WAIT_V(n) asm volatile("s_waitcnt vmcnt(" #n ")" ::: "memory")
#define PG8_WAIT_L(n) asm volatile("s_waitcnt lgkmcnt(" #n ")" ::: "memory")
#define PG8_BAR __builtin_amdgcn_s_barrier()
#define PG8_SCHED __builtin_amdgcn_sched_barrier(0)
    Unit cur, nxt; int ui = 0;
    if (!S.next(0, cur)) return;
    f32x4 acc[2][2][4][2];
#pragma unroll
    for (int a = 0; a < 2; ++a)
#pragma unroll
        for (int b = 0; b < 2; ++b)
#pragma unroll
            for (int m = 0; m < 4; ++m)
#pragma unroll
                for (int n = 0; n < 2; ++n) acc[a][b][m][n] = (f32x4){0.f, 0.f, 0.f, 0.f};
    bf16x8 At[4][2], B0[2][2], B1[2][2];
    const char* cA = (const char*)g.A + (size_t)cur.pm * tstep; const char* cB = (const char*)g.Bt + (size_t)cur.pn * tstep;
    S.a_ready(cur);
    if constexpr (SP2) {
        PG8_STAGE(PG8_SB(0, 0), cB, voffB); PG8_STAGE(PG8_SB(0, 1), cB + hstep, voffB); PG8_STAGE(PG8_SA(0, 0), cA, voffA); PG8_STAGE(PG8_SA(0, 1), cA + hstep, voffA);
        if (wr == 1) PG8_BAR;
        PG8_WAIT_V(2); PG8_BAR;
        PG8_STAGE(PG8_SB(1, 0), cB + kstep, voffB); PG8_STAGE(PG8_SA(1, 0), cA + kstep, voffA); PG8_STAGE(PG8_SB(1, 1), cB + hstep + kstep, voffB);
        PG8_WAIT_V(6); PG8_BAR;
    } else {
        PG8_STAGE(PG8_SB(0, 0), cB, voffB); PG8_STAGE(PG8_SA(0, 0), cA, voffA); PG8_STAGE(PG8_SB(0, 1), cB + hstep, voffB); PG8_STAGE(PG8_SA(0, 1), cA + hstep, voffA);
        if (wr == 1) PG8_BAR;
        PG8_WAIT_V(4); PG8_BAR;
        PG8_STAGE(PG8_SB(1, 0), cB + kstep, voffB); PG8_STAGE(PG8_SA(1, 0), cA + kstep, voffA); PG8_STAGE(PG8_SB(1, 1), cB + hstep + kstep, voffB);
        PG8_WAIT_V(6); PG8_BAR;
    }
    for (;;) {
        const bool has_next = S.next(ui + 1, nxt);
        const char* nA = has_next ? (const char*)g.A + (size_t)nxt.pm * tstep : cA; const char* nB = has_next ? (const char*)g.Bt + (size_t)nxt.pn * tstep : cB;
        for (int t = 0; t < nt; t += 2) {
            const bool last = (t == nt - 2);
            const char* a1 = cA + (size_t)(t + 1) * kstep;
            const char* a2 = last ? nA : cA + (size_t)(t + 2) * kstep; const char* b2 = last ? nB : cB + (size_t)(t + 2) * kstep;
            const char* a3 = a2 + kstep; const char* b3 = b2 + kstep;
            if (last && has_next) S.a_ready(nxt);
            if constexpr (SP2) {
            PG8_LDB(B0, 0, 0); PG8_LDB(B1, 0, 1); PG8_SCHED; PG8_LDA(At, 0, 0); PG8_STAGE(PG8_SA(1, 1), a1 + hstep, voffA);
            PG8_WAIT_V(8); PG8_WAIT_L(0); PG8_BAR; PG8_MMA(0, 0, At, B0); PG8_MMA(0, 1, At, B1); PG8_BAR; PG8_SCHED;
            PG8_LDA(At, 0, 1); PG8_STAGE(PG8_SB(0, 0), b2, voffB); PG8_STAGE(PG8_SB(0, 1), b2 + hstep, voffB); PG8_STAGE(PG8_SA(0, 0), a2, voffA);
            PG8_WAIT_V(8); PG8_WAIT_L(0); PG8_BAR; PG8_MMA(1, 0, At, B0); PG8_MMA(1, 1, At, B1); PG8_BAR; PG8_SCHED;
            PG8_LDB(B0, 1, 0); PG8_LDB(B1, 1, 1); PG8_SCHED; PG8_LDA(At, 1, 0); PG8_STAGE(PG8_SA(0, 1), a2 + hstep, voffA);
            PG8_WAIT_V(8); PG8_WAIT_L(0); PG8_BAR; PG8_MMA(0, 0, At, B0); PG8_MMA(0, 1, At, B1); PG8_BAR; PG8_SCHED;
            PG8_LDA(At, 1, 1); PG8_STAGE(PG8_SB(1, 0), b3, voffB); PG8_STAGE(PG8_SB(1, 1), b3 + hstep, voffB); PG8_STAGE(PG8_SA(1, 0), a3, voffA);
            PG8_WAIT_V(8); PG8_WAIT_L(0); PG8_BAR; PG8_MMA(1, 0, At, B0); PG8_MMA(1, 1, At, B1); PG8_BAR; PG8_SCHED;
            } else {
            PG8_LDB(B0, 0, 0); PG8_SCHED; PG8_LDA(At, 0, 0); PG8_STAGE(PG8_SA(1, 1), a1 + hstep, voffA);
            PG8_WAIT_L(8); PG8_BAR; PG8_WAIT_L(0); PG8_MMA(0, 0, At, B0); PG8_BAR; PG8_SCHED;
            PG8_LDB(B1, 0, 1); PG8_STAGE(PG8_SB(0, 0), b2, voffB);
            PG8_BAR; PG8_WAIT_L(0); PG8_MMA(0, 1, At, B1); PG8_BAR;
            PG8_LDA(At, 0, 1); PG8_STAGE(PG8_SA(0, 0), a2, voffA);
            PG8_BAR; PG8_WAIT_L(0); PG8_MMA(1, 0, At, B0); PG8_BAR; PG8_SCHED;
            PG8_STAGE(PG8_SB(0, 1), b2 + hstep, voffB);
            PG8_WAIT_V(6); PG8_BAR; PG8_MMA(1, 1, At, B1); PG8_BAR;
            PG8_LDB(B0, 1, 0); PG8_SCHED; PG8_LDA(At, 1, 0); PG8_STAGE(PG8_SA(0, 1), a2 + hstep, voffA);
            PG8_WAIT_L(8); PG8_BAR; PG8_WAIT_L(0); PG8_MMA(0, 0, At, B0); PG8_BAR; PG8_SCHED;
            PG8_LDB(B1, 1, 1); PG8_STAGE(PG8_SB(1, 0), b3, voffB);
            PG8_BAR; PG8_WAIT_L(0); PG8_MMA(0, 1, At, B1); PG8_BAR;
            PG8_LDA(At, 1, 1); PG8_STAGE(PG8_SA(1, 0), a3, voffA);
            PG8_BAR; PG8_WAIT_L(0); PG8_MMA(1, 0, At, B0); PG8_BAR; PG8_SCHED;
            PG8_STAGE(PG8_SB(1, 1), b3 + hstep, voffB);
            PG8_WAIT_V(6); PG8_BAR; PG8_MMA(1, 1, At, B1); PG8_BAR;
            }
        }
        if constexpr (ALIGN_EPI) { if (wr == 0) PG8_BAR; }
        if constexpr (!Epi::AFTER_DRAIN) { E(acc, cur, wr, wc, fr, fq); S.done(cur); }
        if (!has_next) break;
#pragma unroll
        for (int a = 0; a < 2; ++a)
#pragma unroll
            for (int b = 0; b < 2; ++b)
#pragma unroll
                for (int m = 0; m < 4; ++m)
#pragma unroll
                    for (int n = 0; n < 2; ++n) acc[a][b][m][n] = (f32x4){0.f, 0.f, 0.f, 0.f};
        cur = nxt; cA = nA; cB = nB; ++ui;
        if constexpr (ALIGN_EPI) { if (wr == 1) PG8_BAR; }
    }
    PG8_WAIT_V(0);
    if constexpr (!ALIGN_EPI) { if (wr == 0) PG8_BAR; }
    PG8_BAR;
    if constexpr (Epi::AFTER_DRAIN) { E.fused(acc, cur, wr, wc, fr, fq, lds, wid, lane); S.done(cur); }
#undef PG8_SA
#undef PG8_SB
#undef PG8_STAGE
#undef PG8_LDA
#undef PG8_LDB
#undef PG8_MMA
#undef PG8_WAIT_V
#undef PG8_WAIT_L
#undef PG8_BAR
#undef PG8_SCHED
}
}

namespace pg8 {
struct EpiBf16Plain {
    static constexpr bool PERM = true, AFTER_DRAIN = false;
    bf16_t* O; int ldc;
    __device__ __forceinline__ void operator()(const f32x4 (&acc)[2][2][4][2], const Unit& u, int wr, int wc, int fr, int fq) const {
        const int row0 = u.pm * BM + wr * 64 + fr; const int col0 = u.pn * BM + wc * 32 + 8 * fq;
#pragma unroll
        for (int ai = 0; ai < 2; ++ai)
#pragma unroll
            for (int m = 0; m < 4; ++m) { bf16_t* rowp = O + (size_t)(row0 + ai * HALF + m * 16) * ldc + col0;
#pragma unroll
                for (int bj = 0; bj < 2; ++bj) { const f32x4 v0 = acc[ai][bj][m][0], v1 = acc[ai][bj][m][1];
                    u32x4 w; w.x = cvt_pk_bf16(v0[0], v0[1]); w.y = cvt_pk_bf16(v0[2], v0[3]); w.z = cvt_pk_bf16(v1[0], v1[1]); w.w = cvt_pk_bf16(v1[2], v1[3]);
                    *(u32x4*)(rowp + bj * HALF) = w; } }
    }
};
}

typedef unsigned short bf16_t;
#define LDS_WAIT() asm volatile("s_waitcnt lgkmcnt(0)" ::: "memory")
__device__ __forceinline__ float bf2f(bf16_t b) { return __uint_as_float(((unsigned)b) << 16); }
__device__ __forceinline__ unsigned f2bf(float f) { unsigned u = __float_as_uint(f); return (u + 0x7fffu + ((u >> 16) & 1u)) >> 16; }
__device__ __forceinline__ unsigned pk2(float lo, float hi) { return f2bf(lo) | (f2bf(hi) << 16); }
__device__ __forceinline__ float wave_sum(float v) {
#pragma unroll
    for (int o = 1; o < 64; o <<= 1) v += __shfl_xor(v, o);
    return v;
}
__device__ __forceinline__ float wave_max(float v) {
#pragma unroll
    for (int o = 1; o < 64; o <<= 1) v = fmaxf(v, __shfl_xor(v, o));
    return v;
}
__device__ __forceinline__ float sigmoidf_(float x) { return 1.f / (1.f + __expf(-x)); }
__device__ __forceinline__ float siluf_(float x) { return x / (1.f + __expf(-x)); }

constexpr int D_MODEL = 4096, BATCH = 4, SEQ = 2048, MTOK = BATCH * SEQ;
constexpr int IN_COLS = 26640, IN_PAD = 26880;
constexpr int OFF_MQ = 0, OFF_MK = 2048, OFF_MV = 4096, OFF_GQ = 6144, OFF_GK = 8192, OFF_GV = 10240, OFF_GR = 14336, OFF_GA = 18432, OFF_SM = 18448, OFF_SG = 22544;
constexpr int D_FF = 11008;
constexpr float EPS = 1e-6f;

struct GemmArgs { const bf16_t* A; const bf16_t* Bt; void* C; int M, N, K, ldc; };
template <int EPI>
__global__ __launch_bounds__(512, 2) void k_gemm(GemmArgs a) {
    extern __shared__ __attribute__((aligned(16))) unsigned char shm[];
    pg8::Gemm g{a.A, a.Bt, a.M, a.N, a.K};
    pg8::StaticOrder S; S.init(g.M, g.N, (int)gridDim.x, (int)blockIdx.x);
    if constexpr (EPI == 0) { pg8::EpiBf16Plain E{(bf16_t*)a.C, a.ldc}; pg8::gemm_phase<pg8::EpiBf16Plain, pg8::StaticOrder, true, true>((PG8_LAS unsigned char*)shm, g, S, E); }
    else { pg8::EpiF32 E{(float*)a.C, a.ldc, nullptr}; pg8::gemm_phase<pg8::EpiF32, pg8::StaticOrder, true, true>((PG8_LAS unsigned char*)shm, g, S, E); }
}
static void launch_gemm(int epi, const bf16_t* A, const bf16_t* Bt, void* C, int M, int N, int K, int ldc, hipStream_t stream) {
    GemmArgs a; memset(&a, 0, sizeof(a)); a.A = A; a.Bt = Bt; a.C = C; a.M = M; a.N = N; a.K = K; a.ldc = ldc;
    if (epi == 0) hipLaunchKernelGGL(k_gemm<0>, dim3(256), dim3(512), pg8::STAGE_BYTES, stream, a);
    else hipLaunchKernelGGL(k_gemm<1>, dim3(256), dim3(512), pg8::STAGE_BYTES, stream, a);
}

__global__ __launch_bounds__(256) void k_convert(const float* __restrict__ W, int K, int N, bf16_t* __restrict__ Bt, int row_off) {
    __shared__ float scr_all[4][64 * 33];
    const int wave = threadIdx.x >> 6, lane = threadIdx.x & 63;
    float* scr = scr_all[wave];
    const int nblk = (N + 31) / 32, kblk = K / 64, nitems = nblk * kblk;
    for (int item = blockIdx.x * 4 + wave; item < nitems; item += gridDim.x * 4) {
        const int kb = item / nblk, nb = item % nblk, k0 = kb * 64, n0 = nb * 32;
        const int n = n0 + (lane & 31);
#pragma unroll 8
        for (int i = 0; i < 32; ++i) { const int kk = 2 * i + (lane >> 5); scr[kk * 33 + (lane & 31)] = (n < N) ? W[(size_t)(k0 + kk) * N + n] : 0.f; }
        LDS_WAIT(); asm volatile("" ::: "memory");
        const int c = lane & 7;
#pragma unroll
        for (int j = 0; j < 4; ++j) { const int nn = (lane >> 3) + 8 * j; const float* s = scr + (8 * c) * 33 + nn;
            uint4 o; o.x = pk2(s[0 * 33], s[1 * 33]); o.y = pk2(s[2 * 33], s[3 * 33]); o.z = pk2(s[4 * 33], s[5 * 33]); o.w = pk2(s[6 * 33], s[7 * 33]);
            if (n0 + nn < N) *(uint4*)(Bt + (size_t)(row_off + n0 + nn) * K + k0 + 8 * c) = o; }
        LDS_WAIT(); asm volatile("" ::: "memory");
    }
}

__global__ __launch_bounds__(256) void k_rmsnorm_bf16(const float* __restrict__ x, const float* __restrict__ g, bf16_t* __restrict__ out, int rows) {
    const int lane = threadIdx.x & 63; const int row = blockIdx.x * 4 + (threadIdx.x >> 6); if (row >= rows) return;
    const float4* xr = (const float4*)(x + (size_t)row * D_MODEL) + lane; const float4* gr = (const float4*)g + lane;
    float4 v[16]; float s = 0.f;
#pragma unroll
    for (int j = 0; j < 16; ++j) { v[j] = xr[64 * j]; s += v[j].x * v[j].x + v[j].y * v[j].y + v[j].z * v[j].z + v[j].w * v[j].w; }
    const float rstd = rsqrtf(wave_sum(s) * (1.f / D_MODEL) + EPS);
    uint2* o = (uint2*)(out + (size_t)row * D_MODEL) + lane;
#pragma unroll
    for (int j = 0; j < 16; ++j) { const float4 gg = gr[64 * j]; uint2 w; w.x = pk2(v[j].x * rstd * gg.x, v[j].y * rstd * gg.y); w.y = pk2(v[j].z * rstd * gg.z, v[j].w * rstd * gg.w); o[64 * j] = w; }
}

__global__ __launch_bounds__(256) void k_rope(const bf16_t* __restrict__ u, float* __restrict__ Q32, float* __restrict__ K32) {
    const size_t i = (size_t)blockIdx.x * 256 + threadIdx.x;
    if (i >= (size_t)MTOK * 16 * 64) return;
    const int d = (int)(i & 63), hd = (int)((i >> 6) & 15); const int row = (int)(i >> 10); const int pos = row & (SEQ - 1);
    const float inv_freq = powf(10000.f, -(float)d / 64.f); const float ang = (float)pos * inv_freq; const float c = cosf(ang), s = sinf(ang);
    const bf16_t* ur = u + (size_t)row * IN_PAD;
    { const float x1 = bf2f(ur[OFF_MQ + hd * 128 + d]), x2 = bf2f(ur[OFF_MQ + hd * 128 + 64 + d]);
      Q32[(size_t)row * 2048 + hd * 128 + d] = x1 * c - x2 * s; Q32[(size_t)row * 2048 + hd * 128 + 64 + d] = x2 * c + x1 * s; }
    { const float x1 = bf2f(ur[OFF_MK + hd * 128 + d]), x2 = bf2f(ur[OFF_MK + hd * 128 + 64 + d]);
      K32[(size_t)row * 2048 + hd * 128 + d] = x1 * c - x2 * s; K32[(size_t)row * 2048 + hd * 128 + 64 + d] = x2 * c + x1 * s; }
}
__global__ __launch_bounds__(128) void k_kmean(const float* __restrict__ K32, float* __restrict__ KM) {
    const int n = blockIdx.x & 7, hd = (blockIdx.x >> 3) & 15, b = blockIdx.x >> 7, d = threadIdx.x;
    float s = 0.f;
    for (int t = 0; t < 256; ++t) s += K32[(size_t)(b * SEQ + n * 256 + t) * 2048 + hd * 128 + d];
    KM[(size_t)blockIdx.x * 128 + d] = s * (1.f / 256.f);
}
__global__ __launch_bounds__(256) void k_moba(const float* __restrict__ Q32, const float* __restrict__ K32, const bf16_t* __restrict__ u, const float* __restrict__ KM, bf16_t* __restrict__ Aout) {
    __shared__ float sq[4][128]; __shared__ float sp[4][1024];
    const int wave = threadIdx.x >> 6, lane = threadIdx.x & 63;
    const int gw = blockIdx.x * 4 + wave; const int row = gw >> 4, hd = gw & 15;
    const int b = row >> 11, s = row & (SEQ - 1), qb = s >> 8;
    const float* q = Q32 + (size_t)row * 2048 + hd * 128;
    const float q0 = q[lane], q1 = q[lane + 64];
    sq[wave][lane] = q0; sq[wave][lane + 64] = q1;
    LDS_WAIT(); asm volatile("" ::: "memory");
    float gate[8];
#pragma unroll
    for (int n = 0; n < 8; ++n) { const float* km = KM + (size_t)((b * 16 + hd) * 8 + n) * 128; float g = wave_sum(q0 * km[lane] + q1 * km[lane + 64]); gate[n] = (n < qb) ? g : -INFINITY; }
    unsigned picked = 0u; int selb[3];
#pragma unroll
    for (int r = 0; r < 3; ++r) { float best = -INFINITY; int bi = -1;
#pragma unroll
        for (int n = 0; n < 8; ++n) { const bool ok = !((picked >> n) & 1u) && gate[n] > best; if (ok) { best = gate[n]; bi = n; } }
        selb[r] = bi; if (bi >= 0) picked |= 1u << bi; }
    float sc[16]; float mx = -INFINITY;
#pragma unroll
    for (int m = 0; m < 16; ++m) { const int blk = (m < 12) ? selb[m >> 2] : qb; float v = -INFINITY;
        if (blk >= 0) { const int j = blk * 256 + (m & 3) * 64 + lane;
            if (m < 12 || j <= s) { const float4* kr = (const float4*)(K32 + (size_t)(b * SEQ + j) * 2048 + hd * 128); float a = 0.f;
                for (int d4 = 0; d4 < 32; ++d4) { const float4 kv = kr[d4]; const float* qq = &sq[wave][4 * d4]; a += qq[0] * kv.x + qq[1] * kv.y + qq[2] * kv.z + qq[3] * kv.w; }
                v = a * 0.08838834764831845f; } }
        sc[m] = v; mx = fmaxf(mx, v); }
    mx = wave_max(mx);
    float sum = 0.f;
#pragma unroll
    for (int m = 0; m < 16; ++m) { sc[m] = (sc[m] == -INFINITY) ? 0.f : __expf(sc[m] - mx); sum += sc[m]; }
    sum = wave_sum(sum); const float inv = 1.f / sum;
#pragma unroll
    for (int m = 0; m < 16; ++m) sp[wave][m * 64 + lane] = sc[m] * inv;
    LDS_WAIT(); asm volatile("" ::: "memory");
    float o0 = 0.f, o1 = 0.f;
#pragma unroll
    for (int m = 0; m < 16; ++m) { const int blk = (m < 12) ? selb[m >> 2] : qb;
        if (blk >= 0) { const int jb = blk * 256 + (m & 3) * 64; int lim = 64; if (m >= 12) { lim = s - jb + 1; lim = lim < 0 ? 0 : (lim > 64 ? 64 : lim); }
            for (int l = 0; l < lim; ++l) { const float p = sp[wave][m * 64 + l]; const unsigned vv = *(const unsigned*)(u + (size_t)(b * SEQ + jb + l) * IN_PAD + OFF_MV + hd * 128 + 2 * lane);
                o0 += p * __uint_as_float(vv << 16); o1 += p * __uint_as_float(vv & 0xffff0000u); } } }
    *(unsigned*)(Aout + (size_t)row * 2048 + hd * 128 + 2 * lane) = pk2(o0, o1);
    LDS_WAIT(); asm volatile("" ::: "memory");
}
__global__ __launch_bounds__(256) void k_decay(const bf16_t* __restrict__ u, const float* __restrict__ up, const float* __restrict__ bias, float* __restrict__ A32) {
    const size_t i = (size_t)blockIdx.x * 256 + threadIdx.x; if (i >= (size_t)MTOK * 2048) return;
    const int c = (int)(i & 2047), row = (int)(i >> 11);
    float x = bias[c];
#pragma unroll
    for (int r = 0; r < 16; ++r) x += bf2f(u[(size_t)row * IN_PAD + OFF_GA + r]) * up[r * 2048 + c];
    const float ls = fminf(x, 0.f) - log1pf(expf(-fabsf(x)));
    A32[i] = expf(ls * (1.f / 16.f));
}
__global__ __launch_bounds__(256) void k_gla(const bf16_t* __restrict__ u, const float* __restrict__ A32, float* __restrict__ O32) {
    const int wave = threadIdx.x >> 6, lane = threadIdx.x & 63; const int gw = blockIdx.x * 4 + wave;
    const int dvg = gw & 31, h = (gw >> 5) & 7, b = gw >> 8; const int dvl = lane & 15, kg = lane >> 4;
    float S[64];
#pragma unroll
    for (int i = 0; i < 64; ++i) S[i] = 0.f;
    for (int t = 0; t < SEQ; ++t) { const size_t row = (size_t)b * SEQ + t;
        const uint4* qp = (const uint4*)(u + row * IN_PAD + OFF_GQ + h * 256 + kg * 64); const uint4* kp = (const uint4*)(u + row * IN_PAD + OFF_GK + h * 256 + kg * 64);
        const float4* ap = (const float4*)(A32 + row * 2048 + h * 256 + kg * 64);
        const float v = bf2f(u[row * IN_PAD + OFF_GV + h * 512 + dvg * 16 + dvl]);
        float o = 0.f;
#pragma unroll
        for (int c8 = 0; c8 < 8; ++c8) { const uint4 qv = qp[c8], kv = kp[c8]; const float4 a0 = ap[2 * c8], a1 = ap[2 * c8 + 1];
            const unsigned qw[4] = {qv.x, qv.y, qv.z, qv.w}, kw[4] = {kv.x, kv.y, kv.z, kv.w}; const float aa[8] = {a0.x, a0.y, a0.z, a0.w, a1.x, a1.y, a1.z, a1.w};
#pragma unroll
            for (int j = 0; j < 4; ++j) { const float qlo = __uint_as_float(qw[j] << 16), qhi = __uint_as_float(qw[j] & 0xffff0000u), klo = __uint_as_float(kw[j] << 16), khi = __uint_as_float(kw[j] & 0xffff0000u);
                S[c8 * 8 + 2 * j] = aa[2 * j] * S[c8 * 8 + 2 * j] + klo * v; o += qlo * S[c8 * 8 + 2 * j];
                S[c8 * 8 + 2 * j + 1] = aa[2 * j + 1] * S[c8 * 8 + 2 * j + 1] + khi * v; o += qhi * S[c8 * 8 + 2 * j + 1]; } }
        o += __shfl_xor(o, 16); o += __shfl_xor(o, 32);
        if (kg == 0) O32[row * 4096 + h * 512 + dvg * 16 + dvl] = o * (1.f / 16.f);
    }
}
__global__ __launch_bounds__(256) void k_gla_norm(const float* __restrict__ O32, const float* __restrict__ g, const bf16_t* __restrict__ u, bf16_t* __restrict__ Aout) {
    const int lane = threadIdx.x & 63; const int gw = blockIdx.x * 4 + (threadIdx.x >> 6); const int row = gw >> 3, h = gw & 7;
    const float* o = O32 + (size_t)row * 4096 + h * 512; float v[8]; float s = 0.f;
#pragma unroll
    for (int j = 0; j < 8; ++j) { v[j] = o[lane + 64 * j]; s += v[j] * v[j]; }
    const float rstd = rsqrtf(wave_sum(s) * (1.f / 512.f) + EPS);
#pragma unroll
    for (int j = 0; j < 8; ++j) { const int dv = lane + 64 * j; const float gr = bf2f(u[(size_t)row * IN_PAD + OFF_GR + h * 512 + dv]);
        Aout[(size_t)row * 4096 + h * 512 + dv] = (bf16_t)f2bf(v[j] * rstd * g[dv] * siluf_(gr)); }
}
__global__ __launch_bounds__(256) void k_merge(const bf16_t* __restrict__ u, const float* __restrict__ ym, const float* __restrict__ yg, bf16_t* __restrict__ out) {
    const size_t i = (size_t)blockIdx.x * 256 + threadIdx.x; if (i >= (size_t)MTOK * 4096) return;
    const int c = (int)(i & 4095); const size_t row = i >> 12;
    const float gm = bf2f(u[row * IN_PAD + OFF_SM + c]), gg = bf2f(u[row * IN_PAD + OFF_SG + c]);
    out[i] = (bf16_t)f2bf(sigmoidf_(gm) * ym[i] + sigmoidf_(gg) * yg[i]);
}
__global__ __launch_bounds__(256) void k_resnorm1(const float* __restrict__ x, const float* __restrict__ y, const float* __restrict__ g1, const float* __restrict__ g2, float* __restrict__ x1out, bf16_t* __restrict__ h2) {
    const int lane = threadIdx.x & 63; const int row = blockIdx.x * 4 + (threadIdx.x >> 6);
    const float4* yr = (const float4*)(y + (size_t)row * D_MODEL) + lane; const float4* xr = (const float4*)(x + (size_t)row * D_MODEL) + lane;
    float4 v[16]; float s = 0.f;
#pragma unroll
    for (int j = 0; j < 16; ++j) { v[j] = yr[64 * j]; s += v[j].x * v[j].x + v[j].y * v[j].y + v[j].z * v[j].z + v[j].w * v[j].w; }
    const float rstd = rsqrtf(wave_sum(s) * (1.f / D_MODEL) + EPS); float s2 = 0.f;
    float4* xo = (float4*)(x1out + (size_t)row * D_MODEL) + lane;
#pragma unroll
    for (int j = 0; j < 16; ++j) { const float4 gg = ((const float4*)g1)[lane + 64 * j], xx = xr[64 * j];
        v[j].x = xx.x + v[j].x * rstd * gg.x; v[j].y = xx.y + v[j].y * rstd * gg.y; v[j].z = xx.z + v[j].z * rstd * gg.z; v[j].w = xx.w + v[j].w * rstd * gg.w;
        xo[64 * j] = v[j]; s2 += v[j].x * v[j].x + v[j].y * v[j].y + v[j].z * v[j].z + v[j].w * v[j].w; }
    const float rstd2 = rsqrtf(wave_sum(s2) * (1.f / D_MODEL) + EPS);
    uint2* o = (uint2*)(h2 + (size_t)row * D_MODEL) + lane;
#pragma unroll
    for (int j = 0; j < 16; ++j) { const float4 gg = ((const float4*)g2)[lane + 64 * j]; uint2 w; w.x = pk2(v[j].x * rstd2 * gg.x, v[j].y * rstd2 * gg.y); w.y = pk2(v[j].z * rstd2 * gg.z, v[j].w * rstd2 * gg.w); o[64 * j] = w; }
}
__global__ __launch_bounds__(256) void k_swiglu(const bf16_t* __restrict__ gu, bf16_t* __restrict__ hid) {
    const size_t i = (size_t)blockIdx.x * 256 + threadIdx.x; if (i >= (size_t)MTOK * D_FF) return;
    const size_t row = i / D_FF; const int c = (int)(i % D_FF);
    const float g = bf2f(gu[row * (2 * D_FF) + c]), uu = bf2f(gu[row * (2 * D_FF) + D_FF + c]);
    hid[i] = (bf16_t)f2bf(siluf_(g) * uu);
}
__global__ __launch_bounds__(256) void k_resnorm2(const float* __restrict__ y, const float* __restrict__ g, float* __restrict__ out) {
    const int lane = threadIdx.x & 63; const int row = blockIdx.x * 4 + (threadIdx.x >> 6);
    const float4* yr = (const float4*)(y + (size_t)row * D_MODEL) + lane; float4* xo = (float4*)(out + (size_t)row * D_MODEL) + lane;
    float4 v[16]; float s = 0.f;
#pragma unroll
    for (int j = 0; j < 16; ++j) { v[j] = yr[64 * j]; s += v[j].x * v[j].x + v[j].y * v[j].y + v[j].z * v[j].z + v[j].w * v[j].w; }
    const float rstd = rsqrtf(wave_sum(s) * (1.f / D_MODEL) + EPS);
#pragma unroll
    for (int j = 0; j < 16; ++j) { const float4 gg = ((const float4*)g)[lane + 64 * j]; float4 xx = xo[64 * j];
        xx.x += v[j].x * rstd * gg.x; xx.y += v[j].y * rstd * gg.y; xx.z += v[j].z * rstd * gg.z; xx.w += v[j].w * rstd * gg.w; xo[64 * j] = xx; }
}

constexpr size_t MiB = 1u << 20;
constexpr size_t WS_WM = 1 * MiB;
constexpr size_t WS_WG = WS_WM + (size_t)4096 * 2048 * 2;
constexpr size_t WS_WO = WS_WG + (size_t)4096 * 4096 * 2;
constexpr size_t WS_WGU = WS_WO + (size_t)4096 * 4096 * 2;
constexpr size_t WS_WD = WS_WGU + (size_t)22016 * 4096 * 2;
constexpr size_t WS_RA = WS_WD + (size_t)4096 * 11008 * 2;
constexpr size_t RA_BYTES = (size_t)IN_PAD * 4096 * 2;
constexpr size_t WS_RU = WS_RA + RA_BYTES;
constexpr size_t RU_BYTES = (size_t)MTOK * IN_PAD * 2;
constexpr size_t WS_RH = WS_RU + RU_BYTES;
constexpr size_t WS_RO = WS_RH + (size_t)MTOK * 4096 * 2;
constexpr size_t WS_AM = WS_RO + (size_t)MTOK * 4096 * 4;
constexpr size_t WS_AG = WS_AM + (size_t)MTOK * 2048 * 2;
constexpr size_t WS_MG = WS_AG + (size_t)MTOK * 4096 * 2;
constexpr size_t WS_KM = WS_MG + (size_t)MTOK * 4096 * 2;
constexpr size_t WS_HID = WS_KM + 1 * MiB;
constexpr size_t WS_END = WS_HID + (size_t)MTOK * D_FF * 2;

extern "C" void kernel_launch(void* const* d_in, const int* in_sizes, int n_in, void* d_out, int out_size, void* d_ws, size_t ws_size, hipStream_t stream) {
    static int ok = 0;
    if (ok == 0) {
        if (n_in != 15 || in_sizes[0] != MTOK * D_MODEL || out_size != MTOK * D_MODEL || ws_size < WS_END) {
            fprintf(stderr, "kernel_launch: shape/ws mismatch n_in %d in0 %d out %d ws %zu need %zu\n", n_in, n_in > 0 ? in_sizes[0] : -1, out_size, ws_size, (size_t)WS_END); ok = -1; return; }
        if (hipFuncSetAttribute((const void*)k_gemm<0>, hipFuncAttributeMaxDynamicSharedMemorySize, pg8::STAGE_BYTES) != hipSuccess ||
            hipFuncSetAttribute((const void*)k_gemm<1>, hipFuncAttributeMaxDynamicSharedMemorySize, pg8::STAGE_BYTES) != hipSuccess) { fprintf(stderr, "kernel_launch: hipFuncSetAttribute failed\n"); ok = -1; return; }
        ok = 1;
    }
    if (ok < 0) return;
    const float* x = (const float*)d_in[0]; const float* g_premix = (const float*)d_in[1]; const float* w_in = (const float*)d_in[2];
    const float* gate_up = (const float*)d_in[3]; const float* gate_bias = (const float*)d_in[4]; const float* g_glanorm = (const float*)d_in[5];
    const float* w_bm = (const float*)d_in[6]; const float* w_bg = (const float*)d_in[7]; const float* w_out = (const float*)d_in[8];
    const float* g_postmix = (const float*)d_in[9]; const float* g_preffn = (const float*)d_in[10];
    const float* w_fg = (const float*)d_in[11]; const float* w_fu = (const float*)d_in[12]; const float* w_fd = (const float*)d_in[13]; const float* g_postffn = (const float*)d_in[14];
    unsigned char* ws = (unsigned char*)d_ws; float* out = (float*)d_out;
    bf16_t* WmT = (bf16_t*)(ws + WS_WM); bf16_t* WgT = (bf16_t*)(ws + WS_WG); bf16_t* WoT = (bf16_t*)(ws + WS_WO); bf16_t* WguT = (bf16_t*)(ws + WS_WGU); bf16_t* WdT = (bf16_t*)(ws + WS_WD);
    bf16_t* WinT = (bf16_t*)(ws + WS_RA); float* Q32 = (float*)(ws + WS_RA); float* K32 = Q32 + (size_t)MTOK * 2048; float* A32 = K32 + (size_t)MTOK * 2048;
    float* ymoba = (float*)(ws + WS_RA); float* y = (float*)(ws + WS_RA);
    bf16_t* u = (bf16_t*)(ws + WS_RU); bf16_t* gu = (bf16_t*)(ws + WS_RU);
    bf16_t* h = (bf16_t*)(ws + WS_RH); bf16_t* h2 = h;
    float* ogla = (float*)(ws + WS_RO); float* ygla = ogla; float* y2 = ogla;
    bf16_t* Am = (bf16_t*)(ws + WS_AM); bf16_t* Ag = (bf16_t*)(ws + WS_AG); bf16_t* mg = (bf16_t*)(ws + WS_MG); float* KM = (float*)(ws + WS_KM); bf16_t* hid = (bf16_t*)(ws + WS_HID);
    const int CG = 2048;
    hipLaunchKernelGGL(k_convert, dim3(CG), dim3(256), 0, stream, w_in, 4096, IN_COLS, WinT, 0);
    (void)hipMemsetAsync(WinT + (size_t)IN_COLS * 4096, 0, (size_t)(IN_PAD - IN_COLS) * 4096 * 2, stream);
    hipLaunchKernelGGL(k_convert, dim3(CG), dim3(256), 0, stream, w_bm, 2048, 4096, WmT, 0);
    hipLaunchKernelGGL(k_convert, dim3(CG), dim3(256), 0, stream, w_bg, 4096, 4096, WgT, 0);
    hipLaunchKernelGGL(k_convert, dim3(CG), dim3(256), 0, stream, w_out, 4096, 4096, WoT, 0);
    hipLaunchKernelGGL(k_convert, dim3(CG), dim3(256), 0, stream, w_fg, 4096, D_FF, WguT, 0);
    hipLaunchKernelGGL(k_convert, dim3(CG), dim3(256), 0, stream, w_fu, 4096, D_FF, WguT, D_FF);
    hipLaunchKernelGGL(k_convert, dim3(CG), dim3(256), 0, stream, w_fd, D_FF, 4096, WdT, 0);
    hipLaunchKernelGGL(k_rmsnorm_bf16, dim3(MTOK / 4), dim3(256), 0, stream, x, g_premix, h, MTOK);
    launch_gemm(0, h, WinT, u, MTOK, IN_PAD, 4096, IN_PAD, stream);
    hipLaunchKernelGGL(k_rope, dim3(MTOK * 16 * 64 / 256), dim3(256), 0, stream, u, Q32, K32);
    hipLaunchKernelGGL(k_kmean, dim3(BATCH * 16 * 8), dim3(128), 0, stream, K32, KM);
    hipLaunchKernelGGL(k_moba, dim3(MTOK * 16 / 4), dim3(256), 0, stream, Q32, K32, u, KM, Am);
    hipLaunchKernelGGL(k_decay, dim3(MTOK * 2048 / 256), dim3(256), 0, stream, u, gate_up, gate_bias, A32);
    hipLaunchKernelGGL(k_gla, dim3(256), dim3(256), 0, stream, u, A32, ogla);
    hipLaunchKernelGGL(k_gla_norm, dim3(MTOK * 8 / 4), dim3(256), 0, stream, ogla, g_glanorm, u, Ag);
    launch_gemm(1, Am, WmT, ymoba, MTOK, 4096, 2048, 4096, stream);
    launch_gemm(1, Ag, WgT, ygla, MTOK, 4096, 4096, 4096, stream);
    hipLaunchKernelGGL(k_merge, dim3(MTOK * 4096 / 256), dim3(256), 0, stream, u, ymoba, ygla, mg);
    launch_gemm(1, mg, WoT, y, MTOK, 4096, 4096, 4096, stream);
    hipLaunchKernelGGL(k_resnorm1, dim3(MTOK / 4), dim3(256), 0, stream, x, y, g_postmix, g_preffn, out, h2);
    launch_gemm(0, h2, WguT, gu, MTOK, 2 * D_FF, 4096, 2 * D_FF, stream);
    hipLaunchKernelGGL(k_swiglu, dim3((unsigned)(((size_t)MTOK * D_FF + 255) / 256)), dim3(256), 0, stream, gu, hid);
    launch_gemm(1, hid, WdT, y2, MTOK, 4096, D_FF, 4096, stream);
    hipLaunchKernelGGL(k_resnorm2, dim3(MTOK / 4), dim3(256), 0, stream, y2, g_postffn, out);
    const hipError_t le = hipPeekAtLastError();
    if (le != hipSuccess) fprintf(stderr, "kernel_launch: launch failed: %s\n", hipGetErrorName(le));
}
```

```cpp
#include <hip/hip_runtime.h>
#include <cstdio>
#include <cstdint>
#include <cstring>
namespace pg8 {
#define PG8_LAS __attribute__((address_space(3)))
typedef unsigned short bf16_t;
typedef short bf16x8 __attribute__((ext_vector_type(8)));
typedef float f32x4 __attribute__((ext_vector_type(4)));
typedef unsigned u32x4 __attribute__((ext_vector_type(4)));
constexpr int BM = 256, BK = 64, HALF = 128, HTB = HALF * BK * 2  , STAGE_BYTES = 8 * HTB, NXCD = 8, WGM = 8;

__host__ __device__ __forceinline__ int lds_byte(int r, int c) { const int st = (r >> 4) * 2 + (c >> 5), rr = r & 15, cc = c & 31, ob = rr * 64 + cc * 2; return st * 1024 + (ob ^ (((ob >> 9) & 1) << 5)); }
__host__ __device__ __forceinline__ void stage_rc(int b, int& R, int& C) { const int st = b / 1024, sb = b % 1024, swz = sb ^ (((sb >> 9) & 1) << 5); R = (st >> 1) * 16 + swz / 64; C = (st & 1) * 32 + (swz % 64) / 2; }
__host__ __device__ __forceinline__ int perm32(int rho) { const int n = rho >> 4, i = rho & 15; return 8 * (i >> 2) + 4 * n + (i & 3); }

struct Unit { int pm, pn; };
struct Gemm { const bf16_t* A; const bf16_t* Bt; int M, N, K; };

struct StaticOrder {
    int nM, nN, nwg, G, c;
    __host__ __device__ void init(int M, int N, int G_, int c_) { nM = M / BM; nN = N / BM; nwg = nM * nN; G = G_; c = c_; }
    __host__ __device__ bool next(int i, Unit& u) const {
        const long L = (long)i * G + c; if (L >= nwg) return false;
        int wgid = (int)L; { const int q = nwg / NXCD, r = nwg % NXCD, xcd = wgid % NXCD, off = wgid / NXCD; wgid = (xcd < r ? xcd * (q + 1) : r * (q + 1) + (xcd - r) * q) + off; }
        const int nig = WGM * nN, gid = wgid / nig, fm = gid * WGM, gsz = (nM - fm) < WGM ? (nM - fm) : WGM;
        u.pm = fm + ((wgid % nig) % gsz); u.pn = (wgid % nig) / gsz; return true;
    }
    __device__ __forceinline__ void a_ready(const Unit&) const {}
    __device__ __forceinline__ void done(const Unit&) const {}
};
__device__ __forceinline__ unsigned cvt_pk_bf16(float lo, float hi) { typedef __bf16 bf2_ __attribute__((ext_vector_type(2))); typedef float f2_ __attribute__((ext_vector_type(2))); const f2_ f = {lo, hi}; return __builtin_bit_cast(unsigned, __builtin_convertvector(f, bf2_)); }
typedef float f32x2 __attribute__((ext_vector_type(2)));
struct EpiF32 {
    static constexpr bool PERM = false, AFTER_DRAIN = false;
    float* C; int ldc; const float* bias;
    __device__ __forceinline__ void operator()(const f32x4 (&acc)[2][2][4][2], const Unit& u, int wr, int wc, int fr, int fq) const {
        const int row0 = u.pm * BM + wr * 64 + fr, col0 = u.pn * BM + wc * 32 + 4 * fq;
        f32x4 bv[2][2];
#pragma unroll
        for (int bj = 0; bj < 2; ++bj)
#pragma unroll
            for (int n = 0; n < 2; ++n) bv[bj][n] = bias ? *(const f32x4*)(bias + col0 + bj * HALF + n * 16) : (f32x4){0.f, 0.f, 0.f, 0.f};
#pragma unroll
        for (int ai = 0; ai < 2; ++ai)
#pragma unroll
            for (int m = 0; m < 4; ++m) { float* rowp = C + (size_t)(row0 + ai * HALF + m * 16) * ldc + col0;
#pragma unroll
                for (int bj = 0; bj < 2; ++bj)
#pragma unroll
                    for (int n = 0; n < 2; ++n) *(f32x4*)(rowp + bj * HALF + n * 16) = acc[ai][bj][m][n] + bv[bj][n]; }
    }
};
template <class Epi, class Sched, bool ALIGN_EPI = false, bool SP2 = false>
__device__ __forceinline__ void gemm_phase(PG8_LAS unsigned char* lds, const Gemm g, const Sched& S, const Epi& E) {
    const int tid = threadIdx.x, wid = __builtin_amdgcn_readfirstlane(tid >> 6), lane = tid & 63, wr = wid >> 2, wc = wid & 3, fr = lane & 15, fq = lane >> 4;
    const int K = g.K, nt = K / BK;
    unsigned voffA[2], voffB[2];
#pragma unroll
    for (int i = 0; i < 2; ++i) { int R, C; stage_rc(tid * 16 + i * 8192, R, C); const int Rb = Epi::PERM ? ((R & ~31) + perm32(R & 31)) : R;
        voffA[i] = (unsigned)(R * K + C) * 2u; voffB[i] = (unsigned)(Rb * K + C) * 2u; }
    const size_t kstep = (size_t)(BK * 2);
    const size_t hstep = (size_t)HALF * K * 2;
    const size_t tstep = 2 * hstep;
    const unsigned ldsw = (unsigned)wid * 1024u;
    const int aoff = lds_byte(wr * 64 + fr, fq * 8), boff = lds_byte(wc * 32 + fr, fq * 8);
#define PG8_SA(b, h) (((b) * 2 + (h)) * HTB)
#define PG8_SB(b, h) ((4 + (b) * 2 + (h)) * HTB)
#define PG8_STAGE(bufoff, gbase, voff) do { _Pragma("unroll") for (int _i = 0; _i < 2; ++_i) \
        __builtin_amdgcn_global_load_lds((const unsigned*)((const char*)(gbase) + (voff)[_i]), (PG8_LAS unsigned*)(lds + (bufoff) + ldsw + _i * 8192), 16, 0, 0); } while (0)
#define PG8_LDA(dst, b, h) do { _Pragma("unroll") for (int m = 0; m < 4; ++m) _Pragma("unroll") for (int k = 0; k < 2; ++k) dst[m][k] = *(const PG8_LAS bf16x8*)(lds + PG8_SA(b, h) + aoff + m * 2048 + k * 1024); } while (0)
#define PG8_LDB(dst, b, h) do { _Pragma("unroll") for (int n = 0; n < 2; ++n) _Pragma("unroll") for (int k = 0; k < 2; ++k) dst[n][k] = *(const PG8_LAS bf16x8*)(lds + PG8_SB(b, h) + boff + n * 2048 + k * 1024); } while (0)
#define PG8_MMA(ai, bj, At, Bt) do { __builtin_amdgcn_s_setprio(1); _Pragma("unroll") for (int m = 0; m < 4; ++m) _Pragma("unroll") for (int n = 0; n < 2; ++n) _Pragma("unroll") for (int k = 0; k < 2; ++k) \
        acc[ai][bj][m][n] = __builtin_amdgcn_mfma_f32_16x16x32_bf16(Bt[n][k], At[m][k], acc[ai][bj][m][n], 0, 0, 0); __builtin_amdgcn_s_setprio(0); } while (0)
#define PG8_WAIT_V(n) asm volatile("s_waitcnt vmcnt(" #n ")" ::: "memory")
#define PG8_WAIT_L(n) asm volatile("s_waitcnt lgkmcnt(" #n ")" ::: "memory")
#define PG8_BAR __builtin_amdgcn_s_barrier()
#define PG8_SCHED __builtin_amdgcn_sched_barrier(0)
    Unit cur, nxt; int ui = 0;
    if (!S.next(0, cur)) return;
    f32x4 acc[2][2][4][2];
#pragma unroll
    for (int a = 0; a < 2; ++a)
#pragma unroll
        for (int b = 0; b < 2; ++b)
#pragma unroll
            for (int m = 0; m < 4; ++m)
#pragma unroll
                for (int n = 0; n < 2; ++n) acc[a][b][m][n] = (f32x4){0.f, 0.f, 0.f, 0.f};
    bf16x8 At[4][2], B0[2][2], B1[2][2];
    const char* cA = (const char*)g.A + (size_t)cur.pm * tstep; const char* cB = (const char*)g.Bt + (size_t)cur.pn * tstep;
    S.a_ready(cur);
    if constexpr (SP2) {
        PG8_STAGE(PG8_SB(0, 0), cB, voffB); PG8_STAGE(PG8_SB(0, 1), cB + hstep, voffB); PG8_STAGE(PG8_SA(0, 0), cA, voffA); PG8_STAGE(PG8_SA(0, 1), cA + hstep, voffA);
        if (wr == 1) PG8_BAR;
        PG8_WAIT_V(2); PG8_BAR;
        PG8_STAGE(PG8_SB(1, 0), cB + kstep, voffB); PG8_STAGE(PG8_SA(1, 0), cA + kstep, voffA); PG8_STAGE(PG8_SB(1, 1), cB + hstep + kstep, voffB);
        PG8_WAIT_V(6); PG8_BAR;
    } else {
        PG8_STAGE(PG8_SB(0, 0), cB, voffB); PG8_STAGE(PG8_SA(0, 0), cA, voffA); PG8_STAGE(PG8_SB(0, 1), cB + hstep, voffB); PG8_STAGE(PG8_SA(0, 1), cA + hstep, voffA);
        if (wr == 1) PG8_BAR;
        PG8_WAIT_V(4); PG8_BAR;
        PG8_STAGE(PG8_SB(1, 0), cB + kstep, voffB); PG8_STAGE(PG8_SA(1, 0), cA + kstep, voffA); PG8_STAGE(PG8_SB(1, 1), cB + hstep + kstep, voffB);
        PG8_WAIT_V(6); PG8_BAR;
    }
    for (;;) {
        const bool has_next = S.next(ui + 1, nxt);
        const char* nA = has_next ? (const char*)g.A + (size_t)nxt.pm * tstep : cA; const char* nB = has_next ? (const char*)g.Bt + (size_t)nxt.pn * tstep : cB;
        for (int t = 0; t < nt; t += 2) {
            const bool last = (t == nt - 2);
            const char* a1 = cA + (size_t)(t + 1) * kstep;
            const char* a2 = last ? nA : cA + (size_t)(t + 2) * kstep; const char* b2 = last ? nB : cB + (size_t)(t + 2) * kstep;
            const char* a3 = a2 + kstep; const char* b3 = b2 + kstep;
            if (last && has_next) S.a_ready(nxt);
            if constexpr (SP2) {
            PG8_LDB(B0, 0, 0); PG8_LDB(B1, 0, 1); PG8_SCHED; PG8_LDA(At, 0, 0); PG8_STAGE(PG8_SA(1, 1), a1 + hstep, voffA);
            PG8_WAIT_V(8); PG8_WAIT_L(0); PG8_BAR; PG8_MMA(0, 0, At, B0); PG8_MMA(0, 1, At, B1); PG8_BAR; PG8_SCHED;
            PG8_LDA(At, 0, 1); PG8_STAGE(PG8_SB(0, 0), b2, voffB); PG8_STAGE(PG8_SB(0, 1), b2 + hstep, voffB); PG8_STAGE(PG8_SA(0, 0), a2, voffA);
            PG8_WAIT_V(8); PG8_WAIT_L(0); PG8_BAR; PG8_MMA(1, 0, At, B0); PG8_MMA(1, 1, At, B1); PG8_BAR; PG8_SCHED;
            PG8_LDB(B0, 1, 0); PG8_LDB(B1, 1, 1); PG8_SCHED; PG8_LDA(At, 1, 0); PG8_STAGE(PG8_SA(0, 1), a2 + hstep, voffA);
            PG8_WAIT_V(8); PG8_WAIT_L(0); PG8_BAR; PG8_MMA(0, 0, At, B0); PG8_MMA(0, 1, At, B1); PG8_BAR; PG8_SCHED;
            PG8_LDA(At, 1, 1); PG8_STAGE(PG8_SB(1, 0), b3, voffB); PG8_STAGE(PG8_SB(1, 1), b3 + hstep, voffB); PG8_STAGE(PG8_SA(1, 0), a3, voffA);
            PG8_WAIT_V(8); PG8_WAIT_L(0); PG8_BAR; PG8_MMA(1, 0, At, B0); PG8_MMA(1, 1, At, B1); PG8_BAR; PG8_SCHED;
            } else {
            PG8_LDB(B0, 0, 0); PG8_SCHED; PG8_LDA(At, 0, 0); PG8_STAGE(PG8_SA(1, 1), a1 + hstep, voffA);
            PG8_WAIT_L(8); PG8_BAR; PG8_WAIT_L(0); PG8_MMA(0, 0, At, B0); PG8_BAR; PG8_SCHED;
            PG8_LDB(B1, 0, 1); PG8_STAGE(PG8_SB(0, 0), b2, voffB);
            PG8_BAR; PG8_WAIT_L(0); PG8_MMA(0, 1, At, B1); PG8_BAR;
            PG8_LDA(At, 0, 1); PG8_STAGE(PG8_SA(0, 0), a2, voffA);
            PG8_BAR; PG8_WAIT_L(0); PG8_MMA(1, 0, At, B0); PG8_BAR; PG8_SCHED;
            PG8_STAGE(PG8_SB(0, 1), b2 + hstep, voffB);
            PG8_WAIT_V(6); PG8_BAR; PG8_MMA(1, 1, At, B1); PG8_BAR;
            PG8_LDB(B0, 1, 0); PG8_SCHED; PG8_LDA(At, 1, 0); PG8_STAGE(PG8_SA(0, 1), a2 + hstep, voffA);
            PG8_WAIT_L(8); PG8_BAR; PG8_WAIT_L(0); PG8_MMA(0, 0, At, B0); PG8_BAR; PG8_SCHED;
            PG8_LDB(B1, 1, 1); PG8_STAGE(PG8_SB(1, 0), b3, voffB);
            PG8_BAR; PG8_WAIT_L(0); PG8_MMA(0, 1, At, B1); PG8_BAR;
            PG8_LDA(At, 1, 1); PG8_STAGE(PG8_SA(1, 0), a3, voffA);
            PG8_BAR; PG8_WAIT_L(0); PG8_MMA(1, 0, At, B0); PG8_BAR; PG8_SCHED;
            PG8_STAGE(PG8_SB(1, 1), b3 + hstep, voffB);
            PG8_WAIT_V(6); PG8_BAR; PG8_MMA(1, 1, At, B1); PG8_BAR;
            }
        }
        if constexpr (ALIGN_EPI) { if (wr == 0) PG8_BAR; }
        if constexpr (!Epi::AFTER_DRAIN) { E(acc, cur, wr, wc, fr, fq); S.done(cur); }
        if (!has_next) break;
#pragma unroll
        for (int a = 0; a < 2; ++a)
#pragma unroll
            for (int b = 0; b < 2; ++b)
#pragma unroll
                for (int m = 0; m < 4; ++m)
#pragma unroll
                    for (int n = 0; n < 2; ++n) acc[a][b][m][n] = (f32x4){0.f, 0.f, 0.f, 0.f};
        cur = nxt; cA = nA; cB = nB; ++ui;
        if constexpr (ALIGN_EPI) { if (wr == 1) PG8_BAR; }
    }
    PG8_WAIT_V(0);
    if constexpr (!ALIGN_EPI) { if (wr == 0) PG8_BAR; }
    PG8_BAR;
    if constexpr (Epi::AFTER_DRAIN) { E.fused(acc, cur, wr, wc, fr, fq, lds, wid, lane); S.done(cur); }
#undef PG8_SA
#undef PG8_SB
#undef PG8_STAGE
#undef PG8_LDA
#undef PG8_LDB
#undef PG8_MMA
#undef PG8_WAIT_V
#undef PG8_WAIT_L
#undef PG8_BAR
#undef PG8_SCHED
}
}

namespace pg8 {
struct EpiBf16Plain {
    static constexpr bool PERM = true, AFTER_DRAIN = false;
    bf16_t* O; int ldc;
    __device__ __forceinline__ void operator()(const f32x4 (&acc)[2][2][4][2], const Unit& u, int wr, int wc, int fr, int fq) const {
        const int row0 = u.pm * BM + wr * 64 + fr; const int col0 = u.pn * BM + wc * 32 + 8 * fq;
#pragma unroll
        for (int ai = 0; ai < 2; ++ai)
#pragma unroll
            for (int m = 0; m < 4; ++m) { bf16_t* rowp = O + (size_t)(row0 + ai * HALF + m * 16) * ldc + col0;
#pragma unroll
                for (int bj = 0; bj < 2; ++bj) { const f32x4 v0 = acc[ai][bj][m][0], v1 = acc[ai][bj][m][1];
                    u32x4 w; w.x = cvt_pk_bf16(v0[0], v0[1]); w.y = cvt_pk_bf16(v0[2], v0[3]); w.z = cvt_pk_bf16(v1[0], v1[1]); w.w = cvt_pk_bf16(v1[2], v1[3]);
                    *(u32x4*)(rowp + bj * HALF) = w; } }
    }
};
}

namespace pg8 {
__device__ __forceinline__ float sigm(float x) { return __builtin_amdgcn_rcpf(1.f + __expf(-x)); }
struct EpiSwiGLU {
    static constexpr bool PERM = true, AFTER_DRAIN = false;
    bf16_t* O; int ldc; const float* rs;
    __device__ __forceinline__ void operator()(const f32x4 (&acc)[2][2][4][2], const Unit& u, int wr, int wc, int fr, int fq) const {
        const int row0 = u.pm * BM + wr * 64 + fr; const int col0 = u.pn * HALF + wc * 32 + 8 * fq;
#pragma unroll
        for (int ai = 0; ai < 2; ++ai)
#pragma unroll
            for (int m = 0; m < 4; ++m) { bf16_t* rowp = O + (size_t)(row0 + ai * HALF + m * 16) * ldc + col0; float v[8]; const float r = rs[row0 + ai * HALF + m * 16];
#pragma unroll
                for (int n = 0; n < 2; ++n)
#pragma unroll
                    for (int e = 0; e < 4; ++e) { const float g = acc[ai][0][m][n][e] * r, up = acc[ai][1][m][n][e] * r; v[4 * n + e] = g * sigm(g) * up; }
                u32x4 w; w.x = cvt_pk_bf16(v[0], v[1]); w.y = cvt_pk_bf16(v[2], v[3]); w.z = cvt_pk_bf16(v[4], v[5]); w.w = cvt_pk_bf16(v[6], v[7]);
                *(u32x4*)rowp = w; }
    }
};
struct EpiGateF32 {
    static constexpr bool PERM = true, AFTER_DRAIN = false;
    bf16_t* Y; int ldc; const bf16_t* G; int ldg;
    __device__ __forceinline__ void operator()(const f32x4 (&acc)[2][2][4][2], const Unit& u, int wr, int wc, int fr, int fq) const {
        const int row0 = u.pm * BM + wr * 64 + fr; const int col0 = u.pn * BM + wc * 32 + 8 * fq;
#pragma unroll
        for (int ai = 0; ai < 2; ++ai)
#pragma unroll
            for (int m = 0; m < 4; ++m) { const size_t r = (size_t)(row0 + ai * HALF + m * 16);
#pragma unroll
                for (int bj = 0; bj < 2; ++bj) { const u32x4 g = *(const u32x4*)(G + r * ldg + col0 + bj * HALF); f32x4 o0, o1;
#pragma unroll
                    for (int e = 0; e < 2; ++e) { o0[2 * e] = sigm(__uint_as_float(g[e] << 16)) * acc[ai][bj][m][0][2 * e]; o0[2 * e + 1] = sigm(__uint_as_float(g[e] & 0xffff0000u)) * acc[ai][bj][m][0][2 * e + 1];
                        o1[2 * e] = sigm(__uint_as_float(g[2 + e] << 16)) * acc[ai][bj][m][1][2 * e]; o1[2 * e + 1] = sigm(__uint_as_float(g[2 + e] & 0xffff0000u)) * acc[ai][bj][m][1][2 * e + 1]; }
                    u32x4 w; w.x = cvt_pk_bf16(o0[0], o0[1]); w.y = cvt_pk_bf16(o0[2], o0[3]); w.z = cvt_pk_bf16(o1[0], o1[1]); w.w = cvt_pk_bf16(o1[2], o1[3]);
                    *(u32x4*)(Y + r * ldc + col0 + bj * HALF) = w; } }
    }
};
struct EpiMergeBf16 {
    static constexpr bool PERM = true, AFTER_DRAIN = false;
    bf16_t* O; int ldc; const bf16_t* Y; const bf16_t* G; int ldg;
    __device__ __forceinline__ void operator()(const f32x4 (&acc)[2][2][4][2], const Unit& u, int wr, int wc, int fr, int fq) const {
        const int row0 = u.pm * BM + wr * 64 + fr; const int col0 = u.pn * BM + wc * 32 + 8 * fq;
#pragma unroll
        for (int ai = 0; ai < 2; ++ai)
#pragma unroll
            for (int m = 0; m < 4; ++m) { const size_t r = (size_t)(row0 + ai * HALF + m * 16);
#pragma unroll
                for (int bj = 0; bj < 2; ++bj) { const u32x4 g = *(const u32x4*)(G + r * ldg + col0 + bj * HALF); const u32x4 yw = *(const u32x4*)(Y + r * ldc + col0 + bj * HALF); const f32x4 y0 = {__uint_as_float(yw[0] << 16), __uint_as_float(yw[0] & 0xffff0000u), __uint_as_float(yw[1] << 16), __uint_as_float(yw[1] & 0xffff0000u)}, y1 = {__uint_as_float(yw[2] << 16), __uint_as_float(yw[2] & 0xffff0000u), __uint_as_float(yw[3] << 16), __uint_as_float(yw[3] & 0xffff0000u)}; f32x4 o0, o1;
#pragma unroll
                    for (int e = 0; e < 2; ++e) { o0[2 * e] = y0[2 * e] + sigm(__uint_as_float(g[e] << 16)) * acc[ai][bj][m][0][2 * e]; o0[2 * e + 1] = y0[2 * e + 1] + sigm(__uint_as_float(g[e] & 0xffff0000u)) * acc[ai][bj][m][0][2 * e + 1];
                        o1[2 * e] = y1[2 * e] + sigm(__uint_as_float(g[2 + e] << 16)) * acc[ai][bj][m][1][2 * e]; o1[2 * e + 1] = y1[2 * e + 1] + sigm(__uint_as_float(g[2 + e] & 0xffff0000u)) * acc[ai][bj][m][1][2 * e + 1]; }
                    u32x4 w; w.x = cvt_pk_bf16(o0[0], o0[1]); w.y = cvt_pk_bf16(o0[2], o0[3]); w.z = cvt_pk_bf16(o1[0], o1[1]); w.w = cvt_pk_bf16(o1[2], o1[3]);
                    *(u32x4*)(O + r * ldc + col0 + bj * HALF) = w; } }
    }
};
}

namespace pg8 {
struct EpiIn {
    static constexpr bool PERM = true, AFTER_DRAIN = false;
    bf16_t* O; int ldc; const float* CS; const float* SN; float* KS;
    __device__ __forceinline__ void operator()(const f32x4 (&acc)[2][2][4][2], const Unit& u, int wr, int wc, int fr_, int fq_) const {
        int fr = fr_, fq = fq_; asm volatile("" : "+v"(fr), "+v"(fq));
        const int row0 = u.pm * BM + wr * 64 + fr; const int col0 = u.pn * BM + wc * 32 + 8 * fq;
        if (u.pn >= 16) {
#pragma unroll
            for (int ai = 0; ai < 2; ++ai)
#pragma unroll
                for (int m = 0; m < 4; ++m) { bf16_t* rowp = O + (size_t)(row0 + ai * HALF + m * 16) * ldc + col0;
#pragma unroll
                    for (int bj = 0; bj < 2; ++bj) { const f32x4 v0 = acc[ai][bj][m][0], v1 = acc[ai][bj][m][1];
                        u32x4 w; w.x = cvt_pk_bf16(v0[0], v0[1]); w.y = cvt_pk_bf16(v0[2], v0[3]); w.z = cvt_pk_bf16(v1[0], v1[1]); w.w = cvt_pk_bf16(v1[2], v1[3]);
                        *(u32x4*)(rowp + bj * HALF) = w; } }
        } else {
            const int q4 = 4 * (4 * wc + fq);
            f32x4 s1[2] = {(f32x4){0.f, 0.f, 0.f, 0.f}, (f32x4){0.f, 0.f, 0.f, 0.f}}, s2[2] = {(f32x4){0.f, 0.f, 0.f, 0.f}, (f32x4){0.f, 0.f, 0.f, 0.f}};
#pragma unroll
            for (int ai = 0; ai < 2; ++ai)
#pragma unroll
                for (int m = 0; m < 4; ++m) { int row = row0 + ai * HALF + m * 16; asm volatile("" : "+v"(row));
                    const int pos = row & 2047;
                    const f32x4 cs = *(const f32x4*)(CS + (unsigned)(pos * 64 + q4)), sn = *(const f32x4*)(SN + (unsigned)(pos * 64 + q4));
                    bf16_t* rowp = O + ((unsigned)row * (unsigned)ldc + (unsigned)col0);
#pragma unroll
                    for (int bj = 0; bj < 2; ++bj) { const f32x4 x1 = acc[ai][bj][m][0], x2 = acc[ai][bj][m][1]; const f32x4 o1 = x1 * cs - x2 * sn, o2 = x2 * cs + x1 * sn;
                        s1[bj] += o1; s2[bj] += o2;
                        u32x4 w; w.x = cvt_pk_bf16(o1[0], o1[1]); w.y = cvt_pk_bf16(o1[2], o1[3]); w.z = cvt_pk_bf16(o2[0], o2[1]); w.w = cvt_pk_bf16(o2[2], o2[3]);
                        *(u32x4*)(rowp + bj * HALF) = w; }
                    asm volatile("" : "+v"(s1[0]), "+v"(s1[1]), "+v"(s2[0]), "+v"(s2[1]) :: "memory"); }
            if (u.pn >= 8) {
#pragma unroll
                for (int bj = 0; bj < 2; ++bj)
#pragma unroll
                    for (int e = 0; e < 4; ++e) { float a = s1[bj][e], b = s2[bj][e];
#pragma unroll
                        for (int o = 1; o < 16; o <<= 1) { a += __shfl_xor(a, o); b += __shfl_xor(b, o); }
                        s1[bj][e] = a; s2[bj][e] = b; }
                if (fr == 0) { const int b = u.pm >> 3, blk = u.pm & 7;
#pragma unroll
                    for (int bj = 0; bj < 2; ++bj) { const int hd = (u.pn - 8) * 2 + bj; float* kp = KS + (size_t)(((b * 16 + hd) * 8 + blk) * 128 + wc * 32 + 8 * fq);
#pragma unroll
                        for (int e = 0; e < 4; ++e) { atomicAdd(kp + e, s1[bj][e]); atomicAdd(kp + 4 + e, s2[bj][e]); } } }
            }
        }
    }
};
}

typedef unsigned short bf16_t;
#define LAS __attribute__((address_space(3)))
#define LDS_WAIT() asm volatile("s_waitcnt lgkmcnt(0)" ::: "memory")
__device__ __forceinline__ float bf2f(bf16_t b) { return __uint_as_float(((unsigned)b) << 16); }
__device__ __forceinline__ unsigned f2bf(float f) { unsigned u = __float_as_uint(f); return (u + 0x7fffu + ((u >> 16) & 1u)) >> 16; }
__device__ __forceinline__ unsigned pk2(float lo, float hi) { return f2bf(lo) | (f2bf(hi) << 16); }
__device__ __forceinline__ float wave_sum(float v) {
#pragma unroll
    for (int o = 1; o < 64; o <<= 1) v += __shfl_xor(v, o);
    return v;
}
__device__ __forceinline__ float wave_max(float v) {
#pragma unroll
    for (int o = 1; o < 64; o <<= 1) v = fmaxf(v, __shfl_xor(v, o));
    return v;
}
__device__ __forceinline__ float sigmoidf_(float x) { return __builtin_amdgcn_rcpf(1.f + __expf(-x)); }
__device__ __forceinline__ float siluf_(float x) { return x * __builtin_amdgcn_rcpf(1.f + __expf(-x)); }

#define XB_TMO      128
#define XB_XCNT(j)  (256  + 64 * (j))
#define XB_XSUB(j)  (1280 + 64 * (j))
#define XB_XGEN(j)  (2304 + 64 * (j))
#define XB_TOP      3328
#define XB_TOPGEN   3392
#define XCD_BAR_WORDS 3456
#define XB_SPIN_CAP (1u << 18)

__device__ __forceinline__ unsigned xb_ld(unsigned* p)              { return __hip_atomic_load(p, __ATOMIC_RELAXED, __HIP_MEMORY_SCOPE_AGENT); }
__device__ __forceinline__ unsigned xb_add(unsigned* p, unsigned v) { return __hip_atomic_fetch_add(p, v, __ATOMIC_RELAXED, __HIP_MEMORY_SCOPE_AGENT); }
__device__ __forceinline__ unsigned xb_xcc_id() { return (unsigned)__builtin_amdgcn_s_getreg((3 << 11) | 20) & 0xFu; }
#define XB_SPIN(cond, bar) do { unsigned _sp = 0; while (cond) { __builtin_amdgcn_s_sleep(1); \
    if ((++_sp & 255u) == 0u) { if (xb_ld(&(bar)[XB_TMO])) break; if (_sp > XB_SPIN_CAP) { atomicAdd(&(bar)[XB_TMO], 1u); break; } } } } while (0)

struct XcdBarrier {
    unsigned* bar; unsigned x;
    volatile LAS unsigned* st;
};

__device__ __forceinline__ XcdBarrier xcd_barrier_post(unsigned* bar, volatile LAS unsigned* st) {
    XcdBarrier b; b.bar = bar; b.x = xb_xcc_id(); b.st = st;
    if (threadIdx.x == 0) (void)xb_add(&bar[XB_XCNT(b.x)], 1u);
    return b;
}
__device__ __forceinline__ void xcd_barrier_complete(unsigned* bar, unsigned x, unsigned& nloc, unsigned& nx) {
    const unsigned G = gridDim.x * gridDim.y * gridDim.z;
    unsigned sum, cnt, mine, sp = 0u;
    for (;;) {
        sum = 0u; cnt = 0u; mine = 0u;
#pragma unroll
        for (unsigned j = 0; j < 16; ++j) { const unsigned c = xb_ld(&bar[XB_XCNT(j)]); sum += c; cnt += (c > 0u) ? 1u : 0u; mine = (j == x) ? c : mine; }
        if (sum == G) break;
        __builtin_amdgcn_s_sleep(1);
        if ((++sp & 255u) == 0u) { if (xb_ld(&bar[XB_TMO])) break; if (sp > XB_SPIN_CAP) { atomicAdd(&bar[XB_TMO], 1u); break; } }
    }
    nloc = mine > 0u ? mine : 1u; nx = cnt > 0u ? cnt : 1u;
}

__device__ __forceinline__ void xcd_barrier(const XcdBarrier& b) {
    asm volatile("s_waitcnt vmcnt(0)" ::: "memory");
    __syncthreads();
    if (threadIdx.x == 0) {
        unsigned* bar = b.bar;
        __builtin_amdgcn_s_waitcnt(0);
        unsigned nloc = b.st[0], nx = b.st[1];
        if (nloc == 0u) { xcd_barrier_complete(bar, b.x, nloc, nx); b.st[0] = nloc; b.st[1] = nx; }
        const unsigned old = xb_add(&bar[XB_XSUB(b.x)], 1u);
        const unsigned gen = old / nloc;
        if (old + 1u == (gen + 1u) * nloc) {
            __builtin_amdgcn_fence(__ATOMIC_RELEASE, "agent");
            asm volatile("s_waitcnt vmcnt(0)" ::: "memory");
            const unsigned og = xb_add(&bar[XB_TOP], 1u);
            const unsigned tg = og / nx;
            if (og + 1u == (tg + 1u) * nx) xb_add(&bar[XB_TOPGEN], 1u);
            else XB_SPIN(xb_ld(&bar[XB_TOPGEN]) == tg, bar);
            __builtin_amdgcn_fence(__ATOMIC_ACQUIRE, "agent");
            xb_add(&bar[XB_XGEN(b.x)], 1u);
            asm volatile("s_waitcnt vmcnt(0)" ::: "memory");
        } else {
            XB_SPIN(xb_ld(&bar[XB_XGEN(b.x)]) == gen, bar);
            __builtin_amdgcn_fence(__ATOMIC_ACQUIRE, "agent");
            asm volatile("s_waitcnt vmcnt(0)" ::: "memory");
        }
    }
    __syncthreads();
}

namespace mb {
using bf16x8 = __attribute__((ext_vector_type(8))) short;
using s16x4  = __attribute__((ext_vector_type(4))) short;
using f32x16 = __attribute__((ext_vector_type(16))) float;
using u32x4  = __attribute__((ext_vector_type(4))) unsigned;
constexpr int   D = 128, NW = 8, QBLK = 32, KVBLK = 64, LD = 26624  , LDO = 2048  ;
constexpr float SCALE = 0.088388347648318440f, THR = 8.f, NEG = -1e30f;
constexpr int SHM_V = KVBLK * D * 2, SHM_K = KVBLK * D * 2, SHM_ATTN = 2 * SHM_V + 2 * SHM_K + NW * 64 * 4;
#define KSWZ(row, colB) ((row) * 256 + ((colB) ^ (((row) & 7) << 4)))
#define SBAR() __builtin_amdgcn_sched_barrier(0)
__device__ __forceinline__ int crow(int r, int hi) { return (r & 3) + 8 * (r >> 2) + 4 * hi; }
__device__ __forceinline__ unsigned cvtpk(float lo, float hi) { typedef __bf16 bf2_ __attribute__((ext_vector_type(2))); typedef float f2_ __attribute__((ext_vector_type(2))); const f2_ f = {lo, hi}; return __builtin_bit_cast(unsigned, __builtin_convertvector(f, bf2_)); }
__device__ __forceinline__ void partialSM(f32x16& p0, f32x16& p1, float& m_reg, float& mn, float& alpha) {
  constexpr float C = SCALE * 1.4426950408889634f;
  float pmax = p0[0]; for (int r = 1; r < 16; ++r) pmax = fmaxf(pmax, p0[r]); for (int r = 0; r < 16; ++r) pmax = fmaxf(pmax, p1[r]);
  { auto rr = __builtin_amdgcn_permlane32_swap(__float_as_uint(pmax), __float_as_uint(pmax), false, false);
    pmax = fmaxf(__uint_as_float(rr[0]), __uint_as_float(rr[1])); }
  if (__builtin_expect(__all(pmax - m_reg <= THR / SCALE), 1)) { mn = m_reg; alpha = 1.f; }
  else { mn = fmaxf(m_reg, pmax); alpha = __builtin_amdgcn_exp2f((m_reg - mn) * C); m_reg = mn; }
  float mnC = -mn * C;
  for (int r = 0; r < 16; ++r) p0[r] = fmaf(p0[r], C, mnC); for (int r = 0; r < 16; ++r) p1[r] = fmaf(p1[r], C, mnC);
  for (int r = 0; r < 16; ++r) p0[r] = __builtin_amdgcn_exp2f(p0[r]);
}
__device__ __forceinline__ void finishSM(f32x16& p0, f32x16& p1, float alpha, float& l_reg, bf16x8& pa0, bf16x8& pa1, bf16x8& pa2, bf16x8& pa3) {
  for (int r = 0; r < 16; ++r) p1[r] = __builtin_amdgcn_exp2f(p1[r]);
  float ps = 0; for (int r = 0; r < 16; ++r) ps += p0[r]; for (int r = 0; r < 16; ++r) ps += p1[r];
  { auto rr = __builtin_amdgcn_permlane32_swap(__float_as_uint(ps), __float_as_uint(ps), false, false);
    ps = __uint_as_float(rr[0]) + __uint_as_float(rr[1]); }
  l_reg = l_reg * alpha + ps;
#define PK4(P, BASE, OUT) do { unsigned a0 = cvtpk(P[BASE + 0], P[BASE + 1]), a1 = cvtpk(P[BASE + 2], P[BASE + 3]);   \
    unsigned b0 = cvtpk(P[BASE + 4], P[BASE + 5]), b1 = cvtpk(P[BASE + 6], P[BASE + 7]);                              \
    auto r0 = __builtin_amdgcn_permlane32_swap(a0, b0, false, false); auto r1 = __builtin_amdgcn_permlane32_swap(a1, b1, false, false); \
    u32x4 w = {r0[0], r1[0], r0[1], r1[1]}; OUT = *reinterpret_cast<bf16x8*>(&w); } while (0)
  PK4(p0, 0, pa0); PK4(p0, 8, pa1); PK4(p1, 0, pa2); PK4(p1, 8, pa3);
#undef PK4
}
__device__ __forceinline__ void qkt(f32x16& p0, f32x16& p1, const char* Ks, const bf16x8* qr, const int (&kb4)[4]) {
  p0 = f32x16{}; p1 = f32x16{};
#pragma unroll
  for (int d0 = 0; d0 < 8; ++d0) {
    bf16x8 b0 = *reinterpret_cast<const bf16x8*>(Ks + kb4[d0 & 3] + (d0 >> 2) * 128);
    bf16x8 b1 = *reinterpret_cast<const bf16x8*>(Ks + kb4[d0 & 3] + (d0 >> 2) * 128 + 32 * 256);
    p0 = __builtin_amdgcn_mfma_f32_32x32x16_bf16(b0, qr[d0], p0, 0, 0, 0);
    p1 = __builtin_amdgcn_mfma_f32_32x32x16_bf16(b1, qr[d0], p1, 0, 0, 0); }
}
__device__ __forceinline__ int v_st(int k, int c) { const int kk = (k & ~0xC) | ((k & 4) << 1) | ((k & 8) >> 1); return ((kk >> 3) * 4 + (c >> 5)) * 512 + ((kk & 7) * 32 + (c & 31)) * 2; }
__device__ __forceinline__ int v_rd_base(int lane) { return ((lane & 3) << 3) | (((lane >> 2) & 3) << 6) | (((lane >> 4) & 1) << 5) | (((lane >> 5) & 1) << 8); }
constexpr int v_rd_off(int d0, int ks, int half) { return d0 * 512 + ks * 4096 + half * 2048; }
template <int OFF> __device__ __forceinline__ s16x4 tr_read(int vb) {
  s16x4 r; asm volatile("ds_read_b64_tr_b16 %0, %1 offset:%2" : "=&v"(r) : "v"(vb), "i"(OFF) : "memory"); return r;
}
template <int D0> __device__ __forceinline__ void pv_one(f32x16& od, int vb, bf16x8 pa0, bf16x8 pa1, bf16x8 pa2, bf16x8 pa3) {
  const s16x4 l0 = tr_read<v_rd_off(D0, 0, 0)>(vb), h0 = tr_read<v_rd_off(D0, 0, 1)>(vb), l1 = tr_read<v_rd_off(D0, 1, 0)>(vb), h1 = tr_read<v_rd_off(D0, 1, 1)>(vb);
  const s16x4 l2 = tr_read<v_rd_off(D0, 2, 0)>(vb), h2 = tr_read<v_rd_off(D0, 2, 1)>(vb), l3 = tr_read<v_rd_off(D0, 3, 0)>(vb), h3 = tr_read<v_rd_off(D0, 3, 1)>(vb);
  asm volatile("s_waitcnt lgkmcnt(0)" ::: "memory"); SBAR();
#define PK(L, H) (bf16x8){L[0], L[1], L[2], L[3], H[0], H[1], H[2], H[3]}
  od = __builtin_amdgcn_mfma_f32_32x32x16_bf16(pa0, PK(l0, h0), od, 0, 0, 0);
  od = __builtin_amdgcn_mfma_f32_32x32x16_bf16(pa1, PK(l1, h1), od, 0, 0, 0);
  od = __builtin_amdgcn_mfma_f32_32x32x16_bf16(pa2, PK(l2, h2), od, 0, 0, 0);
  od = __builtin_amdgcn_mfma_f32_32x32x16_bf16(pa3, PK(l3, h3), od, 0, 0, 0);
#undef PK
}
__device__ __forceinline__ void pv_d0(f32x16* o, int vb, bf16x8 pa0, bf16x8 pa1, bf16x8 pa2, bf16x8 pa3) {
  pv_one<0>(o[0], vb, pa0, pa1, pa2, pa3); pv_one<1>(o[1], vb, pa0, pa1, pa2, pa3); pv_one<2>(o[2], vb, pa0, pa1, pa2, pa3); pv_one<3>(o[3], vb, pa0, pa1, pa2, pa3);
}
__device__ __forceinline__ int key0(int j, int qb) { return j < 4 ? qb * 256 + j * 64 : ((j - 4) >> 2) * 256 + ((j - 4) & 3) * 64; }
__device__ __forceinline__ void mask_tile(f32x16& p0, f32x16& p1, int j, unsigned selmask, int rowb, int hi) {
  int rb = rowb; asm volatile("" : "+v"(rb));
  const int lim = (j < 4) ? (rb - 64 * j) : (((selmask >> ((j - 4) >> 2)) & 1u) ? 4096 : -4096);
  if (__all(lim >= 63)) return;
  const int limh = lim - 4 * hi;
#pragma unroll
  for (int r = 0; r < 16; ++r) { const int cr = (r & 3) + 8 * (r >> 2); p0[r] = (cr > limh) ? NEG : p0[r]; p1[r] = (cr + 32 > limh) ? NEG : p1[r]; }
}
__device__ __forceinline__ void moba_unit(const unsigned short* __restrict__ Qb, const unsigned short* __restrict__ Kh, const unsigned short* __restrict__ Vh,
                                          unsigned short* __restrict__ Ob, const float* __restrict__ KS, int qb, char* lds) {
  int tid_ = threadIdx.x; asm volatile("" : "+v"(tid_));
  const int tid = tid_, wid = tid >> 6, lane = tid & 63, r32 = lane & 31, hi = lane >> 5;
  char* V_lds = lds; char* K_lds = lds + 2 * SHM_V;
  float* ws = (float*)(lds + 2 * SHM_V + 2 * SHM_K) + wid * 64; float* li_l = ws; float* al_l = ws + 32;
  float m_reg = NEG, l_reg = 0; f32x16 o[4] = {}; bf16x8 qr[8];
  const unsigned short* Qw = Qb + (long)(wid * QBLK + r32) * LD + hi * 8;
#pragma unroll
  for (int d0 = 0; d0 < 8; ++d0) qr[d0] = *reinterpret_cast<const bf16x8*>(Qw + d0 * 16);
  unsigned selmask = 0u;
  {
    float gate[8];
#pragma unroll
    for (int n = 0; n < 8; ++n) { float g = 0.f;
      if (n < qb) {
#pragma unroll
        for (int d0 = 0; d0 < 8; ++d0) { const float4 k0 = *(const float4*)(KS + n * 128 + d0 * 16 + hi * 8), k1 = *(const float4*)(KS + n * 128 + d0 * 16 + hi * 8 + 4);
          const u32x4 qw = *reinterpret_cast<const u32x4*>(&qr[d0]);
          g += __uint_as_float(qw[0] << 16) * k0.x + __uint_as_float(qw[0] & 0xffff0000u) * k0.y + __uint_as_float(qw[1] << 16) * k0.z + __uint_as_float(qw[1] & 0xffff0000u) * k0.w
             + __uint_as_float(qw[2] << 16) * k1.x + __uint_as_float(qw[2] & 0xffff0000u) * k1.y + __uint_as_float(qw[3] << 16) * k1.z + __uint_as_float(qw[3] & 0xffff0000u) * k1.w; }
        g += __shfl_xor(g, 32); }
      gate[n] = (n < qb) ? g : -INFINITY; }
#pragma unroll
    for (int r = 0; r < 3; ++r) { float best = -INFINITY; int bi = -1;
#pragma unroll
      for (int n = 0; n < 8; ++n) { const bool ok = !((selmask >> n) & 1u) && gate[n] > best; if (ok) { best = gate[n]; bi = n; } }
      if (bi >= 0) selmask |= 1u << bi; }
  }
  const int rowb = wid * QBLK + r32;
  int kb4[4];
#pragma unroll
  for (int q = 0; q < 4; ++q) kb4[q] = r32 * 256 + (((q << 5) | (hi << 4)) ^ ((r32 & 7) << 4));
  const int sr = tid >> 4, sc = (tid & 15) * 8, vst0 = v_st(sr, sc), vst1 = v_st(32 + sr, sc);
  const int vb0 = (int)(uintptr_t)V_lds + v_rd_base(lane);
  struct { bf16x8 vs0, vs1, ks0, ks1; } sr_[1];
  const unsigned voff = (unsigned)((sr * LD + sc) * 2);
#define SLOAD(i, k0) do { const char* vb_ = (const char*)Vh + (size_t)(k0) * (LD * 2); const char* kb_ = (const char*)Kh + (size_t)(k0) * (LD * 2); \
    sr_[i].vs0 = *reinterpret_cast<const bf16x8*>(vb_ + voff); sr_[i].vs1 = *reinterpret_cast<const bf16x8*>(vb_ + 32 * LD * 2 + voff); \
    sr_[i].ks0 = *reinterpret_cast<const bf16x8*>(kb_ + voff); sr_[i].ks1 = *reinterpret_cast<const bf16x8*>(kb_ + 32 * LD * 2 + voff); } while (0)
#define SWRITE(b, i) do { *(bf16x8*)(V_lds + (b) * SHM_V + vst0) = sr_[i].vs0;          \
    *(bf16x8*)(V_lds + (b) * SHM_V + vst1) = sr_[i].vs1; int kc = sc * 2;               \
    *(bf16x8*)(K_lds + (b) * SHM_K + KSWZ(sr, kc)) = sr_[i].ks0;                       \
    *(bf16x8*)(K_lds + (b) * SHM_K + KSWZ(32 + sr, kc)) = sr_[i].ks1; } while (0)
#define SWAIT() asm volatile("s_waitcnt vmcnt(0)" ::: "memory")
#define RESC(a) do { if (__any((a) < 1.f)) { if (hi == 0) al_l[r32] = (a); asm volatile("s_waitcnt lgkmcnt(0)" ::: "memory"); \
    for (int d = 0; d < 4; ++d) for (int r = 0; r < 16; ++r) o[d][r] *= al_l[crow(r, hi)]; } } while (0)
  f32x16 pA0, pA1, pB0, pB1; float mnA, mnB, alA, alB; bf16x8 pa0, pa1, pa2, pa3; const int NT = 4 * (qb + 1);
  constexpr int SE = 0, SO = 0;
  SLOAD(SE, key0(0, qb)); asm volatile("s_waitcnt vmcnt(0)" ::: "memory"); SWRITE(0, SE); __syncthreads();
  qkt(pA0, pA1, K_lds, qr, kb4); mask_tile(pA0, pA1, 0, selmask, rowb, hi); partialSM(pA0, pA1, m_reg, mnA, alA);
  SLOAD(SO, key0(1, qb));
  SWAIT(); SWRITE(1, SO); __syncthreads();
  for (int j = 1; j + 1 < NT; j += 2) {
    SBAR(); qkt(pB0, pB1, K_lds + SHM_K, qr, kb4);
    finishSM(pA0, pA1, alA, l_reg, pa0, pa1, pa2, pa3); SBAR();
    SLOAD(SO, key0(j + 1, qb)); SBAR();
    pv_d0(o, vb0, pa0, pa1, pa2, pa3); mask_tile(pB0, pB1, j, selmask, rowb, hi); partialSM(pB0, pB1, m_reg, mnB, alB);
    __syncthreads(); SWAIT(); SWRITE(0, SE);
    RESC(alB); __syncthreads();
    SBAR(); qkt(pA0, pA1, K_lds, qr, kb4);
    finishSM(pB0, pB1, alB, l_reg, pa0, pa1, pa2, pa3); SBAR();
    SLOAD(SE, key0(j + 2, qb)); SBAR();
    pv_d0(o, vb0 + (int)SHM_V, pa0, pa1, pa2, pa3); mask_tile(pA0, pA1, j + 1, selmask, rowb, hi); partialSM(pA0, pA1, m_reg, mnA, alA);
    __syncthreads(); SWAIT(); SWRITE(1, SO);
    RESC(alA); __syncthreads();
  }
  SBAR(); qkt(pB0, pB1, K_lds + SHM_K, qr, kb4);
  finishSM(pA0, pA1, alA, l_reg, pa0, pa1, pa2, pa3); SBAR();
  pv_d0(o, vb0, pa0, pa1, pa2, pa3); mask_tile(pB0, pB1, NT - 1, selmask, rowb, hi); partialSM(pB0, pB1, m_reg, mnB, alB);
  __syncthreads(); RESC(alB);
  finishSM(pB0, pB1, alB, l_reg, pa0, pa1, pa2, pa3); SBAR();
  pv_d0(o, vb0 + (int)SHM_V, pa0, pa1, pa2, pa3);
  if (hi == 0) li_l[r32] = l_reg; asm volatile("s_waitcnt lgkmcnt(0)" ::: "memory");
  float rli[16];
#pragma unroll
  for (int r = 0; r < 16; ++r) rli[r] = __builtin_amdgcn_rcpf(li_l[crow(r, hi)]);
  unsigned ooff = (unsigned)((wid * QBLK + 4 * hi) * LDO + r32); asm volatile("" : "+v"(ooff));
#pragma unroll
  for (int r = 0; r < 16; ++r) { const int cr = (r & 3) + 8 * (r >> 2);
#pragma unroll
    for (int d0 = 0; d0 < 4; ++d0) { const float v = o[d0][r] * rli[r]; unsigned u = __float_as_uint(v); u = (u + 0x7fffu + ((u >> 16) & 1u)) >> 16; Ob[ooff + (unsigned)(cr * LDO + d0 * 32)] = (unsigned short)u; } }
  asm volatile("s_waitcnt lgkmcnt(0)" ::: "memory"); __syncthreads();
#undef SLOAD
#undef SWRITE
#undef SWAIT
#undef RESC
}
#undef KSWZ
#undef SBAR
}

namespace gf {
typedef short bf16x8 __attribute__((ext_vector_type(8)));
typedef short s16x4 __attribute__((ext_vector_type(4)));
typedef float f32x4 __attribute__((ext_vector_type(4)));
typedef unsigned u32x2 __attribute__((ext_vector_type(2)));
typedef unsigned u32x4 __attribute__((ext_vector_type(4)));
#define GF_LAS __attribute__((address_space(3)))
constexpr int PK = 528, PV = 272, PJ = 144;
constexpr int L_QD = 0, L_KI = 64 * PK, L_VV = 2 * 64 * PK, L_PP = L_VV + 64 * PV, L_DEC = L_PP + 64 * PJ, L_END = L_DEC + 1024;
constexpr int L_SSX = 131072 + 1024, PSX = 144, L_RS = L_SSX + 64 * 144;
static_assert(L_END <= 131072 && L_RS + 256 <= 147456, "fused GLA LDS map");
constexpr float GF_EPS = 1e-6f;
constexpr unsigned GF_SPIN_CAP = 1u << 16;
__device__ __forceinline__ unsigned cvtpk(float lo, float hi) { typedef __bf16 bf2_ __attribute__((ext_vector_type(2))); typedef float f2_ __attribute__((ext_vector_type(2))); const f2_ f = {lo, hi}; return __builtin_bit_cast(unsigned, __builtin_convertvector(f, bf2_)); }
__device__ __forceinline__ s16x4 trrd(int addr) { s16x4 r; asm volatile("ds_read_b64_tr_b16 %0, %1" : "=&v"(r) : "v"(addr) : "memory"); return r; }
template <int OFF> __device__ __forceinline__ s16x4 trrdo(int addr) { static_assert(OFF >= 0 && OFF < 65536, "ds offset"); s16x4 r; asm volatile("ds_read_b64_tr_b16 %0, %1 offset:%2" : "=&v"(r) : "v"(addr), "n"(OFF) : "memory"); return r; }
#define GF_FRAG(base, row, pitch, kbyte) (*(const GF_LAS bf16x8*)((base) + (row) * (pitch) + (kbyte)))

__device__ __forceinline__ void fused_unit(const unsigned short* __restrict__ Qd, const unsigned short* __restrict__ Ki, const unsigned short* __restrict__ V, int ldv,
                                           const unsigned short* __restrict__ SGR, int ldsgr, const float* __restrict__ DEC, const float* __restrict__ gn, unsigned short* __restrict__ Out, int ldo,
                                           float* SSQh, int dvs, GF_LAS unsigned char* lds) {
    int tid = threadIdx.x; asm volatile("" : "+v"(tid));
    const int w = __builtin_amdgcn_readfirstlane(tid >> 6); int lane = tid & 63, l15 = lane & 15, g = lane >> 4;
    const int ldsb = (int)(unsigned)(size_t)lds;
    int tr_r = 8 * g + (l15 >> 2), tr_c = 8 * (l15 & 3);
    f32x4 S[16];
#pragma unroll
    for (int tt = 0; tt < 16; ++tt) S[tt] = (f32x4){0.f, 0.f, 0.f, 0.f};
    const f32x4 g4 = *(const f32x4*)(gn + 16 * w + 4 * g);
    u32x4 rq[4], rk[4], rv[2]; float rd = 0.f;
    unsigned vq = (unsigned)(((tid >> 5) * 2048 + 8 * (tid & 31)) * 2), vv = (unsigned)(((tid >> 4) * ldv + 8 * (tid & 15)) * 2), vs = (unsigned)((l15 * ldsgr + 4 * g) * 2), vo = (unsigned)((l15 * ldo + 4 * g) * 2);
    int lq = (tid >> 5) * PK + 16 * (tid & 31), lv = (tid >> 4) * PV + 16 * (tid & 15);
#define GF_LOAD_Q(c) do { _Pragma("unroll") for (int q = 0; q < 4; ++q) rq[q] = *(const u32x4*)((const char*)Qd + (size_t)((c) * 64 + 16 * q) * 4096 + vq); } while (0)
#define GF_LOAD_K(c) do { _Pragma("unroll") for (int q = 0; q < 4; ++q) rk[q] = *(const u32x4*)((const char*)Ki + (size_t)((c) * 64 + 16 * q) * 4096 + vq); } while (0)
#define GF_LOAD_V(c) do { _Pragma("unroll") for (int q = 0; q < 2; ++q) rv[q] = *(const u32x4*)((const char*)V + (size_t)((c) * 64 + 32 * q) * (size_t)(2 * ldv) + vv); \
        if (tid < 256) rd = *(const float*)((const char*)DEC + (size_t)((c) > 0 ? (c) - 1 : 0) * 8192 + 4u * (unsigned)tid); } while (0)
#define GF_LOAD(c) do { GF_LOAD_Q(c); GF_LOAD_K(c); GF_LOAD_V(c); } while (0)
    u32x2 ovp[4], ovq[4]; float ssp = 0.f, ssq = 0.f, pv = 0.f;
#pragma unroll
    for (int it = 0; it < 4; ++it) { ovp[it] = (u32x2){0u, 0u}; ovq[it] = (u32x2){0u, 0u}; }
#define GF_RSTD(CH_) do { const int sl_ = (lane >> 3) & 3, tk_ = 8 * w + (lane & 7); const float* sp_ = SSQh + (size_t)(CH_) * 256 + 64 * sl_ + tk_; float p_ = (sl_ == dvs) ? ssq : pv; \
        for (unsigned n_ = 0; n_ < GF_SPIN_CAP && !(p_ >= 0.f); ++n_) { __builtin_amdgcn_s_sleep(1); p_ = __hip_atomic_load(sp_, __ATOMIC_RELAXED, __HIP_MEMORY_SCOPE_AGENT); } \
        p_ = p_ + __shfl_xor(p_, 8); p_ = p_ + __shfl_xor(p_, 16); \
        if ((lane >> 3) == 0) *(GF_LAS float*)(lds + L_RS + 4 * tk_) = rsqrtf(p_ * (1.f / 512.f) + GF_EPS); } while (0)
#define GF_PUBLISH(CH_) do { if ((lane >> 3) == 0) __hip_atomic_store(SSQh + (size_t)(CH_) * 256 + 64 * dvs + 8 * w + (lane & 7), ssp, __ATOMIC_RELAXED, __HIP_MEMORY_SCOPE_AGENT); } while (0)
#define GF_PEEK(CH_) do { pv = __hip_atomic_load(SSQh + (size_t)(CH_) * 256 + 64 * ((lane >> 3) & 3) + 8 * w + (lane & 7), __ATOMIC_RELAXED, __HIP_MEMORY_SCOPE_AGENT); } while (0)
#define GF_FINAL(CH_) do { _Pragma("unroll") for (int it = 0; it < 4; ++it) { const float rs_ = *(const GF_LAS float*)(lds + L_RS + 4 * (16 * it + l15)); u32x2 o_; \
            o_.x = cvtpk(__uint_as_float(ovq[it].x << 16) * rs_, __uint_as_float(ovq[it].x & 0xffff0000u) * rs_); o_.y = cvtpk(__uint_as_float(ovq[it].y << 16) * rs_, __uint_as_float(ovq[it].y & 0xffff0000u) * rs_); \
            *(u32x2*)((char*)Out + ((size_t)((CH_) * 64 + 16 * it) * ldo + 16 * w) * 2 + vo) = o_; } } while (0)
    GF_LOAD(0);
    for (int c = 0; c < 32; ++c) {
        { int t_ = threadIdx.x; asm volatile("" : "+v"(t_)); tid = t_; lane = t_ & 63; l15 = lane & 15; g = lane >> 4; tr_r = 8 * g + (l15 >> 2); tr_c = 8 * (l15 & 3);
          vq = (unsigned)(((tid >> 5) * 2048 + 8 * (tid & 31)) * 2); vv = (unsigned)(((tid >> 4) * ldv + 8 * (tid & 15)) * 2); vs = (unsigned)((l15 * ldsgr + 4 * g) * 2); vo = (unsigned)((l15 * ldo + 4 * g) * 2);
          lq = (tid >> 5) * PK + 16 * (tid & 31); lv = (tid >> 4) * PV + 16 * (tid & 15); }
#pragma unroll
        for (int q = 0; q < 4; ++q) { *(GF_LAS u32x4*)(lds + L_QD + 16 * q * PK + lq) = rq[q]; *(GF_LAS u32x4*)(lds + L_KI + 16 * q * PK + lq) = rk[q]; }
#pragma unroll
        for (int q = 0; q < 2; ++q) *(GF_LAS u32x4*)(lds + L_VV + 32 * q * PV + lv) = rv[q];
        if (tid < 256) *(GF_LAS float*)(lds + L_DEC + 4 * tid) = rd;
        if (c > 0) GF_PUBLISH(c - 1);
        if (c > 1) GF_RSTD(c - 2);
        u32x2 sg[4];
#pragma unroll
        for (int it = 0; it < 4; ++it) sg[it] = *(const u32x2*)((const char*)SGR + ((size_t)(c * 64 + 16 * it) * ldsgr + 16 * w) * 2 + vs);
        if (c + 1 < 32) GF_LOAD_Q(c + 1);
        asm volatile("s_waitcnt lgkmcnt(0)" ::: "memory"); __syncthreads();
        if (c > 1) GF_FINAL(c - 2);
#pragma unroll
        for (int it = 0; it < 4; ++it) ovq[it] = ovp[it];
        ssq = ssp;
        { const int it = w >> 1; f32x4 pa[2] = {(f32x4){0.f, 0.f, 0.f, 0.f}, (f32x4){0.f, 0.f, 0.f, 0.f}};
          bf16x8 pq[8], pk[8][2];
#define GF_LP(k_) do { pq[k_] = GF_FRAG(lds + L_QD, 16 * it + l15, PK, 64 * (k_) + 16 * g); pk[k_][0] = GF_FRAG(lds + L_KI, 16 * (2 * (w & 1)) + l15, PK, 64 * (k_) + 16 * g); \
              pk[k_][1] = GF_FRAG(lds + L_KI, 16 * (2 * (w & 1) + 1) + l15, PK, 64 * (k_) + 16 * g); } while (0)
          GF_LP(0); GF_LP(1);
#pragma unroll
          for (int ks = 0; ks < 8; ++ks) {
              if (ks + 2 < 8) GF_LP(ks + 2);
              __builtin_amdgcn_sched_barrier(0);
#pragma unroll
              for (int jj = 0; jj < 2; ++jj) pa[jj] = __builtin_amdgcn_mfma_f32_16x16x32_bf16(pk[ks][jj], pq[ks], pa[jj], 0, 0, 0);
              __builtin_amdgcn_sched_barrier(0); }
#undef GF_LP
#pragma unroll
          for (int jj = 0; jj < 2; ++jj) { const int i = 16 * it + l15, j0 = 16 * (2 * (w & 1) + jj) + 4 * g; f32x4 v = pa[jj];
#pragma unroll
              for (int r = 0; r < 4; ++r) v[r] = (j0 + r <= i) ? v[r] : 0.f;
              u32x2 o; o.x = cvtpk(v[0], v[1]); o.y = cvtpk(v[2], v[3]); *(GF_LAS u32x2*)(lds + L_PP + i * PJ + 2 * j0) = o; } }
        if (c + 1 < 32) GF_LOAD_K(c + 1);
        asm volatile("s_waitcnt lgkmcnt(0)" ::: "memory"); __syncthreads();
        bf16x8 vf[2];
        { const int a0 = ldsb + L_VV + tr_r * PV + 2 * (16 * w) + tr_c;
          const s16x4 x0 = trrd(a0), x1 = trrd(a0 + 4 * PV), x2 = trrd(a0 + 32 * PV), x3 = trrd(a0 + 36 * PV);
          asm volatile("s_waitcnt lgkmcnt(0)" ::: "memory"); __builtin_amdgcn_sched_barrier(0);
          vf[0] = (bf16x8){x0[0], x0[1], x0[2], x0[3], x1[0], x1[1], x1[2], x1[3]}; vf[1] = (bf16x8){x2[0], x2[1], x2[2], x2[3], x3[0], x3[1], x3[2], x3[3]}; }
        f32x4 oa[4];
#pragma unroll
        for (int it = 0; it < 4; ++it) oa[it] = (f32x4){0.f, 0.f, 0.f, 0.f};
#pragma unroll
        for (int ks = 0; ks < 2; ++ks)
#pragma unroll
            for (int it = 0; it < 4; ++it) { const bf16x8 pf = GF_FRAG(lds + L_PP, 16 * it + l15, PJ, 64 * ks + 16 * g); oa[it] = __builtin_amdgcn_mfma_f32_16x16x32_bf16(vf[ks], pf, oa[it], 0, 0, 0); }
        if (c + 1 < 32) GF_LOAD_V(c + 1);
        { const int cp = c > 0 ? c - 1 : 0; GF_PEEK(cp); }
        if (c > 0) {
            u32x4 qf[8][4];
            f32x4 dq[8][2];
#define GF_LQ(s_) do { _Pragma("unroll") for (int it = 0; it < 4; ++it) { const GF_LAS unsigned char* qp = lds + L_QD + (16 * it + l15) * PK + 2 * (32 * (s_) + 4 * g); \
                const u32x2 q0 = *(const GF_LAS u32x2*)qp, q1 = *(const GF_LAS u32x2*)(qp + 32); qf[s_][it] = (u32x4){q0.x, q0.y, q1.x, q1.y}; } \
                dq[s_][0] = *(const GF_LAS f32x4*)(lds + L_DEC + 4 * (16 * (2 * (s_)) + 4 * g)); dq[s_][1] = *(const GF_LAS f32x4*)(lds + L_DEC + 4 * (16 * (2 * (s_) + 1) + 4 * g)); } while (0)
            GF_LQ(0); GF_LQ(1);
#pragma unroll
            for (int s = 0; s < 8; ++s) {
                if (s + 2 < 8) GF_LQ(s + 2);
                __builtin_amdgcn_sched_barrier(0);
                { float z_ = 0.f; asm volatile("" : "+v"(z_));
                  _Pragma("unroll") for (int h = 0; h < 2; ++h) { f32x4 t = S[2 * s + h]; const f32x4 d = dq[s][h]; t[0] = t[0] * d[0]; t[1] = __builtin_fmaf(t[1], d[1], z_); t[2] = t[2] * d[2]; t[3] = __builtin_fmaf(t[3], d[3], z_); S[2 * s + h] = t; } }
                u32x4 sw; sw.x = cvtpk(S[2 * s][0], S[2 * s][1]); sw.y = cvtpk(S[2 * s][2], S[2 * s][3]); sw.z = cvtpk(S[2 * s + 1][0], S[2 * s + 1][1]); sw.w = cvtpk(S[2 * s + 1][2], S[2 * s + 1][3]);
                const bf16x8 sf = __builtin_bit_cast(bf16x8, sw);
#pragma unroll
                for (int it = 0; it < 4; ++it) oa[it] = __builtin_amdgcn_mfma_f32_16x16x32_bf16(sf, __builtin_bit_cast(bf16x8, qf[s][it]), oa[it], 0, 0, 0);
                __builtin_amdgcn_sched_barrier(0); }
#undef GF_LQ
        }
#define GF_TR4(T4_, U_) x[U_][0] = trrdo<2 * 16 * (4 * T4_ + U_)>(a0); x[U_][1] = trrdo<2 * 16 * (4 * T4_ + U_) + 4 * PK>(a0); x[U_][2] = trrdo<2 * 16 * (4 * T4_ + U_) + 32 * PK>(a0); x[U_][3] = trrdo<2 * 16 * (4 * T4_ + U_) + 36 * PK>(a0);
#define GF_SUPD(T4_) { s16x4 x[4][4]; const int a0 = ldsb + L_KI + tr_r * PK + tr_c;         \
            GF_TR4(T4_, 0) GF_TR4(T4_, 1) GF_TR4(T4_, 2) GF_TR4(T4_, 3) \
            asm volatile("s_waitcnt lgkmcnt(0)" ::: "memory"); __builtin_amdgcn_sched_barrier(0); \
            _Pragma("unroll") for (int u = 0; u < 4; ++u) { const int tt = 4 * T4_ + u; \
                const bf16x8 k0 = (bf16x8){x[u][0][0], x[u][0][1], x[u][0][2], x[u][0][3], x[u][1][0], x[u][1][1], x[u][1][2], x[u][1][3]}, k1 = (bf16x8){x[u][2][0], x[u][2][1], x[u][2][2], x[u][2][3], x[u][3][0], x[u][3][1], x[u][3][2], x[u][3][3]}; \
                f32x4 a = S[tt]; a = __builtin_amdgcn_mfma_f32_16x16x32_bf16(k0, vf[0], a, 0, 0, 0); a = __builtin_amdgcn_mfma_f32_16x16x32_bf16(k1, vf[1], a, 0, 0, 0); S[tt] = a; } }
        GF_SUPD(0) GF_SUPD(1) GF_SUPD(2) GF_SUPD(3)
#undef GF_SUPD
#undef GF_TR4
#pragma unroll
        for (int it = 0; it < 4; ++it) { const f32x4 o = oa[it]; float sq = (o[0] * o[0] + o[1] * o[1]) + (o[2] * o[2] + o[3] * o[3]);
            *(GF_LAS float*)(lds + L_SSX + (16 * it + l15) * PSX + (4 * w + g) * 4) = sq;
            float m0 = __uint_as_float(sg[it].x << 16), m1 = __uint_as_float(sg[it].x & 0xffff0000u), m2 = __uint_as_float(sg[it].y << 16), m3 = __uint_as_float(sg[it].y & 0xffff0000u);
            m0 = m0 * __builtin_amdgcn_rcpf(1.f + __expf(-m0)); m1 = m1 * __builtin_amdgcn_rcpf(1.f + __expf(-m1)); m2 = m2 * __builtin_amdgcn_rcpf(1.f + __expf(-m2)); m3 = m3 * __builtin_amdgcn_rcpf(1.f + __expf(-m3));
            u32x2 ov; ov.x = cvtpk(o[0] * g4[0] * m0, o[1] * g4[1] * m1); ov.y = cvtpk(o[2] * g4[2] * m2, o[3] * g4[3] * m3);
            ovp[it] = ov; }
        asm volatile("s_waitcnt lgkmcnt(0)" ::: "memory"); __syncthreads();
        { float ws[8];
#pragma unroll
            for (int k = 0; k < 8; ++k) { const f32x4 a = *(const GF_LAS f32x4*)(lds + L_SSX + (8 * w + (lane & 7)) * PSX + 16 * k); ws[k] = (a[0] + a[1]) + (a[2] + a[3]); }
            ssp = ((ws[0] + ws[1]) + (ws[2] + ws[3])) + ((ws[4] + ws[5]) + (ws[6] + ws[7])); }
    }
    GF_PUBLISH(31); GF_RSTD(30);
    asm volatile("s_waitcnt lgkmcnt(0)" ::: "memory"); __syncthreads();
    GF_FINAL(30);
#pragma unroll
    for (int it = 0; it < 4; ++it) ovq[it] = ovp[it];
    ssq = ssp; pv = -1.f;
    __syncthreads();
    GF_RSTD(31);
    asm volatile("s_waitcnt lgkmcnt(0)" ::: "memory"); __syncthreads();
    GF_FINAL(31);
    __syncthreads();
#undef GF_RSTD
#undef GF_PUBLISH
#undef GF_PEEK
#undef GF_FINAL
#undef GF_LOAD
#undef GF_LOAD_Q
#undef GF_LOAD_K
#undef GF_LOAD_V
}
#undef GF_FRAG
}

constexpr int D_MODEL = 4096, BATCH = 4, SEQ = 2048, MTOK = BATCH * SEQ;
constexpr int IN_COLS = 26640, IN_PAD = 26624;
constexpr int OFF_MQ = 0, OFF_MK = 2048, OFF_MV = 4096, OFF_GQ = 6144, OFF_GK = 8192, OFF_GV = 10240, OFF_GR = 14336, OFF_SM = 18432, OFF_SG = 22528, GA_SRC = 18432  , GA_ROW = 26624  ;
constexpr int D_FF = 11008;
constexpr float EPS = 1e-6f;
constexpr int NWAVES = 8, NTHR = 512;
constexpr int WD_SPLIT = 256;
constexpr int LDS_BYTES = 147456, MISC_OFF = 131072;

struct Params {
    const float* in[15]; float* out; unsigned char* ws; unsigned* ctl;
    int ph_lo, ph_hi;
};
struct Ctx { int tid, lane, wave, G, bid; LAS unsigned char* lds; };

constexpr int CV_GK_OFF = 8 * 8448;
__device__ __forceinline__ void conv_stage_gain(const Ctx& c, const float* __restrict__ g, int K) { __syncthreads(); for (int i = c.tid; i < K; i += NTHR) *(LAS float*)(c.lds + CV_GK_OFF + 4 * i) = g[i]; __syncthreads(); }
template <int MODE, int KG = 8, bool KSC = false> __device__ __forceinline__ void conv_items(const Ctx& c, const float* __restrict__ W, int K, int N, bf16_t* __restrict__ Bt, int row_off, int u_begin = 0, int u_end = 0x7fffffff) {
    LAS unsigned* scr = (LAS unsigned*)(c.lds + c.wave * 8448);
    typedef float f4v_ __attribute__((ext_vector_type(4)));
    const int lane = c.lane, cq = lane & 15, r = lane >> 4; constexpr int NG = 8 / KG; const int nblk = (N + 63) / 64, nbg = (nblk + NG - 1) / NG, nunits_all = nbg * (K / (64 * KG)), nunits = nunits_all < u_end ? nunits_all : u_end;
#define CV_COORD(U_) const int kb_ = ((U_) / nbg) * KG + (c.wave % KG), nb_ = ((U_) % nbg) * NG + (c.wave / KG); const int k0 = kb_ * 64, n0 = nb_ * 64; const bool live = ((U_) < nunits) && (nb_ < nblk); const bool ok = (n0 + 4 * cq) < N;
  \

#define CV_LOAD(v_, U_) do { const int Uc_ = ((U_) < nunits) ? (U_) : nunits - 1; int kb_ = (Uc_ / nbg) * KG + (c.wave % KG), nb_ = (Uc_ % nbg) * NG + (c.wave / KG); nb_ = nb_ < nblk ? nb_ : nblk - 1; \
        const int k0 = kb_ * 64, n0 = nb_ * 64; const bool ok = (n0 + 4 * cq) < N; const int nc_ = ok ? (n0 + 4 * cq) : (N - 4); \
        _Pragma("unroll") for (int i = 0; i < 16; ++i) { const int kk = 8 * (i >> 1) + 2 * r + (i & 1); f4v_ t_ = __builtin_nontemporal_load((const f4v_*)(W + (size_t)(k0 + kk) * N + nc_)); \
            if (!ok) t_ = (f4v_){0.f, 0.f, 0.f, 0.f}; v_[i] = t_; } } while (0)
#define CV_PROC(v_, U_) do { CV_COORD(U_) (void)ok; if (live) { \
        _Pragma("unroll") for (int m = 0; m < 8; ++m) { const int kp = 4 * m + r;         \
            float ga_ = 1.f, gb_ = 1.f; if (KSC) { typedef float f2g_ __attribute__((ext_vector_type(2))); const f2g_ gg_ = *(const LAS f2g_*)(c.lds + CV_GK_OFF + 4 * (k0 + 2 * kp)); ga_ = gg_[0]; gb_ = gg_[1]; } \
            scr[(4 * cq + 0) * 33 + kp] = pk2(v_[2 * m][0] * ga_, v_[2 * m + 1][0] * gb_); scr[(4 * cq + 1) * 33 + kp] = pk2(v_[2 * m][1] * ga_, v_[2 * m + 1][1] * gb_); \
            scr[(4 * cq + 2) * 33 + kp] = pk2(v_[2 * m][2] * ga_, v_[2 * m + 1][2] * gb_); scr[(4 * cq + 3) * 33 + kp] = pk2(v_[2 * m][3] * ga_, v_[2 * m + 1][3] * gb_); } \
        LDS_WAIT(); asm volatile("" ::: "memory"); \
        _Pragma("unroll") for (int ps = 0; ps < 4; ++ps) { const int nn = (lane >> 2) + 16 * ps, q = lane & 3; const LAS unsigned* sp = scr + nn * 33 + 8 * q; \
            uint4 o0, o1; o0.x = sp[0]; o0.y = sp[1]; o0.z = sp[2]; o0.w = sp[3]; o1.x = sp[4]; o1.y = sp[5]; o1.z = sp[6]; o1.w = sp[7]; \
            const int n = n0 + nn; const int drow = (MODE == 0) ? (row_off + n) : (MODE == 1) ? ((n >> 7) * 256 + (n & 127) + row_off) : ((n < 4096) ? ((n & ~127) + 8 * ((n & 63) >> 2) + 4 * ((n >> 6) & 1) + (n & 3)) : (n < GA_SRC) ? n : (n < GA_SRC + 16) ? (GA_ROW + n - GA_SRC) : (n - 16)) + row_off; \
            if (n < N) { uint4* dp = (uint4*)(Bt + (size_t)drow * K + k0 + 16 * q); dp[0] = o0; dp[1] = o1; } } \
        LDS_WAIT(); asm volatile("" ::: "memory"); } } while (0)
    f4v_ va[16], vb[16];
    CV_LOAD(va, u_begin + c.bid);
    for (int U = u_begin + c.bid; U < nunits; U += 2 * c.G) {
        CV_LOAD(vb, U + c.G);
        CV_PROC(va, U);
        CV_LOAD(va, U + 2 * c.G);
        CV_PROC(vb, U + c.G);
    }
#undef CV_COORD
#undef CV_LOAD
#undef CV_PROC
}
__device__ __forceinline__ void rmsnorm_rows_bf16(const Ctx& c, const float* __restrict__ x, const float* __restrict__ g, bf16_t* __restrict__ out) {
    typedef float f4v_ __attribute__((ext_vector_type(4)));
    const int lane = c.lane, stride = c.G * NWAVES; const float4* gr = (const float4*)g + lane;
#define RN_LOAD(v_, row_) do { if ((row_) < MTOK) { const f4v_* xr = (const f4v_*)(x + (size_t)(row_) * D_MODEL) + lane; _Pragma("unroll") for (int j = 0; j < 16; ++j) v_[j] = xr[64 * j]; } } while (0)
#define RN_PROC(v_, row_) do { if ((row_) < MTOK) { float s = 0.f; \
        _Pragma("unroll") for (int j = 0; j < 16; ++j) s += v_[j][0] * v_[j][0] + v_[j][1] * v_[j][1] + v_[j][2] * v_[j][2] + v_[j][3] * v_[j][3]; \
        const float rstd = rsqrtf(wave_sum(s) * (1.f / D_MODEL) + EPS); uint2* o = (uint2*)(out + (size_t)(row_) * D_MODEL) + lane; \
        _Pragma("unroll") for (int j = 0; j < 16; ++j) { const float4 gg = gr[64 * j]; uint2 w; w.x = pk2(v_[j][0] * rstd * gg.x, v_[j][1] * rstd * gg.y); w.y = pk2(v_[j][2] * rstd * gg.z, v_[j][3] * rstd * gg.w); o[64 * j] = w; \
            if ((j & 3) == 3) asm volatile("" ::: "memory"); } } } while (0)
    f4v_ va[16], vb[16];
    const int row0 = c.bid * NWAVES + c.wave; RN_LOAD(va, row0);
    for (int row = row0; row < MTOK; row += 2 * stride) { RN_LOAD(vb, row + stride); RN_PROC(va, row); RN_LOAD(va, row + 2 * stride); RN_PROC(vb, row + stride); }
#undef RN_LOAD
#undef RN_PROC
}
__device__ __forceinline__ void rope_table_phase(const Ctx& c, float* __restrict__ CS, float* __restrict__ SN) {
    for (int i = c.bid * NTHR + c.tid; i < SEQ * 64; i += c.G * NTHR) { const int j = i & 63, pos = i >> 6;
        const float inv_freq = powf(10000.f, -(float)j / 64.f); const float ang = (float)pos * inv_freq; CS[i] = cosf(ang); SN[i] = sinf(ang); }
}
__device__ __forceinline__ void gla_prep_phase(const Ctx& c, const bf16_t* __restrict__ u, const bf16_t* __restrict__ hrows, const bf16_t* __restrict__ wga, const float* __restrict__ up, const float* __restrict__ bias, float* __restrict__ DEC,
                                               bf16_t* __restrict__ Qd, bf16_t* __restrict__ Ki) {
    LAS float* ga = (LAS float*)c.lds; LAS float* gap = ga + 1024;
    for (int item = c.bid; item < (MTOK / 64) * 2; item += c.G) { const int ci = item >> 1, col = (item & 1) * 1024 + 2 * c.tid;
        __syncthreads();
        unsigned qc[16], kc[16], qn[16], kn[16];
#define PREP_LOAD(q_, k_, tb_) do { _Pragma("unroll") for (int i = 0; i < 16; ++i) { const size_t row_ = (size_t)ci * 64 + (tb_) + i; q_[i] = *(const unsigned*)(u + row_ * IN_PAD + OFF_GQ + col); k_[i] = *(const unsigned*)(u + row_ * IN_PAD + OFF_GK + col); } } while (0)
        PREP_LOAD(qc, kc, 0);
        {
            const int mt = c.wave & 3, kh = c.wave >> 2, l15 = c.lane & 15, lq = c.lane >> 4; pg8::f32x4 a4 = {0.f, 0.f, 0.f, 0.f};
            const bf16_t* hp = hrows + (size_t)(ci * 64 + 16 * mt + l15) * 4096 + 2048 * kh + 8 * lq; const bf16_t* wp = wga + (size_t)l15 * 4096 + 2048 * kh + 8 * lq;
#pragma unroll 16
            for (int ks = 0; ks < 64; ++ks) { const pg8::bf16x8 hf = *(const pg8::bf16x8*)(hp + 32 * ks), wf = *(const pg8::bf16x8*)(wp + 32 * ks); a4 = __builtin_amdgcn_mfma_f32_16x16x32_bf16(hf, wf, a4, 0, 0, 0); }
#pragma unroll
            for (int r = 0; r < 4; ++r) gap[kh * 1024 + (16 * mt + 4 * lq + r) * 16 + l15] = a4[r];
            asm volatile("s_waitcnt lgkmcnt(0)" ::: "memory"); __syncthreads();
            ga[c.tid] = gap[c.tid] + gap[1024 + c.tid]; ga[512 + c.tid] = gap[512 + c.tid] + gap[1536 + c.tid]; }
        float up0[16], up1[16];
#pragma unroll
        for (int r = 0; r < 16; ++r) { const float2 v = *(const float2*)(up + r * 2048 + col); up0[r] = v.x; up1[r] = v.y; }
        const float2 bs = *(const float2*)(bias + col);
        asm volatile("s_waitcnt lgkmcnt(0)" ::: "memory"); __syncthreads();
        float bl0 = 0.f, bl1 = 0.f;
        for (int t = 0; t < 64; ++t) { float x0 = bs.x, x1 = bs.y;
#pragma unroll
            for (int r = 0; r < 16; ++r) { const float g = ga[t * 16 + r]; x0 += g * up0[r]; x1 += g * up1[r]; }
            bl0 += (fminf(x0, 0.f) - __logf(1.f + __expf(-fabsf(x0)))) * 0.0625f; bl1 += (fminf(x1, 0.f) - __logf(1.f + __expf(-fabsf(x1)))) * 0.0625f; }
        *(float2*)(DEC + (size_t)ci * 2048 + col) = make_float2(__expf(bl0), __expf(bl1));
        float bc0 = 0.f, bc1 = 0.f;
#pragma unroll 1
        for (int tb = 0; tb < 64; tb += 16) {
            if (tb + 16 < 64) PREP_LOAD(qn, kn, tb + 16);
            asm volatile("" ::: "memory");
#pragma unroll
          for (int i = 0; i < 16; ++i) { const int t = tb + i; float x0 = bs.x, x1 = bs.y; const size_t row = (size_t)ci * 64 + t;
            const unsigned qw = qc[i], kw = kc[i];
#pragma unroll
            for (int r = 0; r < 16; ++r) { const float g = ga[t * 16 + r]; x0 += g * up0[r]; x1 += g * up1[r]; }
            bc0 += (fminf(x0, 0.f) - __logf(1.f + __expf(-fabsf(x0)))) * 0.0625f; bc1 += (fminf(x1, 0.f) - __logf(1.f + __expf(-fabsf(x1)))) * 0.0625f;
            const float q0 = __uint_as_float(qw << 16), q1 = __uint_as_float(qw & 0xffff0000u), k0 = __uint_as_float(kw << 16), k1 = __uint_as_float(kw & 0xffff0000u);
            const float e0 = __expf(bc0), e1 = __expf(bc1);
            *(unsigned*)(Qd + row * 2048 + col) = pk2(q0 * 0.0625f * e0, q1 * 0.0625f * e1);
            *(unsigned*)(Ki + row * 2048 + col) = pk2(k0 * __expf(-bc0), k1 * __expf(-bc1)); }
            asm volatile("" ::: "memory");
#pragma unroll
            for (int i = 0; i < 16; ++i) { qc[i] = qn[i]; kc[i] = kn[i]; }
        }
#undef PREP_LOAD
    }
    __syncthreads();
}
__device__ __forceinline__ void resnorm1_phase(const Ctx& c, const float* __restrict__ x, const bf16_t* y, const float* __restrict__ g1, const float* __restrict__ g2, float* __restrict__ rstd1, bf16_t* __restrict__ h2, bf16_t* x1b) {
    const int lane = c.lane;
    for (int row = c.bid * NWAVES + c.wave; row < MTOK; row += c.G * NWAVES) {
        const uint2* yr = (const uint2*)(y + (size_t)row * D_MODEL) + lane; uint2* x1o = (uint2*)(x1b + (size_t)row * D_MODEL) + lane; const float4* xr = (const float4*)(x + (size_t)row * D_MODEL) + lane;
        uint2 yw[16]; float4 v[16]; float s = 0.f;
#pragma unroll
        for (int j = 0; j < 16; ++j) yw[j] = yr[64 * j];
#pragma unroll
        for (int j = 0; j < 16; ++j) v[j] = xr[64 * j];
        asm volatile("" ::: "memory");
#pragma unroll
        for (int j = 0; j < 16; ++j) { const float a = __uint_as_float(yw[j].x << 16), b = __uint_as_float(yw[j].x & 0xffff0000u), cc = __uint_as_float(yw[j].y << 16), d = __uint_as_float(yw[j].y & 0xffff0000u); s += a * a + b * b + cc * cc + d * d; }
        const float rstd = rsqrtf(wave_sum(s) * (1.f / D_MODEL) + EPS); float s2 = 0.f;
#pragma unroll
        for (int j = 0; j < 16; ++j) asm volatile("" : "+v"(yw[j].x), "+v"(yw[j].y));
#pragma unroll
        for (int j = 0; j < 16; ++j) { const float4 gg = ((const float4*)g1)[lane + 64 * j];
            v[j].x = v[j].x + __uint_as_float(yw[j].x << 16) * rstd * gg.x; v[j].y = v[j].y + __uint_as_float(yw[j].x & 0xffff0000u) * rstd * gg.y;
            v[j].z = v[j].z + __uint_as_float(yw[j].y << 16) * rstd * gg.z; v[j].w = v[j].w + __uint_as_float(yw[j].y & 0xffff0000u) * rstd * gg.w;
            s2 += v[j].x * v[j].x + v[j].y * v[j].y + v[j].z * v[j].z + v[j].w * v[j].w;
            { uint2 w1; w1.x = pk2(v[j].x, v[j].y); w1.y = pk2(v[j].z, v[j].w); x1o[64 * j] = w1; }
            if ((j & 3) == 3) asm volatile("" ::: "memory"); }
        const float rstd2 = rsqrtf(wave_sum(s2) * (1.f / D_MODEL) + EPS);
        if (lane == 0) rstd1[row] = rstd2;
    }
}
__device__ __forceinline__ void resnorm2_phase(const Ctx& c, const bf16_t* __restrict__ x1b, const bf16_t* __restrict__ y2, const float* __restrict__ g2, float* __restrict__ out) {
    const int lane = c.lane;
    for (int row = c.bid * NWAVES + c.wave; row < MTOK; row += c.G * NWAVES) {
        const uint2* yr = (const uint2*)(y2 + (size_t)row * D_MODEL) + lane; const uint2* xr = (const uint2*)(x1b + (size_t)row * D_MODEL) + lane; float4* xo = (float4*)(out + (size_t)row * D_MODEL) + lane;
        uint2 yw[16], xw[16]; float s = 0.f;
#pragma unroll
        for (int j = 0; j < 16; ++j) yw[j] = yr[64 * j];
#pragma unroll
        for (int j = 0; j < 16; ++j) xw[j] = xr[64 * j];
        asm volatile("" ::: "memory");
#pragma unroll
        for (int j = 0; j < 16; ++j) { const float a = __uint_as_float(yw[j].x << 16), b = __uint_as_float(yw[j].x & 0xffff0000u), cc = __uint_as_float(yw[j].y << 16), d = __uint_as_float(yw[j].y & 0xffff0000u); s += a * a + b * b + cc * cc + d * d; }
        const float rstd = rsqrtf(wave_sum(s) * (1.f / D_MODEL) + EPS);
#pragma unroll
        for (int j = 0; j < 16; ++j) asm volatile("" : "+v"(yw[j].x), "+v"(yw[j].y));
#pragma unroll
        for (int j = 0; j < 16; ++j) { const float4 gg = ((const float4*)g2)[lane + 64 * j]; const uint2 xq = xw[j], y2q = yw[j];
            float4 o;
            o.x = __uint_as_float(xq.x << 16) + __uint_as_float(y2q.x << 16) * rstd * gg.x; o.y = __uint_as_float(xq.x & 0xffff0000u) + __uint_as_float(y2q.x & 0xffff0000u) * rstd * gg.y;
            o.z = __uint_as_float(xq.y << 16) + __uint_as_float(y2q.y << 16) * rstd * gg.z; o.w = __uint_as_float(xq.y & 0xffff0000u) + __uint_as_float(y2q.y & 0xffff0000u) * rstd * gg.w;
            xo[64 * j] = o; if ((j & 3) == 3) asm volatile("" ::: "memory"); }
    }
}

__device__ __forceinline__ void gla_norm_apply_phase(const Ctx& c, bf16_t* __restrict__ A, const float* __restrict__ SSQ) {
    const int lane = c.lane, stride = c.G * NWAVES;
    for (int row0 = c.bid * NWAVES + c.wave; row0 < MTOK; row0 += 4 * stride) {
        uint4 v[4][8]; float sq[4];
#pragma unroll
        for (int q = 0; q < 4; ++q) { const int row = row0 + q * stride; sq[q] = 0.f;
            if (row < MTOK) { const uint4* ar = (const uint4*)(A + (size_t)row * 4096) + lane;
#pragma unroll
                for (int j = 0; j < 8; ++j) v[q][j] = ar[64 * j];
                sq[q] = SSQ[(size_t)row * 32 + (lane & 31)]; } }
        asm volatile("" ::: "memory");
#pragma unroll
        for (int q = 0; q < 4; ++q) { const int row = row0 + q * stride;
            if (row < MTOK) { uint4* ar = (uint4*)(A + (size_t)row * 4096) + lane;
                float t = sq[q]; t += __shfl_xor(t, 1); t += __shfl_xor(t, 2); const float rr = rsqrtf(t * (1.f / 512.f) + EPS);
#pragma unroll
                for (int j = 0; j < 8; ++j) { const float rj = __int_as_float(__builtin_amdgcn_readlane(__float_as_int(rr), 4 * j)); uint4 o; const unsigned w4[4] = {v[q][j].x, v[q][j].y, v[q][j].z, v[q][j].w}; unsigned o4[4];
#pragma unroll
                    for (int e = 0; e < 4; ++e) o4[e] = pk2(__uint_as_float(w4[e] << 16) * rj, __uint_as_float(w4[e] & 0xffff0000u) * rj);
                    o.x = o4[0]; o.y = o4[1]; o.z = o4[2]; o.w = o4[3]; ar[64 * j] = o; } } }
    }
}

constexpr size_t MiB = 1u << 20;
constexpr size_t WS_CTL = 0, CTL_ZERO_BYTES = 512 * 1024;
constexpr size_t WS_KS = 128 * 1024, WS_CS = 512 * 1024;
constexpr int CW_BAR = 0, CW_QHEAD = 8192, CW_QCONV = 8192 + 64;
constexpr size_t WS_WM = 1 * MiB;
constexpr size_t WS_WG = WS_WM + (size_t)4096 * 2048 * 2;
constexpr size_t WS_WO = WS_WG + (size_t)4096 * 4096 * 2;
constexpr size_t WS_WGU = WS_WO + (size_t)4096 * 4096 * 2;
constexpr size_t WS_WD = WS_WGU + (size_t)22016 * 4096 * 2;
constexpr size_t WS_RA = WS_WD + (size_t)4096 * 11008 * 2;
constexpr size_t RA_BYTES = (size_t)IN_COLS * 4096 * 2;
constexpr size_t WS_RU = WS_RA + RA_BYTES;
constexpr size_t RU_BYTES = (size_t)MTOK * IN_PAD * 2;
constexpr size_t WS_RH = WS_RU + RU_BYTES;
constexpr size_t WS_RO = WS_RH + (size_t)MTOK * 4096 * 2;
constexpr size_t WS_AM = WS_RO + (size_t)MTOK * 4096 * 4;
constexpr size_t WS_AG = WS_AM + (size_t)MTOK * 2048 * 2;
constexpr size_t WS_MG = WS_AG + (size_t)MTOK * 4096 * 2;
constexpr size_t WS_KM = WS_MG + (size_t)MTOK * 4096 * 2;
constexpr size_t WS_HID = WS_KM + 1 * MiB;
constexpr size_t WS_ST = WS_HID;
constexpr size_t WS_END = WS_ST + (size_t)BATCH * 8 * 32 * 512 * 256 * 2;

template <class Epi> __device__ __forceinline__ void gemm_run(const Ctx& c, const bf16_t* A, const bf16_t* Bt, int M, int N, int K, const Epi& E) {
    pg8::Gemm g{A, Bt, M, N, K}; pg8::StaticOrder S; S.init(M, N, c.G, c.bid);
    pg8::gemm_phase<Epi, pg8::StaticOrder, true, true>(c.lds, g, S, E);
}
template <int EPI> __device__ __forceinline__ void gemm_call(const Ctx& c, const bf16_t* A, const bf16_t* Bt, void* C, int M, int N, int K, int ldc) {
    if constexpr (EPI == 0) { pg8::EpiBf16Plain E{(bf16_t*)C, ldc}; gemm_run(c, A, Bt, M, N, K, E); }
    else { pg8::EpiF32 E{(float*)C, ldc, nullptr}; gemm_run(c, A, Bt, M, N, K, E); }
}

__global__ void __launch_bounds__(NTHR, 2) mk_fwd(Params p) {
    extern __shared__ __attribute__((aligned(16))) unsigned char lds_raw[];
    Ctx c; c.lds = (LAS unsigned char*)lds_raw; c.tid = threadIdx.x; c.lane = c.tid & 63; c.wave = __builtin_amdgcn_readfirstlane(c.tid >> 6); c.G = gridDim.x; c.bid = blockIdx.x;
    volatile LAS unsigned* MISC = (volatile LAS unsigned*)(c.lds + MISC_OFF);
    if (c.tid < 64) MISC[c.tid] = 0u;
    __syncthreads();
    XcdBarrier bar = xcd_barrier_post(p.ctl + CW_BAR, MISC + 8);
    const int lo = p.ph_lo, hi = p.ph_hi;
#define IN(k) (lo <= (k) && (k) < hi)
#define FRESH() do { int t_ = threadIdx.x; asm volatile("" : "+v"(t_)); c.tid = t_; c.lane = t_ & 63; c.wave = __builtin_amdgcn_readfirstlane(t_ >> 6); { size_t wso_ = 0; asm volatile("" : "+s"(wso_)); ws = p.ws + wso_; } } while (0)
#define SEAM(k) do { if (IN(k)) xcd_barrier(bar); } while (0)
    unsigned char* ws = p.ws;
#define xin ((const float*)p.in[0])
#define g_premix ((const float*)p.in[1])
#define w_in ((const float*)p.in[2])
#define gate_up ((const float*)p.in[3])
#define gate_bias ((const float*)p.in[4])
#define g_glanorm ((const float*)p.in[5])
#define w_bm ((const float*)p.in[6])
#define w_bg ((const float*)p.in[7])
#define w_out ((const float*)p.in[8])
#define g_postmix ((const float*)p.in[9])
#define g_preffn ((const float*)p.in[10])
#define w_fg ((const float*)p.in[11])
#define w_fu ((const float*)p.in[12])
#define w_fd ((const float*)p.in[13])
#define g_postffn ((const float*)p.in[14])
#define outp (p.out)
#define WmT ((bf16_t*)(ws + WS_WM))
#define WgT ((bf16_t*)(ws + WS_WG))
#define WoT ((bf16_t*)(ws + WS_WO))
#define WguT ((bf16_t*)(ws + WS_WGU))
#define WdT ((bf16_t*)(ws + WS_WD))
#define WinT ((bf16_t*)(ws + WS_RA))
#define MQ ((bf16_t*)(ws + WS_RA))
#define MK (MQ + (size_t)MTOK * 2048)
#define MV (MQ + (size_t)MTOK * 2048 * 2)
#define BC ((float*)(MQ + (size_t)MTOK * 2048 * 3))
#define ymoba ((bf16_t*)(ws + WS_RA + 2 * MiB))
#define ybuf ((bf16_t*)(ws + WS_RA + 2 * MiB))
#define ubuf ((bf16_t*)(ws + WS_RU))
#define gu ((bf16_t*)(ws + WS_RU))
#define hbuf ((bf16_t*)(ws + WS_RH))
#define h2 ((bf16_t*)(ws + WS_RH))
#define Qd ((bf16_t*)(ws + WS_RO))
#define Ki (Qd + (size_t)MTOK * 2048)
#define Ke (Qd + (size_t)MTOK * 2048 * 2)
#define ygla ((float*)(ws + WS_RO))
#define y2 ((bf16_t*)(ws + WS_RO))
#define ST ((bf16_t*)(ws + WS_ST))
#define Am ((bf16_t*)(ws + WS_AM))
#define Ag ((bf16_t*)(ws + WS_AG))
#define mg ((bf16_t*)(ws + WS_MG))
#define KS ((float*)(ws + WS_KS))
#define SSQb ((float*)(ws + WS_RO + 100 * MiB))
#define RS1 ((float*)(ws + WS_KM + 524288))
#define CSt ((float*)(ws + WS_CS))
#define SNt ((float*)(ws + WS_KM))
#define DEC ((float*)(ws + WS_RA))
#define hid ((bf16_t*)(ws + WS_HID))

    if (IN(0)) { FRESH(); } if (IN(0)) {
        conv_items<2>(c, w_in, 4096, IN_COLS, WinT, 0);
        conv_items<0, 4>(c, w_fd, D_FF, 4096, WdT, 0, 0, WD_SPLIT);
        rmsnorm_rows_bf16(c, xin, g_premix, hbuf);
        rope_table_phase(c, CSt, SNt);
    }
    SEAM(0);
    if (IN(1)) { FRESH(); } if (IN(1)) { pg8::EpiIn E{ubuf, IN_PAD, CSt, SNt, KS}; gemm_run(c, hbuf, WinT, MTOK, IN_PAD, 4096, E); }
    SEAM(1);
    if (IN(2)) { FRESH(); } if (IN(2)) { gla_prep_phase(c, ubuf, hbuf, WinT + (size_t)GA_ROW * 4096, gate_up, gate_bias, DEC, Qd, Ki);
        for (int i = c.bid * NTHR + c.tid; i < MTOK * 32; i += c.G * NTHR) __hip_atomic_store(SSQb + i, -1.f, __ATOMIC_RELAXED, __HIP_MEMORY_SCOPE_AGENT); }
    SEAM(2);
    if (IN(4)) { FRESH(); } if (IN(4)) {
        const int half = c.G >> 1;
        if (c.bid < half) {
            for (int it = c.bid; it < BATCH * 8 * 4; it += half) { const int hh = it & 7, dvs = (it >> 3) & 3, b = it >> 5; const size_t t0 = (size_t)(b * SEQ);
                gf::fused_unit(Qd + t0 * 2048 + hh * 256, Ki + t0 * 2048 + hh * 256, ubuf + t0 * IN_PAD + OFF_GV + hh * 512 + dvs * 128, IN_PAD,
                               ubuf + t0 * IN_PAD + OFF_GR + hh * 512 + dvs * 128, IN_PAD, DEC + (size_t)(b * 32) * 2048 + hh * 256, g_glanorm + dvs * 128,
                               Ag + t0 * 4096 + hh * 512 + dvs * 128, 4096, SSQb + (size_t)((b * 8 + hh) * 32) * 256, dvs, c.lds); }
        }
        for (;;) { __syncthreads(); if (c.tid == 0) *(volatile LAS unsigned*)(c.lds + MISC_OFF + 64) = atomicAdd(p.ctl + CW_QHEAD, 1u); __syncthreads();
            const int it = (int)__builtin_amdgcn_readfirstlane(*(volatile LAS unsigned*)(c.lds + MISC_OFF + 64)); if (it >= BATCH * 16 * 4) break;
            const int pr = (it >> 3) & 3, hd = (it & 7) + 8 * ((it >> 5) & 1), b = it >> 6;
#pragma unroll 1
            for (int k = 0; k < 2; ++k) { const int qb = k ? 7 - pr : pr; const size_t q0 = (size_t)(b * SEQ + qb * 256) * IN_PAD + hd * 128, k0 = (size_t)(b * SEQ) * IN_PAD + hd * 128;
                mb::moba_unit(ubuf + OFF_MQ + q0, ubuf + OFF_MK + k0, ubuf + OFF_MV + k0, Am + (size_t)(b * SEQ + qb * 256) * 2048 + hd * 128, KS + (size_t)((b * 16 + hd) * 8) * 128, qb, (char*)lds_raw); } }
        if (c.bid >= half) { FRESH();
            Ctx c2 = c; c2.bid = c.bid - half; c2.G = c.G - half;
            conv_items<0>(c2, w_bg, 4096, 4096, WgT, 0); conv_items<0>(c2, w_out, 4096, 4096, WoT, 0); }
        else if (half > 0) { FRESH(); Ctx c2 = c; c2.G = half; conv_items<0>(c2, w_bm, 2048, 4096, WmT, 0); }
        conv_stage_gain(c, g_preffn, 4096);
        for (;;) { __syncthreads(); if (c.tid == 0) *(volatile LAS unsigned*)(c.lds + MISC_OFF + 64) = atomicAdd(p.ctl + CW_QCONV, 1u); __syncthreads();
            const int q = (int)__builtin_amdgcn_readfirstlane(*(volatile LAS unsigned*)(c.lds + MISC_OFF + 64)); if (q >= 2 * 344) break;
            FRESH(); Ctx c1 = c; c1.bid = 0; c1.G = 1; const int up = q >= 344, u0 = 4 * (up ? q - 344 : q);
            if (up) conv_items<1, 8, true>(c1, w_fu, 4096, D_FF, WguT, 128, u0, u0 + 4); else conv_items<1, 8, true>(c1, w_fg, 4096, D_FF, WguT, 0, u0, u0 + 4); }
    }
    SEAM(4);
    if (IN(6)) { FRESH(); } if (IN(6)) {
        { pg8::EpiGateF32 E{ymoba, 4096, ubuf + OFF_SM, IN_PAD}; gemm_run(c, Am, WmT, MTOK, 4096, 2048, E); }
        { pg8::EpiMergeBf16 E{mg, 4096, ymoba, ubuf + OFF_SG, IN_PAD}; gemm_run(c, Ag, WgT, MTOK, 4096, 4096, E); } }
    SEAM(6);
    if (IN(8)) { FRESH(); } if (IN(8)) gemm_call<0>(c, mg, WoT, ybuf, MTOK, 4096, 4096, 4096);
    SEAM(8);
    if (IN(9)) { FRESH(); } if (IN(9)) resnorm1_phase(c, xin, ybuf, g_postmix, g_preffn, RS1, h2, ybuf);
    SEAM(9);
    if (IN(10)) { FRESH(); } if (IN(10)) { pg8::EpiSwiGLU E{hid, D_FF, RS1}; gemm_run(c, ybuf, WguT, MTOK, 2 * D_FF, 4096, E);
        const int nun = (MTOK / 256) * (2 * D_FF / 256), full = nun / c.G, rem = nun - full * c.G;
        if (rem > 0 && c.bid >= rem) { FRESH(); Ctx c2 = c; c2.bid = c.bid - rem; c2.G = c.G - rem; __syncthreads(); conv_items<0, 4>(c2, w_fd, D_FF, 4096, WdT, 0, WD_SPLIT); }
        else if (rem == 0) { conv_items<0, 4>(c, w_fd, D_FF, 4096, WdT, 0, WD_SPLIT); } }
    SEAM(10);
    if (IN(12)) { FRESH(); } if (IN(12)) gemm_call<0>(c, hid, WdT, y2, MTOK, 4096, D_FF, 4096);
    SEAM(12);
    if (IN(13)) { FRESH(); } if (IN(13)) resnorm2_phase(c, ybuf, y2, g_postffn, outp);
#undef IN
#undef SEAM
}
#undef xin
#undef g_premix
#undef w_in
#undef gate_up
#undef gate_bias
#undef g_glanorm
#undef w_bm
#undef w_bg
#undef w_out
#undef g_postmix
#undef g_preffn
#undef w_fg
#undef w_fu
#undef w_fd
#undef g_postffn
#undef outp
#undef WmT
#undef WgT
#undef WoT
#undef WguT
#undef WdT
#undef WinT
#undef MQ
#undef MK
#undef MV
#undef BC
#undef ymoba
#undef ybuf
#undef ubuf
#undef gu
#undef hbuf
#undef h2
#undef Qd
#undef Ki
#undef Ke
#undef ygla
#undef y2
#undef ST
#undef Am
#undef Ag
#undef mg
#undef KS
#undef SSQb
#undef RS1
#undef CSt
#undef SNt
#undef DEC
#undef hid


extern "C" void kernel_launch(void* const* d_in, const int* in_sizes, int n_in, void* d_out, int out_size, void* d_ws, size_t ws_size, hipStream_t stream) {
    static int grid = 0;
    if (grid == 0) {
        if (n_in != 15 || in_sizes[0] != MTOK * D_MODEL || out_size != MTOK * D_MODEL || ws_size < WS_END) {
            fprintf(stderr, "kernel_launch: shape/ws mismatch n_in %d in0 %d out %d ws %zu need %zu\n", n_in, n_in > 0 ? in_sizes[0] : -1, out_size, ws_size, (size_t)WS_END); grid = -1; return; }
        if (hipFuncSetAttribute((const void*)mk_fwd, hipFuncAttributeMaxDynamicSharedMemorySize, LDS_BYTES) != hipSuccess) { fprintf(stderr, "kernel_launch: hipFuncSetAttribute failed\n"); grid = -1; return; }
        int dev = 0, cus = 0, per_cu = 0;
        if (hipGetDevice(&dev) != hipSuccess || hipDeviceGetAttribute(&cus, hipDeviceAttributeMultiprocessorCount, dev) != hipSuccess) { grid = -1; return; }
        if (hipOccupancyMaxActiveBlocksPerMultiprocessor(&per_cu, (const void*)mk_fwd, NTHR, LDS_BYTES) != hipSuccess || per_cu < 1) { fprintf(stderr, "kernel_launch: occupancy query says %d blocks/CU\n", per_cu); grid = -1; (void)hipGetLastError(); return; }
        grid = cus;
    }
    if (grid < 0) return;
    (void)hipMemsetAsync((char*)d_ws + WS_CTL, 0, CTL_ZERO_BYTES, stream);
    Params p; memset(&p, 0, sizeof(p));
    for (int i = 0; i < 15; ++i) p.in[i] = (const float*)d_in[i];
    p.out = (float*)d_out; p.ws = (unsigned char*)d_ws; p.ctl = (unsigned*)((char*)d_ws + WS_CTL); p.ph_lo = 0; p.ph_hi = 14;
    hipLaunchKernelGGL(mk_fwd, dim3(grid), dim3(NTHR), LDS_BYTES, stream, p);
    const hipError_t le = hipPeekAtLastError();
    if (le != hipSuccess) fprintf(stderr, "kernel_launch: launch failed: %s\n", hipGetErrorName(le));
}
```

```cpp
#include <hip/hip_runtime.h>
#include <cstdio>
#include <cstdint>
#include <cstring>
namespace pg8 {
#define PG8_LAS __attribute__((address_space(3)))
typedef unsigned short bf16_t;
typedef short bf16x8 __attribute__((ext_vector_type(8)));
typedef float f32x4 __attribute__((ext_vector_type(4)));
typedef unsigned u32x4 __attribute__((ext_vector_type(4)));
constexpr int BM = 256, BK = 64, HALF = 128, HTB = HALF * BK * 2  , STAGE_BYTES = 8 * HTB, NXCD = 8, WGM = 8;

__host__ __device__ __forceinline__ int lds_byte(int r, int c) { const int st = (r >> 4) * 2 + (c >> 5), rr = r & 15, cc = c & 31, ob = rr * 64 + cc * 2; return st * 1024 + (ob ^ (((ob >> 9) & 1) << 5)); }
__host__ __device__ __forceinline__ void stage_rc(int b, int& R, int& C) { const int st = b / 1024, sb = b % 1024, swz = sb ^ (((sb >> 9) & 1) << 5); R = (st >> 1) * 16 + swz / 64; C = (st & 1) * 32 + (swz % 64) / 2; }
__host__ __device__ __forceinline__ int perm32(int rho) { const int n = rho >> 4, i = rho & 15; return 8 * (i >> 2) + 4 * n + (i & 3); }

struct Unit { int pm, pn; };
struct Gemm { const bf16_t* A; const bf16_t* Bt; int M, N, K; };

struct StaticOrder {
    int nM, nN, nwg, G, c;
    __host__ __device__ void init(int M, int N, int G_, int c_) { nM = M / BM; nN = N / BM; nwg = nM * nN; G = G_; c = c_; }
    __host__ __device__ bool next(int i, Unit& u) const {
        const long L = (long)i * G + c; if (L >= nwg) return false;
        int wgid = (int)L; { const int q = nwg / NXCD, r = nwg % NXCD, xcd = wgid % NXCD, off = wgid / NXCD; wgid = (xcd < r ? xcd * (q + 1) : r * (q + 1) + (xcd - r) * q) + off; }
        const int nig = WGM * nN, gid = wgid / nig, fm = gid * WGM, gsz = (nM - fm) < WGM ? (nM - fm) : WGM;
        u.pm = fm + ((wgid % nig) % gsz); u.pn = (wgid % nig) / gsz; return true;
    }
    __device__ __forceinline__ void a_ready(const Unit&) const {}
    __device__ __forceinline__ void done(const Unit&) const {}
};
__device__ __forceinline__ unsigned cvt_pk_bf16(float lo, float hi) { typedef __bf16 bf2_ __attribute__((ext_vector_type(2))); typedef float f2_ __attribute__((ext_vector_type(2))); const f2_ f = {lo, hi}; return __builtin_bit_cast(unsigned, __builtin_convertvector(f, bf2_)); }
typedef float f32x2 __attribute__((ext_vector_type(2)));
struct EpiF32 {
    static constexpr bool PERM = false, AFTER_DRAIN = false;
    float* C; int ldc; const float* bias;
    __device__ __forceinline__ void operator()(const f32x4 (&acc)[2][2][4][2], const Unit& u, int wr, int wc, int fr, int fq) const {
        const int row0 = u.pm * BM + wr * 64 + fr, col0 = u.pn * BM + wc * 32 + 4 * fq;
        f32x4 bv[2][2];
#pragma unroll
        for (int bj = 0; bj < 2; ++bj)
#pragma unroll
            for (int n = 0; n < 2; ++n) bv[bj][n] = bias ? *(const f32x4*)(bias + col0 + bj * HALF + n * 16) : (f32x4){0.f, 0.f, 0.f, 0.f};
#pragma unroll
        for (int ai = 0; ai < 2; ++ai)
#pragma unroll
            for (int m = 0; m < 4; ++m) { float* rowp = C + (size_t)(row0 + ai * HALF + m * 16) * ldc + col0;
#pragma unroll
                for (int bj = 0; bj < 2; ++bj)
#pragma unroll
                    for (int n = 0; n < 2; ++n) *(f32x4*)(rowp + bj * HALF + n * 16) = acc[ai][bj][m][n] + bv[bj][n]; }
    }
};
template <class Epi, class Sched, bool ALIGN_EPI = false, bool SP2 = false>
__device__ __forceinline__ void gemm_phase(PG8_LAS unsigned char* lds, const Gemm g, const Sched& S, const Epi& E) {
    const int tid = threadIdx.x, wid = __builtin_amdgcn_readfirstlane(tid >> 6), lane = tid & 63, wr = wid >> 2, wc = wid & 3, fr = lane & 15, fq = lane >> 4;
    const int K = g.K, nt = K / BK;
    unsigned voffA[2], voffB[2];
#pragma unroll
    for (int i = 0; i < 2; ++i) { int R, C; stage_rc(tid * 16 + i * 8192, R, C); const int Rb = Epi::PERM ? ((R & ~31) + perm32(R & 31)) : R;
        voffA[i] = (unsigned)(R * K + C) * 2u; voffB[i] = (unsigned)(Rb * K + C) * 2u; }
    const size_t kstep = (size_t)(BK * 2);
    const size_t hstep = (size_t)HALF * K * 2;
    const size_t tstep = 2 * hstep;
    const unsigned ldsw = (unsigned)wid * 1024u;
    const int aoff = lds_byte(wr * 64 + fr, fq * 8), boff = lds_byte(wc * 32 + fr, fq * 8);
#define PG8_SA(b, h) (((b) * 2 + (h)) * HTB)
#define PG8_SB(b, h) ((4 + (b) * 2 + (h)) * HTB)
#define PG8_STAGE(bufoff, gbase, voff) do { _Pragma("unroll") for (int _i = 0; _i < 2; ++_i) \
        __builtin_amdgcn_global_load_lds((const unsigned*)((const char*)(gbase) + (voff)[_i]), (PG8_LAS unsigned*)(lds + (bufoff) + ldsw + _i * 8192), 16, 0, 0); } while (0)
#define PG8_LDA(dst, b, h) do { _Pragma("unroll") for (int m = 0; m < 4; ++m) _Pragma("unroll") for (int k = 0; k < 2; ++k) dst[m][k] = *(const PG8_LAS bf16x8*)(lds + PG8_SA(b, h) + aoff + m * 2048 + k * 1024); } while (0)
#define PG8_LDB(dst, b, h) do { _Pragma("unroll") for (int n = 0; n < 2; ++n) _Pragma("unroll") for (int k = 0; k < 2; ++k) dst[n][k] = *(const PG8_LAS bf16x8*)(lds + PG8_SB(b, h) + boff + n * 2048 + k * 1024); } while (0)
#define PG8_MMA(ai, bj, At, Bt) do { __builtin_amdgcn_s_setprio(1); _Pragma("unroll") for (int m = 0; m < 4; ++m) _Pragma("unroll") for (int n = 0; n < 2; ++n) _Pragma("unroll") for (int k = 0; k < 2; ++k) \
        acc[ai][bj][m][n] = __builtin_amdgcn_mfma_f32_16x16x32_bf16(Bt[n][k], At[m][k], acc[ai][bj][m][n], 0, 0, 0); __builtin_amdgcn_s_setprio(0); } while (0)
#define PG8_WAIT_V(n) asm volatile("s_waitcnt vmcnt(" #n ")" ::: "memory")
#define PG8_WAIT_L(n) asm volatile("s_waitcnt lgkmcnt(" #n ")" ::: "memory")
#define PG8_BAR __builtin_amdgcn_s_barrier()
#define PG8_SCHED __builtin_amdgcn_sched_barrier(0)
    Unit cur, nxt; int ui = 0;
    if (!S.next(0, cur)) return;
    f32x4 acc[2][2][4][2];
#pragma unroll
    for (int a = 0; a < 2; ++a)
#pragma unroll
        for (int b = 0; b < 2; ++b)
#pragma unroll
            for (int m = 0; m < 4; ++m)
#pragma unroll
                for (int n = 0; n < 2; ++n) acc[a][b][m][n] = (f32x4){0.f, 0.f, 0.f, 0.f};
    bf16x8 At[4][2], B0[2][2], B1[2][2];
    const char* cA = (const char*)g.A + (size_t)cur.pm * tstep; const char* cB = (const char*)g.Bt + (size_t)cur.pn * tstep;
    S.a_ready(cur);
    if constexpr (SP2) {
        PG8_STAGE(PG8_SB(0, 0), cB, voffB); PG8_STAGE(PG8_SB(0, 1), cB + hstep, voffB); PG8_STAGE(PG8_SA(0, 0), cA, voffA); PG8_STAGE(PG8_SA(0, 1), cA + hstep, voffA);
        if (wr == 1) PG8_BAR;
        PG8_WAIT_V(2); PG8_BAR;
        PG8_STAGE(PG8_SB(1, 0), cB + kstep, voffB); PG8_STAGE(PG8_SA(1, 0), cA + kstep, voffA); PG8_STAGE(PG8_SB(1, 1), cB + hstep + kstep, voffB);
        PG8_WAIT_V(6); PG8_BAR;
    } else {
        PG8_STAGE(PG8_SB(0, 0), cB, voffB); PG8_STAGE(PG8_SA(0, 0), cA, voffA); PG8_STAGE(PG8_SB(0, 1), cB + hstep, voffB); PG8_STAGE(PG8_SA(0, 1), cA + hstep, voffA);
        if (wr == 1) PG8_BAR;
        PG8_WAIT_V(4); PG8_BAR;
        PG8_STAGE(PG8_SB(1, 0), cB + kstep, voffB); PG8_STAGE(PG8_SA(1, 0), cA + kstep, voffA); PG8_STAGE(PG8_SB(1, 1), cB + hstep + kstep, voffB);
        PG8_WAIT_V(6); PG8_BAR;
    }
    for (;;) {
        const bool has_next = S.next(ui + 1, nxt);
        const char* nA = has_next ? (const char*)g.A + (size_t)nxt.pm * tstep : cA; const char* nB = has_next ? (const char*)g.Bt + (size_t)nxt.pn * tstep : cB;
        for (int t = 0; t < nt; t += 2) {
            const bool last = (t == nt - 2);
            const char* a1 = cA + (size_t)(t + 1) * kstep;
            const char* a2 = last ? nA : cA + (size_t)(t + 2) * kstep; const char* b2 = last ? nB : cB + (size_t)(t + 2) * kstep;
            const char* a3 = a2 + kstep; const char* b3 = b2 + kstep;
            if (last && has_next) S.a_ready(nxt);
            if constexpr (SP2) {
            PG8_LDB(B0, 0, 0); PG8_LDB(B1, 0, 1); PG8_SCHED; PG8_LDA(At, 0, 0); PG8_STAGE(PG8_SA(1, 1), a1 + hstep, voffA);
            PG8_WAIT_V(8); PG8_WAIT_L(0); PG8_BAR; PG8_MMA(0, 0, At, B0); PG8_MMA(0, 1, At, B1); PG8_BAR; PG8_SCHED;
            PG8_LDA(At, 0, 1); PG8_STAGE(PG8_SB(0, 0), b2, voffB); PG8_STAGE(PG8_SB(0, 1), b2 + hstep, voffB); PG8_STAGE(PG8_SA(0, 0), a2, voffA);
            PG8_WAIT_V(8); PG8_WAIT_L(0); PG8_BAR; PG8_MMA(1, 0, At, B0); PG8_MMA(1, 1, At, B1); PG8_BAR; PG8_SCHED;
            PG8_LDB(B0, 1, 0); PG8_LDB(B1, 1, 1); PG8_SCHED; PG8_LDA(At, 1, 0); PG8_STAGE(PG8_SA(0, 1), a2 + hstep, voffA);
            PG8_WAIT_V(8); PG8_WAIT_L(0); PG8_BAR; PG8_MMA(0, 0, At, B0); PG8_MMA(0, 1, At, B1); PG8_BAR; PG8_SCHED;
            PG8_LDA(At, 1, 1); PG8_STAGE(PG8_SB(1, 0), b3, voffB); PG8_STAGE(PG8_SB(1, 1), b3 + hstep, voffB); PG8_STAGE(PG8_SA(1, 0), a3, voffA);
            PG8_WAIT_V(8); PG8_WAIT_L(0); PG8_BAR; PG8_MMA(1, 0, At, B0); PG8_MMA(1, 1, At, B1); PG8_BAR; PG8_SCHED;
            } else {
            PG8_LDB(B0, 0, 0); PG8_SCHED; PG8_LDA(At, 0, 0); PG8_STAGE(PG8_SA(1, 1), a1 + hstep, voffA);
            PG8_WAIT_L(8); PG8_BAR; PG8_WAIT_L(0); PG8_MMA(0, 0, At, B0); PG8_BAR; PG8_SCHED;
            PG8_LDB(B1, 0, 1); PG8_STAGE(PG8_SB(0, 0), b2, voffB);
            PG8_BAR; PG8_WAIT_L(0); PG8_MMA(0, 1, At, B1); PG8_BAR;
            PG8_LDA(At, 0, 1); PG8_STAGE(PG8_SA(0, 0), a2, voffA);
            PG8_BAR; PG8_WAIT_L(0); PG8_MMA(1, 0, At, B0); PG8_BAR; PG8_SCHED;
            PG8_STAGE(PG8_SB(0, 1), b2 + hstep, voffB);
            PG8_WAIT_V(6); PG8_BAR; PG8_MMA(1, 1, At, B1); PG8_BAR;
            PG8_LDB(B0, 1, 0); PG8_SCHED; PG8_LDA(At, 1, 0); PG8_STAGE(PG8_SA(0, 1), a2 + hstep, voffA);
            PG8_WAIT_L(8); PG8_BAR; PG8_WAIT_L(0); PG8_MMA(0, 0, At, B0); PG8_BAR; PG8_SCHED;
            PG8_LDB(B1, 1, 1); PG8_STAGE(PG8_SB(1, 0), b3, voffB);
            PG8_BAR; PG8_WAIT_L(0); PG8_MMA(0, 1, At, B1); PG8_BAR;
            PG8_LDA(At, 1, 1); PG8_STAGE(PG8_SA(1, 0), a3, voffA);
            PG8_BAR; PG8_WAIT_L(0); PG8_MMA(1, 0, At, B0); PG8_BAR; PG8_SCHED;
            PG8_STAGE(PG8_SB(1, 1), b3 + hstep, voffB);
            PG8_WAIT_V(6); PG8_BAR; PG8_MMA(1, 1, At, B1); PG8_BAR;
            }
        }
        if constexpr (ALIGN_EPI) { if (wr == 0) PG8_BAR; }
        if constexpr (!Epi::AFTER_DRAIN) { E(acc, cur, wr, wc, fr, fq); S.done(cur); }
        if (!has_next) break;
#pragma unroll
        for (int a = 0; a < 2; ++a)
#pragma unroll
            for (int b = 0; b < 2; ++b)
#pragma unroll
                for (int m = 0; m < 4; ++m)
#pragma unroll
                    for (int n = 0; n < 2; ++n) acc[a][b][m][n] = (f32x4){0.f, 0.f, 0.f, 0.f};
        cur = nxt; cA = nA; cB = nB; ++ui;
        if constexpr (ALIGN_EPI) { if (wr == 1) PG8_BAR; }
    }
    PG8_WAIT_V(0);
    if constexpr (!ALIGN_EPI) { if (wr == 0) PG8_BAR; }
    PG8_BAR;
    if constexpr (Epi::AFTER_DRAIN) { E.fused(acc, cur, wr, wc, fr, fq, lds, wid, lane); S.done(cur); }
#undef PG8_SA
#undef PG8_SB
#undef PG8_STAGE
#undef PG8_LDA
#undef PG8_LDB
#undef PG8_MMA
#undef PG8_WAIT_V
#undef PG8_WAIT_L
#undef PG8_BAR
#undef PG8_SCHED
}
}

namespace pg8 {
struct EpiBf16Plain {
    static constexpr bool PERM = true, AFTER_DRAIN = false;
    bf16_t* O; int ldc;
    __device__ __forceinline__ void operator()(const f32x4 (&acc)[2][2][4][2], const Unit& u, int wr, int wc, int fr, int fq) const {
        const int row0 = u.pm * BM + wr * 64 + fr; const int col0 = u.pn * BM + wc * 32 + 8 * fq;
#pragma unroll
        for (int ai = 0; ai < 2; ++ai)
#pragma unroll
            for (int m = 0; m < 4; ++m) { bf16_t* rowp = O + (size_t)(row0 + ai * HALF + m * 16) * ldc + col0;
#pragma unroll
                for (int bj = 0; bj < 2; ++bj) { const f32x4 v0 = acc[ai][bj][m][0], v1 = acc[ai][bj][m][1];
                    u32x4 w; w.x = cvt_pk_bf16(v0[0], v0[1]); w.y = cvt_pk_bf16(v0[2], v0[3]); w.z = cvt_pk_bf16(v1[0], v1[1]); w.w = cvt_pk_bf16(v1[2], v1[3]);
                    *(u32x4*)(rowp + bj * HALF) = w; } }
    }
};
}

namespace pg8 {
__device__ __forceinline__ float sigm(float x) { return __builtin_amdgcn_rcpf(1.f + __expf(-x)); }
struct EpiSwiGLU {
    static constexpr bool PERM = true, AFTER_DRAIN = false;
    bf16_t* O; int ldc;
    __device__ __forceinline__ void operator()(const f32x4 (&acc)[2][2][4][2], const Unit& u, int wr, int wc, int fr, int fq) const {
        const int row0 = u.pm * BM + wr * 64 + fr; const int col0 = u.pn * HALF + wc * 32 + 8 * fq;
#pragma unroll
        for (int ai = 0; ai < 2; ++ai)
#pragma unroll
            for (int m = 0; m < 4; ++m) { bf16_t* rowp = O + (size_t)(row0 + ai * HALF + m * 16) * ldc + col0; float v[8];
#pragma unroll
                for (int n = 0; n < 2; ++n)
#pragma unroll
                    for (int e = 0; e < 4; ++e) { const float g = acc[ai][0][m][n][e], up = acc[ai][1][m][n][e]; v[4 * n + e] = g * sigm(g) * up; }
                u32x4 w; w.x = cvt_pk_bf16(v[0], v[1]); w.y = cvt_pk_bf16(v[2], v[3]); w.z = cvt_pk_bf16(v[4], v[5]); w.w = cvt_pk_bf16(v[6], v[7]);
                *(u32x4*)rowp = w; }
    }
};
struct EpiGateF32 {
    static constexpr bool PERM = true, AFTER_DRAIN = false;
    bf16_t* Y; int ldc; const bf16_t* G; int ldg;
    __device__ __forceinline__ void operator()(const f32x4 (&acc)[2][2][4][2], const Unit& u, int wr, int wc, int fr, int fq) const {
        const int row0 = u.pm * BM + wr * 64 + fr; const int col0 = u.pn * BM + wc * 32 + 8 * fq;
#pragma unroll
        for (int ai = 0; ai < 2; ++ai)
#pragma unroll
            for (int m = 0; m < 4; ++m) { const size_t r = (size_t)(row0 + ai * HALF + m * 16);
#pragma unroll
                for (int bj = 0; bj < 2; ++bj) { const u32x4 g = *(const u32x4*)(G + r * ldg + col0 + bj * HALF); f32x4 o0, o1;
#pragma unroll
                    for (int e = 0; e < 2; ++e) { o0[2 * e] = sigm(__uint_as_float(g[e] << 16)) * acc[ai][bj][m][0][2 * e]; o0[2 * e + 1] = sigm(__uint_as_float(g[e] & 0xffff0000u)) * acc[ai][bj][m][0][2 * e + 1];
                        o1[2 * e] = sigm(__uint_as_float(g[2 + e] << 16)) * acc[ai][bj][m][1][2 * e]; o1[2 * e + 1] = sigm(__uint_as_float(g[2 + e] & 0xffff0000u)) * acc[ai][bj][m][1][2 * e + 1]; }
                    u32x4 w; w.x = cvt_pk_bf16(o0[0], o0[1]); w.y = cvt_pk_bf16(o0[2], o0[3]); w.z = cvt_pk_bf16(o1[0], o1[1]); w.w = cvt_pk_bf16(o1[2], o1[3]);
                    *(u32x4*)(Y + r * ldc + col0 + bj * HALF) = w; } }
    }
};
struct EpiMergeBf16 {
    static constexpr bool PERM = true, AFTER_DRAIN = false;
    bf16_t* O; int ldc; const bf16_t* Y; const bf16_t* G; int ldg;
    __device__ __forceinline__ void operator()(const f32x4 (&acc)[2][2][4][2], const Unit& u, int wr, int wc, int fr, int fq) const {
        const int row0 = u.pm * BM + wr * 64 + fr; const int col0 = u.pn * BM + wc * 32 + 8 * fq;
#pragma unroll
        for (int ai = 0; ai < 2; ++ai)
#pragma unroll
            for (int m = 0; m < 4; ++m) { const size_t r = (size_t)(row0 + ai * HALF + m * 16);
#pragma unroll
                for (int bj = 0; bj < 2; ++bj) { const u32x4 g = *(const u32x4*)(G + r * ldg + col0 + bj * HALF); const u32x4 yw = *(const u32x4*)(Y + r * ldc + col0 + bj * HALF); const f32x4 y0 = {__uint_as_float(yw[0] << 16), __uint_as_float(yw[0] & 0xffff0000u), __uint_as_float(yw[1] << 16), __uint_as_float(yw[1] & 0xffff0000u)}, y1 = {__uint_as_float(yw[2] << 16), __uint_as_float(yw[2] & 0xffff0000u), __uint_as_float(yw[3] << 16), __uint_as_float(yw[3] & 0xffff0000u)}; f32x4 o0, o1;
#pragma unroll
                    for (int e = 0; e < 2; ++e) { o0[2 * e] = y0[2 * e] + sigm(__uint_as_float(g[e] << 16)) * acc[ai][bj][m][0][2 * e]; o0[2 * e + 1] = y0[2 * e + 1] + sigm(__uint_as_float(g[e] & 0xffff0000u)) * acc[ai][bj][m][0][2 * e + 1];
                        o1[2 * e] = y1[2 * e] + sigm(__uint_as_float(g[2 + e] << 16)) * acc[ai][bj][m][1][2 * e]; o1[2 * e + 1] = y1[2 * e + 1] + sigm(__uint_as_float(g[2 + e] & 0xffff0000u)) * acc[ai][bj][m][1][2 * e + 1]; }
                    u32x4 w; w.x = cvt_pk_bf16(o0[0], o0[1]); w.y = cvt_pk_bf16(o0[2], o0[3]); w.z = cvt_pk_bf16(o1[0], o1[1]); w.w = cvt_pk_bf16(o1[2], o1[3]);
                    *(u32x4*)(O + r * ldc + col0 + bj * HALF) = w; } }
    }
};
}

namespace pg8 {
struct EpiIn {
    static constexpr bool PERM = true, AFTER_DRAIN = false;
    bf16_t* O; int ldc; const float* CS; const float* SN; float* KS;
    __device__ __forceinline__ void operator()(const f32x4 (&acc)[2][2][4][2], const Unit& u, int wr, int wc, int fr_, int fq_) const {
        int fr = fr_, fq = fq_; asm volatile("" : "+v"(fr), "+v"(fq));
        const int row0 = u.pm * BM + wr * 64 + fr; const int col0 = u.pn * BM + wc * 32 + 8 * fq;
        if (u.pn >= 16) {
#pragma unroll
            for (int ai = 0; ai < 2; ++ai)
#pragma unroll
                for (int m = 0; m < 4; ++m) { bf16_t* rowp = O + (size_t)(row0 + ai * HALF + m * 16) * ldc + col0;
#pragma unroll
                    for (int bj = 0; bj < 2; ++bj) { const f32x4 v0 = acc[ai][bj][m][0], v1 = acc[ai][bj][m][1];
                        u32x4 w; w.x = cvt_pk_bf16(v0[0], v0[1]); w.y = cvt_pk_bf16(v0[2], v0[3]); w.z = cvt_pk_bf16(v1[0], v1[1]); w.w = cvt_pk_bf16(v1[2], v1[3]);
                        *(u32x4*)(rowp + bj * HALF) = w; } }
        } else {
            const int q4 = 4 * (4 * wc + fq);
            f32x4 s1[2] = {(f32x4){0.f, 0.f, 0.f, 0.f}, (f32x4){0.f, 0.f, 0.f, 0.f}}, s2[2] = {(f32x4){0.f, 0.f, 0.f, 0.f}, (f32x4){0.f, 0.f, 0.f, 0.f}};
#pragma unroll
            for (int ai = 0; ai < 2; ++ai)
#pragma unroll
                for (int m = 0; m < 4; ++m) { int row = row0 + ai * HALF + m * 16; asm volatile("" : "+v"(row));
                    const int pos = row & 2047;
                    const f32x4 cs = *(const f32x4*)(CS + (unsigned)(pos * 64 + q4)), sn = *(const f32x4*)(SN + (unsigned)(pos * 64 + q4));
                    bf16_t* rowp = O + ((unsigned)row * (unsigned)ldc + (unsigned)col0);
#pragma unroll
                    for (int bj = 0; bj < 2; ++bj) { const f32x4 x1 = acc[ai][bj][m][0], x2 = acc[ai][bj][m][1]; const f32x4 o1 = x1 * cs - x2 * sn, o2 = x2 * cs + x1 * sn;
                        s1[bj] += o1; s2[bj] += o2;
                        u32x4 w; w.x = cvt_pk_bf16(o1[0], o1[1]); w.y = cvt_pk_bf16(o1[2], o1[3]); w.z = cvt_pk_bf16(o2[0], o2[1]); w.w = cvt_pk_bf16(o2[2], o2[3]);
                        *(u32x4*)(rowp + bj * HALF) = w; }
                    asm volatile("" : "+v"(s1[0]), "+v"(s1[1]), "+v"(s2[0]), "+v"(s2[1]) :: "memory"); }
            if (u.pn >= 8) {
#pragma unroll
                for (int bj = 0; bj < 2; ++bj)
#pragma unroll
                    for (int e = 0; e < 4; ++e) { float a = s1[bj][e], b = s2[bj][e];
#pragma unroll
                        for (int o = 1; o < 16; o <<= 1) { a += __shfl_xor(a, o); b += __shfl_xor(b, o); }
                        s1[bj][e] = a; s2[bj][e] = b; }
                if (fr == 0) { const int b = u.pm >> 3, blk = u.pm & 7;
#pragma unroll
                    for (int bj = 0; bj < 2; ++bj) { const int hd = (u.pn - 8) * 2 + bj; float* kp = KS + (size_t)(((b * 16 + hd) * 8 + blk) * 128 + wc * 32 + 8 * fq);
#pragma unroll
                        for (int e = 0; e < 4; ++e) { atomicAdd(kp + e, s1[bj][e]); atomicAdd(kp + 4 + e, s2[bj][e]); } } }
            }
        }
    }
};
}

typedef unsigned short bf16_t;
#define LAS __attribute__((address_space(3)))
#define LDS_WAIT() asm volatile("s_waitcnt lgkmcnt(0)" ::: "memory")
__device__ __forceinline__ float bf2f(bf16_t b) { return __uint_as_float(((unsigned)b) << 16); }
__device__ __forceinline__ unsigned f2bf(float f) { unsigned u = __float_as_uint(f); return (u + 0x7fffu + ((u >> 16) & 1u)) >> 16; }
__device__ __forceinline__ unsigned pk2(float lo, float hi) { return f2bf(lo) | (f2bf(hi) << 16); }
__device__ __forceinline__ float wave_sum(float v) {
#pragma unroll
    for (int o = 1; o < 64; o <<= 1) v += __shfl_xor(v, o);
    return v;
}
__device__ __forceinline__ float wave_max(float v) {
#pragma unroll
    for (int o = 1; o < 64; o <<= 1) v = fmaxf(v, __shfl_xor(v, o));
    return v;
}
__device__ __forceinline__ float sigmoidf_(float x) { return __builtin_amdgcn_rcpf(1.f + __expf(-x)); }
__device__ __forceinline__ float siluf_(float x) { return x * __builtin_amdgcn_rcpf(1.f + __expf(-x)); }

#define XB_TMO      128
#define XB_XCNT(j)  (256  + 64 * (j))
#define XB_XSUB(j)  (1280 + 64 * (j))
#define XB_XGEN(j)  (2304 + 64 * (j))
#define XB_TOP      3328
#define XB_TOPGEN   3392
#define XCD_BAR_WORDS 3456
#define XB_SPIN_CAP (1u << 18)

__device__ __forceinline__ unsigned xb_ld(unsigned* p)              { return __hip_atomic_load(p, __ATOMIC_RELAXED, __HIP_MEMORY_SCOPE_AGENT); }
__device__ __forceinline__ unsigned xb_add(unsigned* p, unsigned v) { return __hip_atomic_fetch_add(p, v, __ATOMIC_RELAXED, __HIP_MEMORY_SCOPE_AGENT); }
__device__ __forceinline__ unsigned xb_xcc_id() { return (unsigned)__builtin_amdgcn_s_getreg((3 << 11) | 20) & 0xFu; }
#define XB_SPIN(cond, bar) do { unsigned _sp = 0; while (cond) { __builtin_amdgcn_s_sleep(1); \
    if ((++_sp & 255u) == 0u) { if (xb_ld(&(bar)[XB_TMO])) break; if (_sp > XB_SPIN_CAP) { atomicAdd(&(bar)[XB_TMO], 1u); break; } } } } while (0)

struct XcdBarrier {
    unsigned* bar; unsigned x;
    volatile LAS unsigned* st;
};

__device__ __forceinline__ XcdBarrier xcd_barrier_post(unsigned* bar, volatile LAS unsigned* st) {
    XcdBarrier b; b.bar = bar; b.x = xb_xcc_id(); b.st = st;
    if (threadIdx.x == 0) (void)xb_add(&bar[XB_XCNT(b.x)], 1u);
    return b;
}
__device__ __forceinline__ void xcd_barrier_complete(unsigned* bar, unsigned x, unsigned& nloc, unsigned& nx) {
    const unsigned G = gridDim.x * gridDim.y * gridDim.z;
    unsigned sum, cnt, mine, sp = 0u;
    for (;;) {
        sum = 0u; cnt = 0u; mine = 0u;
#pragma unroll
        for (unsigned j = 0; j < 16; ++j) { const unsigned c = xb_ld(&bar[XB_XCNT(j)]); sum += c; cnt += (c > 0u) ? 1u : 0u; mine = (j == x) ? c : mine; }
        if (sum == G) break;
        __builtin_amdgcn_s_sleep(1);
        if ((++sp & 255u) == 0u) { if (xb_ld(&bar[XB_TMO])) break; if (sp > XB_SPIN_CAP) { atomicAdd(&bar[XB_TMO], 1u); break; } }
    }
    nloc = mine > 0u ? mine : 1u; nx = cnt > 0u ? cnt : 1u;
}

__device__ __forceinline__ void xcd_barrier(const XcdBarrier& b) {
    asm volatile("s_waitcnt vmcnt(0)" ::: "memory");
    __syncthreads();
    if (threadIdx.x == 0) {
        unsigned* bar = b.bar;
        __builtin_amdgcn_s_waitcnt(0);
        unsigned nloc = b.st[0], nx = b.st[1];
        if (nloc == 0u) { xcd_barrier_complete(bar, b.x, nloc, nx); b.st[0] = nloc; b.st[1] = nx; }
        const unsigned old = xb_add(&bar[XB_XSUB(b.x)], 1u);
        const unsigned gen = old / nloc;
        if (old + 1u == (gen + 1u) * nloc) {
            __builtin_amdgcn_fence(__ATOMIC_RELEASE, "agent");
            asm volatile("s_waitcnt vmcnt(0)" ::: "memory");
            const unsigned og = xb_add(&bar[XB_TOP], 1u);
            const unsigned tg = og / nx;
            if (og + 1u == (tg + 1u) * nx) xb_add(&bar[XB_TOPGEN], 1u);
            else XB_SPIN(xb_ld(&bar[XB_TOPGEN]) == tg, bar);
            __builtin_amdgcn_fence(__ATOMIC_ACQUIRE, "agent");
            xb_add(&bar[XB_XGEN(b.x)], 1u);
            asm volatile("s_waitcnt vmcnt(0)" ::: "memory");
        } else {
            XB_SPIN(xb_ld(&bar[XB_XGEN(b.x)]) == gen, bar);
            __builtin_amdgcn_fence(__ATOMIC_ACQUIRE, "agent");
            asm volatile("s_waitcnt vmcnt(0)" ::: "memory");
        }
    }
    __syncthreads();
}

namespace mb {
using bf16x8 = __attribute__((ext_vector_type(8))) short;
using s16x4  = __attribute__((ext_vector_type(4))) short;
using f32x16 = __attribute__((ext_vector_type(16))) float;
using u32x4  = __attribute__((ext_vector_type(4))) unsigned;
constexpr int   D = 128, NW = 8, QBLK = 32, KVBLK = 64, LD = 26624  , LDO = 2048  ;
constexpr float SCALE = 0.088388347648318440f, THR = 8.f, NEG = -1e30f;
constexpr int SHM_V = KVBLK * D * 2, SHM_K = KVBLK * D * 2, SHM_ATTN = 2 * SHM_V + 2 * SHM_K + NW * 64 * 4;
#define KSWZ(row, colB) ((row) * 256 + ((colB) ^ (((row) & 7) << 4)))
#define SBAR() __builtin_amdgcn_sched_barrier(0)
__device__ __forceinline__ int crow(int r, int hi) { return (r & 3) + 8 * (r >> 2) + 4 * hi; }
__device__ __forceinline__ unsigned cvtpk(float lo, float hi) { typedef __bf16 bf2_ __attribute__((ext_vector_type(2))); typedef float f2_ __attribute__((ext_vector_type(2))); const f2_ f = {lo, hi}; return __builtin_bit_cast(unsigned, __builtin_convertvector(f, bf2_)); }
__device__ __forceinline__ void partialSM(f32x16& p0, f32x16& p1, float& m_reg, float& mn, float& alpha) {
  constexpr float C = SCALE * 1.4426950408889634f;
  float pmax = p0[0]; for (int r = 1; r < 16; ++r) pmax = fmaxf(pmax, p0[r]); for (int r = 0; r < 16; ++r) pmax = fmaxf(pmax, p1[r]);
  { auto rr = __builtin_amdgcn_permlane32_swap(__float_as_uint(pmax), __float_as_uint(pmax), false, false);
    pmax = fmaxf(__uint_as_float(rr[0]), __uint_as_float(rr[1])); }
  if (__builtin_expect(__all(pmax - m_reg <= THR / SCALE), 1)) { mn = m_reg; alpha = 1.f; }
  else { mn = fmaxf(m_reg, pmax); alpha = __builtin_amdgcn_exp2f((m_reg - mn) * C); m_reg = mn; }
  float mnC = -mn * C;
  for (int r = 0; r < 16; ++r) p0[r] = fmaf(p0[r], C, mnC); for (int r = 0; r < 16; ++r) p1[r] = fmaf(p1[r], C, mnC);
  for (int r = 0; r < 16; ++r) p0[r] = __builtin_amdgcn_exp2f(p0[r]);
}
__device__ __forceinline__ void finishSM(f32x16& p0, f32x16& p1, float alpha, float& l_reg, bf16x8& pa0, bf16x8& pa1, bf16x8& pa2, bf16x8& pa3) {
  for (int r = 0; r < 16; ++r) p1[r] = __builtin_amdgcn_exp2f(p1[r]);
  float ps = 0; for (int r = 0; r < 16; ++r) ps += p0[r]; for (int r = 0; r < 16; ++r) ps += p1[r];
  { auto rr = __builtin_amdgcn_permlane32_swap(__float_as_uint(ps), __float_as_uint(ps), false, false);
    ps = __uint_as_float(rr[0]) + __uint_as_float(rr[1]); }
  l_reg = l_reg * alpha + ps;
#define PK4(P, BASE, OUT) do { unsigned a0 = cvtpk(P[BASE + 0], P[BASE + 1]), a1 = cvtpk(P[BASE + 2], P[BASE + 3]);   \
    unsigned b0 = cvtpk(P[BASE + 4], P[BASE + 5]), b1 = cvtpk(P[BASE + 6], P[BASE + 7]);                              \
    auto r0 = __builtin_amdgcn_permlane32_swap(a0, b0, false, false); auto r1 = __builtin_amdgcn_permlane32_swap(a1, b1, false, false); \
    u32x4 w = {r0[0], r1[0], r0[1], r1[1]}; OUT = *reinterpret_cast<bf16x8*>(&w); } while (0)
  PK4(p0, 0, pa0); PK4(p0, 8, pa1); PK4(p1, 0, pa2); PK4(p1, 8, pa3);
#undef PK4
}
__device__ __forceinline__ void qkt(f32x16& p0, f32x16& p1, const char* Ks, const bf16x8* qr, const int (&kb4)[4]) {
  p0 = f32x16{}; p1 = f32x16{};
#pragma unroll
  for (int d0 = 0; d0 < 8; ++d0) {
    bf16x8 b0 = *reinterpret_cast<const bf16x8*>(Ks + kb4[d0 & 3] + (d0 >> 2) * 128);
    bf16x8 b1 = *reinterpret_cast<const bf16x8*>(Ks + kb4[d0 & 3] + (d0 >> 2) * 128 + 32 * 256);
    p0 = __builtin_amdgcn_mfma_f32_32x32x16_bf16(b0, qr[d0], p0, 0, 0, 0);
    p1 = __builtin_amdgcn_mfma_f32_32x32x16_bf16(b1, qr[d0], p1, 0, 0, 0); }
}
__device__ __forceinline__ int v_st(int k, int c) { const int kk = (k & ~0xC) | ((k & 4) << 1) | ((k & 8) >> 1); return ((kk >> 3) * 4 + (c >> 5)) * 512 + ((kk & 7) * 32 + (c & 31)) * 2; }
__device__ __forceinline__ int v_rd_base(int lane) { return ((lane & 3) << 3) | (((lane >> 2) & 3) << 6) | (((lane >> 4) & 1) << 5) | (((lane >> 5) & 1) << 8); }
constexpr int v_rd_off(int d0, int ks, int half) { return d0 * 512 + ks * 4096 + half * 2048; }
template <int OFF> __device__ __forceinline__ s16x4 tr_read(int vb) {
  s16x4 r; asm volatile("ds_read_b64_tr_b16 %0, %1 offset:%2" : "=&v"(r) : "v"(vb), "i"(OFF) : "memory"); return r;
}
template <int D0> __device__ __forceinline__ void pv_one(f32x16& od, int vb, bf16x8 pa0, bf16x8 pa1, bf16x8 pa2, bf16x8 pa3) {
  const s16x4 l0 = tr_read<v_rd_off(D0, 0, 0)>(vb), h0 = tr_read<v_rd_off(D0, 0, 1)>(vb), l1 = tr_read<v_rd_off(D0, 1, 0)>(vb), h1 = tr_read<v_rd_off(D0, 1, 1)>(vb);
  const s16x4 l2 = tr_read<v_rd_off(D0, 2, 0)>(vb), h2 = tr_read<v_rd_off(D0, 2, 1)>(vb), l3 = tr_read<v_rd_off(D0, 3, 0)>(vb), h3 = tr_read<v_rd_off(D0, 3, 1)>(vb);
  asm volatile("s_waitcnt lgkmcnt(0)" ::: "memory"); SBAR();
#define PK(L, H) (bf16x8){L[0], L[1], L[2], L[3], H[0], H[1], H[2], H[3]}
  od = __builtin_amdgcn_mfma_f32_32x32x16_bf16(pa0, PK(l0, h0), od, 0, 0, 0);
  od = __builtin_amdgcn_mfma_f32_32x32x16_bf16(pa1, PK(l1, h1), od, 0, 0, 0);
  od = __builtin_amdgcn_mfma_f32_32x32x16_bf16(pa2, PK(l2, h2), od, 0, 0, 0);
  od = __builtin_amdgcn_mfma_f32_32x32x16_bf16(pa3, PK(l3, h3), od, 0, 0, 0);
#undef PK
}
__device__ __forceinline__ void pv_d0(f32x16* o, int vb, bf16x8 pa0, bf16x8 pa1, bf16x8 pa2, bf16x8 pa3) {
  pv_one<0>(o[0], vb, pa0, pa1, pa2, pa3); pv_one<1>(o[1], vb, pa0, pa1, pa2, pa3); pv_one<2>(o[2], vb, pa0, pa1, pa2, pa3); pv_one<3>(o[3], vb, pa0, pa1, pa2, pa3);
}
__device__ __forceinline__ int key0(int j, int qb) { return j < 4 ? qb * 256 + j * 64 : ((j - 4) >> 2) * 256 + ((j - 4) & 3) * 64; }
__device__ __forceinline__ void mask_tile(f32x16& p0, f32x16& p1, int j, unsigned selmask, int rowb, int hi) {
  int rb = rowb; asm volatile("" : "+v"(rb));
  const int lim = (j < 4) ? (rb - 64 * j) : (((selmask >> ((j - 4) >> 2)) & 1u) ? 4096 : -4096);
  if (__all(lim >= 63)) return;
  const int limh = lim - 4 * hi;
#pragma unroll
  for (int r = 0; r < 16; ++r) { const int cr = (r & 3) + 8 * (r >> 2); p0[r] = (cr > limh) ? NEG : p0[r]; p1[r] = (cr + 32 > limh) ? NEG : p1[r]; }
}
__device__ __forceinline__ void moba_unit(const unsigned short* __restrict__ Qb, const unsigned short* __restrict__ Kh, const unsigned short* __restrict__ Vh,
                                          unsigned short* __restrict__ Ob, const float* __restrict__ KS, int qb, char* lds) {
  int tid_ = threadIdx.x; asm volatile("" : "+v"(tid_));
  const int tid = tid_, wid = tid >> 6, lane = tid & 63, r32 = lane & 31, hi = lane >> 5;
  char* V_lds = lds; char* K_lds = lds + 2 * SHM_V;
  float* ws = (float*)(lds + 2 * SHM_V + 2 * SHM_K) + wid * 64; float* li_l = ws; float* al_l = ws + 32;
  float m_reg = NEG, l_reg = 0; f32x16 o[4] = {}; bf16x8 qr[8];
  const unsigned short* Qw = Qb + (long)(wid * QBLK + r32) * LD + hi * 8;
#pragma unroll
  for (int d0 = 0; d0 < 8; ++d0) qr[d0] = *reinterpret_cast<const bf16x8*>(Qw + d0 * 16);
  unsigned selmask = 0u;
  {
    float gate[8];
#pragma unroll
    for (int n = 0; n < 8; ++n) { float g = 0.f;
      if (n < qb) {
#pragma unroll
        for (int d0 = 0; d0 < 8; ++d0) { const float4 k0 = *(const float4*)(KS + n * 128 + d0 * 16 + hi * 8), k1 = *(const float4*)(KS + n * 128 + d0 * 16 + hi * 8 + 4);
          const u32x4 qw = *reinterpret_cast<const u32x4*>(&qr[d0]);
          g += __uint_as_float(qw[0] << 16) * k0.x + __uint_as_float(qw[0] & 0xffff0000u) * k0.y + __uint_as_float(qw[1] << 16) * k0.z + __uint_as_float(qw[1] & 0xffff0000u) * k0.w
             + __uint_as_float(qw[2] << 16) * k1.x + __uint_as_float(qw[2] & 0xffff0000u) * k1.y + __uint_as_float(qw[3] << 16) * k1.z + __uint_as_float(qw[3] & 0xffff0000u) * k1.w; }
        g += __shfl_xor(g, 32); }
      gate[n] = (n < qb) ? g : -INFINITY; }
#pragma unroll
    for (int r = 0; r < 3; ++r) { float best = -INFINITY; int bi = -1;
#pragma unroll
      for (int n = 0; n < 8; ++n) { const bool ok = !((selmask >> n) & 1u) && gate[n] > best; if (ok) { best = gate[n]; bi = n; } }
      if (bi >= 0) selmask |= 1u << bi; }
  }
  const int rowb = wid * QBLK + r32;
  int kb4[4];
#pragma unroll
  for (int q = 0; q < 4; ++q) kb4[q] = r32 * 256 + (((q << 5) | (hi << 4)) ^ ((r32 & 7) << 4));
  const int sr = tid >> 4, sc = (tid & 15) * 8, vst0 = v_st(sr, sc), vst1 = v_st(32 + sr, sc);
  const int vb0 = (int)(uintptr_t)V_lds + v_rd_base(lane);
  struct { bf16x8 vs0, vs1, ks0, ks1; } sr_[1];
  const unsigned voff = (unsigned)((sr * LD + sc) * 2);
#define SLOAD(i, k0) do { const char* vb_ = (const char*)Vh + (size_t)(k0) * (LD * 2); const char* kb_ = (const char*)Kh + (size_t)(k0) * (LD * 2); \
    sr_[i].vs0 = *reinterpret_cast<const bf16x8*>(vb_ + voff); sr_[i].vs1 = *reinterpret_cast<const bf16x8*>(vb_ + 32 * LD * 2 + voff); \
    sr_[i].ks0 = *reinterpret_cast<const bf16x8*>(kb_ + voff); sr_[i].ks1 = *reinterpret_cast<const bf16x8*>(kb_ + 32 * LD * 2 + voff); } while (0)
#define SWRITE(b, i) do { *(bf16x8*)(V_lds + (b) * SHM_V + vst0) = sr_[i].vs0;          \
    *(bf16x8*)(V_lds + (b) * SHM_V + vst1) = sr_[i].vs1; int kc = sc * 2;               \
    *(bf16x8*)(K_lds + (b) * SHM_K + KSWZ(sr, kc)) = sr_[i].ks0;                       \
    *(bf16x8*)(K_lds + (b) * SHM_K + KSWZ(32 + sr, kc)) = sr_[i].ks1; } while (0)
#define SWAIT() asm volatile("s_waitcnt vmcnt(0)" ::: "memory")
#define RESC(a) do { if (__any((a) < 1.f)) { if (hi == 0) al_l[r32] = (a); asm volatile("s_waitcnt lgkmcnt(0)" ::: "memory"); \
    for (int d = 0; d < 4; ++d) for (int r = 0; r < 16; ++r) o[d][r] *= al_l[crow(r, hi)]; } } while (0)
  f32x16 pA0, pA1, pB0, pB1; float mnA, mnB, alA, alB; bf16x8 pa0, pa1, pa2, pa3; const int NT = 4 * (qb + 1);
  constexpr int SE = 0, SO = 0;
  SLOAD(SE, key0(0, qb)); asm volatile("s_waitcnt vmcnt(0)" ::: "memory"); SWRITE(0, SE); __syncthreads();
  qkt(pA0, pA1, K_lds, qr, kb4); mask_tile(pA0, pA1, 0, selmask, rowb, hi); partialSM(pA0, pA1, m_reg, mnA, alA);
  SLOAD(SO, key0(1, qb));
  SWAIT(); SWRITE(1, SO); __syncthreads();
  for (int j = 1; j + 1 < NT; j += 2) {
    SBAR(); qkt(pB0, pB1, K_lds + SHM_K, qr, kb4);
    finishSM(pA0, pA1, alA, l_reg, pa0, pa1, pa2, pa3); SBAR();
    SLOAD(SO, key0(j + 1, qb)); SBAR();
    pv_d0(o, vb0, pa0, pa1, pa2, pa3); mask_tile(pB0, pB1, j, selmask, rowb, hi); partialSM(pB0, pB1, m_reg, mnB, alB);
    __syncthreads(); SWAIT(); SWRITE(0, SE);
    RESC(alB); __syncthreads();
    SBAR(); qkt(pA0, pA1, K_lds, qr, kb4);
    finishSM(pB0, pB1, alB, l_reg, pa0, pa1, pa2, pa3); SBAR();
    SLOAD(SE, key0(j + 2, qb)); SBAR();
    pv_d0(o, vb0 + (int)SHM_V, pa0, pa1, pa2, pa3); mask_tile(pA0, pA1, j + 1, selmask, rowb, hi); partialSM(pA0, pA1, m_reg, mnA, alA);
    __syncthreads(); SWAIT(); SWRITE(1, SO);
    RESC(alA); __syncthreads();
  }
  SBAR(); qkt(pB0, pB1, K_lds + SHM_K, qr, kb4);
  finishSM(pA0, pA1, alA, l_reg, pa0, pa1, pa2, pa3); SBAR();
  pv_d0(o, vb0, pa0, pa1, pa2, pa3); mask_tile(pB0, pB1, NT - 1, selmask, rowb, hi); partialSM(pB0, pB1, m_reg, mnB, alB);
  __syncthreads(); RESC(alB);
  finishSM(pB0, pB1, alB, l_reg, pa0, pa1, pa2, pa3); SBAR();
  pv_d0(o, vb0 + (int)SHM_V, pa0, pa1, pa2, pa3);
  if (hi == 0) li_l[r32] = l_reg; asm volatile("s_waitcnt lgkmcnt(0)" ::: "memory");
  float rli[16];
#pragma unroll
  for (int r = 0; r < 16; ++r) rli[r] = __builtin_amdgcn_rcpf(li_l[crow(r, hi)]);
  unsigned ooff = (unsigned)((wid * QBLK + 4 * hi) * LDO + r32); asm volatile("" : "+v"(ooff));
#pragma unroll
  for (int r = 0; r < 16; ++r) { const int cr = (r & 3) + 8 * (r >> 2);
#pragma unroll
    for (int d0 = 0; d0 < 4; ++d0) { const float v = o[d0][r] * rli[r]; unsigned u = __float_as_uint(v); u = (u + 0x7fffu + ((u >> 16) & 1u)) >> 16; Ob[ooff + (unsigned)(cr * LDO + d0 * 32)] = (unsigned short)u; } }
  asm volatile("s_waitcnt lgkmcnt(0)" ::: "memory"); __syncthreads();
#undef SLOAD
#undef SWRITE
#undef SWAIT
#undef RESC
}
#undef KSWZ
#undef SBAR
}

namespace gf {
typedef short bf16x8 __attribute__((ext_vector_type(8)));
typedef short s16x4 __attribute__((ext_vector_type(4)));
typedef float f32x4 __attribute__((ext_vector_type(4)));
typedef unsigned u32x2 __attribute__((ext_vector_type(2)));
typedef unsigned u32x4 __attribute__((ext_vector_type(4)));
#define GF_LAS __attribute__((address_space(3)))
constexpr int PK = 528, PV = 272, PJ = 144;
constexpr int L_QD = 0, L_KI = 64 * PK, L_VV = 2 * 64 * PK, L_PP = L_VV + 64 * PV, L_DEC = L_PP + 64 * PJ, L_END = L_DEC + 1024;
constexpr int L_SSX = 131072 + 1024, PSX = 144, L_RS = L_SSX + 64 * 144;
static_assert(L_END <= 131072 && L_RS + 256 <= 147456, "fused GLA LDS map");
constexpr float GF_EPS = 1e-6f;
constexpr unsigned GF_SPIN_CAP = 1u << 16;
__device__ __forceinline__ unsigned cvtpk(float lo, float hi) { typedef __bf16 bf2_ __attribute__((ext_vector_type(2))); typedef float f2_ __attribute__((ext_vector_type(2))); const f2_ f = {lo, hi}; return __builtin_bit_cast(unsigned, __builtin_convertvector(f, bf2_)); }
__device__ __forceinline__ s16x4 trrd(int addr) { s16x4 r; asm volatile("ds_read_b64_tr_b16 %0, %1" : "=&v"(r) : "v"(addr) : "memory"); return r; }
template <int OFF> __device__ __forceinline__ s16x4 trrdo(int addr) { static_assert(OFF >= 0 && OFF < 65536, "ds offset"); s16x4 r; asm volatile("ds_read_b64_tr_b16 %0, %1 offset:%2" : "=&v"(r) : "v"(addr), "n"(OFF) : "memory"); return r; }
#define GF_FRAG(base, row, pitch, kbyte) (*(const GF_LAS bf16x8*)((base) + (row) * (pitch) + (kbyte)))

__device__ __forceinline__ void fused_unit(const unsigned short* __restrict__ Qd, const unsigned short* __restrict__ Ki, const unsigned short* __restrict__ V, int ldv,
                                           const unsigned short* __restrict__ SGR, int ldsgr, const float* __restrict__ DEC, const float* __restrict__ gn, unsigned short* __restrict__ Out, int ldo,
                                           float* SSQh, int dvs, GF_LAS unsigned char* lds) {
    int tid = threadIdx.x; asm volatile("" : "+v"(tid));
    const int w = __builtin_amdgcn_readfirstlane(tid >> 6); int lane = tid & 63, l15 = lane & 15, g = lane >> 4;
    const int ldsb = (int)(unsigned)(size_t)lds;
    int tr_r = 8 * g + (l15 >> 2), tr_c = 8 * (l15 & 3);
    f32x4 S[16];
#pragma unroll
    for (int tt = 0; tt < 16; ++tt) S[tt] = (f32x4){0.f, 0.f, 0.f, 0.f};
    const f32x4 g4 = *(const f32x4*)(gn + 16 * w + 4 * g);
    u32x4 rq[4], rk[4], rv[2]; float rd = 0.f;
    unsigned vq = (unsigned)(((tid >> 5) * 2048 + 8 * (tid & 31)) * 2), vv = (unsigned)(((tid >> 4) * ldv + 8 * (tid & 15)) * 2), vs = (unsigned)((l15 * ldsgr + 4 * g) * 2), vo = (unsigned)((l15 * ldo + 4 * g) * 2);
    int lq = (tid >> 5) * PK + 16 * (tid & 31), lv = (tid >> 4) * PV + 16 * (tid & 15);
#define GF_LOAD_Q(c) do { _Pragma("unroll") for (int q = 0; q < 4; ++q) rq[q] = *(const u32x4*)((const char*)Qd + (size_t)((c) * 64 + 16 * q) * 4096 + vq); } while (0)
#define GF_LOAD_K(c) do { _Pragma("unroll") for (int q = 0; q < 4; ++q) rk[q] = *(const u32x4*)((const char*)Ki + (size_t)((c) * 64 + 16 * q) * 4096 + vq); } while (0)
#define GF_LOAD_V(c) do { _Pragma("unroll") for (int q = 0; q < 2; ++q) rv[q] = *(const u32x4*)((const char*)V + (size_t)((c) * 64 + 32 * q) * (size_t)(2 * ldv) + vv); \
        if (tid < 256) rd = *(const float*)((const char*)DEC + (size_t)((c) > 0 ? (c) - 1 : 0) * 8192 + 4u * (unsigned)tid); } while (0)
#define GF_LOAD(c) do { GF_LOAD_Q(c); GF_LOAD_K(c); GF_LOAD_V(c); } while (0)
    u32x2 ovp[4], ovq[4]; float ssp = 0.f, ssq = 0.f, pv = 0.f;
#pragma unroll
    for (int it = 0; it < 4; ++it) { ovp[it] = (u32x2){0u, 0u}; ovq[it] = (u32x2){0u, 0u}; }
#define GF_RSTD(CH_) do { const int sl_ = (lane >> 3) & 3, tk_ = 8 * w + (lane & 7); const float* sp_ = SSQh + (size_t)(CH_) * 256 + 64 * sl_ + tk_; float p_ = (sl_ == dvs) ? ssq : pv; \
        for (unsigned n_ = 0; n_ < GF_SPIN_CAP && !(p_ >= 0.f); ++n_) { __builtin_amdgcn_s_sleep(1); p_ = __hip_atomic_load(sp_, __ATOMIC_RELAXED, __HIP_MEMORY_SCOPE_AGENT); } \
        p_ = p_ + __shfl_xor(p_, 8); p_ = p_ + __shfl_xor(p_, 16); \
        if ((lane >> 3) == 0) *(GF_LAS float*)(lds + L_RS + 4 * tk_) = rsqrtf(p_ * (1.f / 512.f) + GF_EPS); } while (0)
#define GF_PUBLISH(CH_) do { if ((lane >> 3) == 0) __hip_atomic_store(SSQh + (size_t)(CH_) * 256 + 64 * dvs + 8 * w + (lane & 7), ssp, __ATOMIC_RELAXED, __HIP_MEMORY_SCOPE_AGENT); } while (0)
#define GF_PEEK(CH_) do { pv = __hip_atomic_load(SSQh + (size_t)(CH_) * 256 + 64 * ((lane >> 3) & 3) + 8 * w + (lane & 7), __ATOMIC_RELAXED, __HIP_MEMORY_SCOPE_AGENT); } while (0)
#define GF_FINAL(CH_) do { _Pragma("unroll") for (int it = 0; it < 4; ++it) { const float rs_ = *(const GF_LAS float*)(lds + L_RS + 4 * (16 * it + l15)); u32x2 o_; \
            o_.x = cvtpk(__uint_as_float(ovq[it].x << 16) * rs_, __uint_as_float(ovq[it].x & 0xffff0000u) * rs_); o_.y = cvtpk(__uint_as_float(ovq[it].y << 16) * rs_, __uint_as_float(ovq[it].y & 0xffff0000u) * rs_); \
            *(u32x2*)((char*)Out + ((size_t)((CH_) * 64 + 16 * it) * ldo + 16 * w) * 2 + vo) = o_; } } while (0)
    GF_LOAD(0);
    for (int c = 0; c < 32; ++c) {
        { int t_ = threadIdx.x; asm volatile("" : "+v"(t_)); tid = t_; lane = t_ & 63; l15 = lane & 15; g = lane >> 4; tr_r = 8 * g + (l15 >> 2); tr_c = 8 * (l15 & 3);
          vq = (unsigned)(((tid >> 5) * 2048 + 8 * (tid & 31)) * 2); vv = (unsigned)(((tid >> 4) * ldv + 8 * (tid & 15)) * 2); vs = (unsigned)((l15 * ldsgr + 4 * g) * 2); vo = (unsigned)((l15 * ldo + 4 * g) * 2);
          lq = (tid >> 5) * PK + 16 * (tid & 31); lv = (tid >> 4) * PV + 16 * (tid & 15); }
#pragma unroll
        for (int q = 0; q < 4; ++q) { *(GF_LAS u32x4*)(lds + L_QD + 16 * q * PK + lq) = rq[q]; *(GF_LAS u32x4*)(lds + L_KI + 16 * q * PK + lq) = rk[q]; }
#pragma unroll
        for (int q = 0; q < 2; ++q) *(GF_LAS u32x4*)(lds + L_VV + 32 * q * PV + lv) = rv[q];
        if (tid < 256) *(GF_LAS float*)(lds + L_DEC + 4 * tid) = rd;
        if (c > 0) GF_PUBLISH(c - 1);
        if (c > 1) GF_RSTD(c - 2);
        u32x2 sg[4];
#pragma unroll
        for (int it = 0; it < 4; ++it) sg[it] = *(const u32x2*)((const char*)SGR + ((size_t)(c * 64 + 16 * it) * ldsgr + 16 * w) * 2 + vs);
        if (c + 1 < 32) GF_LOAD_Q(c + 1);
        asm volatile("s_waitcnt lgkmcnt(0)" ::: "memory"); __syncthreads();
        if (c > 1) GF_FINAL(c - 2);
#pragma unroll
        for (int it = 0; it < 4; ++it) ovq[it] = ovp[it];
        ssq = ssp;
        { const int it = w >> 1; f32x4 pa[2] = {(f32x4){0.f, 0.f, 0.f, 0.f}, (f32x4){0.f, 0.f, 0.f, 0.f}};
          bf16x8 pq[8], pk[8][2];
#define GF_LP(k_) do { pq[k_] = GF_FRAG(lds + L_QD, 16 * it + l15, PK, 64 * (k_) + 16 * g); pk[k_][0] = GF_FRAG(lds + L_KI, 16 * (2 * (w & 1)) + l15, PK, 64 * (k_) + 16 * g); \
              pk[k_][1] = GF_FRAG(lds + L_KI, 16 * (2 * (w & 1) + 1) + l15, PK, 64 * (k_) + 16 * g); } while (0)
          GF_LP(0); GF_LP(1);
#pragma unroll
          for (int ks = 0; ks < 8; ++ks) {
              if (ks + 2 < 8) GF_LP(ks + 2);
              __builtin_amdgcn_sched_barrier(0);
#pragma unroll
              for (int jj = 0; jj < 2; ++jj) pa[jj] = __builtin_amdgcn_mfma_f32_16x16x32_bf16(pk[ks][jj], pq[ks], pa[jj], 0, 0, 0);
              __builtin_amdgcn_sched_barrier(0); }
#undef GF_LP
#pragma unroll
          for (int jj = 0; jj < 2; ++jj) { const int i = 16 * it + l15, j0 = 16 * (2 * (w & 1) + jj) + 4 * g; f32x4 v = pa[jj];
#pragma unroll
              for (int r = 0; r < 4; ++r) v[r] = (j0 + r <= i) ? v[r] : 0.f;
              u32x2 o; o.x = cvtpk(v[0], v[1]); o.y = cvtpk(v[2], v[3]); *(GF_LAS u32x2*)(lds + L_PP + i * PJ + 2 * j0) = o; } }
        if (c + 1 < 32) GF_LOAD_K(c + 1);
        asm volatile("s_waitcnt lgkmcnt(0)" ::: "memory"); __syncthreads();
        bf16x8 vf[2];
        { const int a0 = ldsb + L_VV + tr_r * PV + 2 * (16 * w) + tr_c;
          const s16x4 x0 = trrd(a0), x1 = trrd(a0 + 4 * PV), x2 = trrd(a0 + 32 * PV), x3 = trrd(a0 + 36 * PV);
          asm volatile("s_waitcnt lgkmcnt(0)" ::: "memory"); __builtin_amdgcn_sched_barrier(0);
          vf[0] = (bf16x8){x0[0], x0[1], x0[2], x0[3], x1[0], x1[1], x1[2], x1[3]}; vf[1] = (bf16x8){x2[0], x2[1], x2[2], x2[3], x3[0], x3[1], x3[2], x3[3]}; }
        f32x4 oa[4];
#pragma unroll
        for (int it = 0; it < 4; ++it) oa[it] = (f32x4){0.f, 0.f, 0.f, 0.f};
#pragma unroll
        for (int ks = 0; ks < 2; ++ks)
#pragma unroll
            for (int it = 0; it < 4; ++it) { const bf16x8 pf = GF_FRAG(lds + L_PP, 16 * it + l15, PJ, 64 * ks + 16 * g); oa[it] = __builtin_amdgcn_mfma_f32_16x16x32_bf16(vf[ks], pf, oa[it], 0, 0, 0); }
        if (c + 1 < 32) GF_LOAD_V(c + 1);
        { const int cp = c > 0 ? c - 1 : 0; GF_PEEK(cp); }
        if (c > 0) {
            u32x4 qf[8][4];
            f32x4 dq[8][2];
#define GF_LQ(s_) do { _Pragma("unroll") for (int it = 0; it < 4; ++it) { const GF_LAS unsigned char* qp = lds + L_QD + (16 * it + l15) * PK + 2 * (32 * (s_) + 4 * g); \
                const u32x2 q0 = *(const GF_LAS u32x2*)qp, q1 = *(const GF_LAS u32x2*)(qp + 32); qf[s_][it] = (u32x4){q0.x, q0.y, q1.x, q1.y}; } \
                dq[s_][0] = *(const GF_LAS f32x4*)(lds + L_DEC + 4 * (16 * (2 * (s_)) + 4 * g)); dq[s_][1] = *(const GF_LAS f32x4*)(lds + L_DEC + 4 * (16 * (2 * (s_) + 1) + 4 * g)); } while (0)
            GF_LQ(0); GF_LQ(1);
#pragma unroll
            for (int s = 0; s < 8; ++s) {
                if (s + 2 < 8) GF_LQ(s + 2);
                __builtin_amdgcn_sched_barrier(0);
                { float z_ = 0.f; asm volatile("" : "+v"(z_));
                  _Pragma("unroll") for (int h = 0; h < 2; ++h) { f32x4 t = S[2 * s + h]; const f32x4 d = dq[s][h]; t[0] = t[0] * d[0]; t[1] = __builtin_fmaf(t[1], d[1], z_); t[2] = t[2] * d[2]; t[3] = __builtin_fmaf(t[3], d[3], z_); S[2 * s + h] = t; } }
                u32x4 sw; sw.x = cvtpk(S[2 * s][0], S[2 * s][1]); sw.y = cvtpk(S[2 * s][2], S[2 * s][3]); sw.z = cvtpk(S[2 * s + 1][0], S[2 * s + 1][1]); sw.w = cvtpk(S[2 * s + 1][2], S[2 * s + 1][3]);
                const bf16x8 sf = __builtin_bit_cast(bf16x8, sw);
#pragma unroll
                for (int it = 0; it < 4; ++it) oa[it] = __builtin_amdgcn_mfma_f32_16x16x32_bf16(sf, __builtin_bit_cast(bf16x8, qf[s][it]), oa[it], 0, 0, 0);
                __builtin_amdgcn_sched_barrier(0); }
#undef GF_LQ
        }
#define GF_TR4(T4_, U_) x[U_][0] = trrdo<2 * 16 * (4 * T4_ + U_)>(a0); x[U_][1] = trrdo<2 * 16 * (4 * T4_ + U_) + 4 * PK>(a0); x[U_][2] = trrdo<2 * 16 * (4 * T4_ + U_) + 32 * PK>(a0); x[U_][3] = trrdo<2 * 16 * (4 * T4_ + U_) + 36 * PK>(a0);
#define GF_SUPD(T4_) { s16x4 x[4][4]; const int a0 = ldsb + L_KI + tr_r * PK + tr_c;         \
            GF_TR4(T4_, 0) GF_TR4(T4_, 1) GF_TR4(T4_, 2) GF_TR4(T4_, 3) \
            asm volatile("s_waitcnt lgkmcnt(0)" ::: "memory"); __builtin_amdgcn_sched_barrier(0); \
            _Pragma("unroll") for (int u = 0; u < 4; ++u) { const int tt = 4 * T4_ + u; \
                const bf16x8 k0 = (bf16x8){x[u][0][0], x[u][0][1], x[u][0][2], x[u][0][3], x[u][1][0], x[u][1][1], x[u][1][2], x[u][1][3]}, k1 = (bf16x8){x[u][2][0], x[u][2][1], x[u][2][2], x[u][2][3], x[u][3][0], x[u][3][1], x[u][3][2], x[u][3][3]}; \
                f32x4 a = S[tt]; a = __builtin_amdgcn_mfma_f32_16x16x32_bf16(k0, vf[0], a, 0, 0, 0); a = __builtin_amdgcn_mfma_f32_16x16x32_bf16(k1, vf[1], a, 0, 0, 0); S[tt] = a; } }
        GF_SUPD(0) GF_SUPD(1) GF_SUPD(2) GF_SUPD(3)
#undef GF_SUPD
#undef GF_TR4
#pragma unroll
        for (int it = 0; it < 4; ++it) { const f32x4 o = oa[it]; float sq = (o[0] * o[0] + o[1] * o[1]) + (o[2] * o[2] + o[3] * o[3]);
            *(GF_LAS float*)(lds + L_SSX + (16 * it + l15) * PSX + (4 * w + g) * 4) = sq;
            float m0 = __uint_as_float(sg[it].x << 16), m1 = __uint_as_float(sg[it].x & 0xffff0000u), m2 = __uint_as_float(sg[it].y << 16), m3 = __uint_as_float(sg[it].y & 0xffff0000u);
            m0 = m0 * __builtin_amdgcn_rcpf(1.f + __expf(-m0)); m1 = m1 * __builtin_amdgcn_rcpf(1.f + __expf(-m1)); m2 = m2 * __builtin_amdgcn_rcpf(1.f + __expf(-m2)); m3 = m3 * __builtin_amdgcn_rcpf(1.f + __expf(-m3));
            u32x2 ov; ov.x = cvtpk(o[0] * g4[0] * m0, o[1] * g4[1] * m1); ov.y = cvtpk(o[2] * g4[2] * m2, o[3] * g4[3] * m3);
            ovp[it] = ov; }
        asm volatile("s_waitcnt lgkmcnt(0)" ::: "memory"); __syncthreads();
        { float ws[8];
#pragma unroll
            for (int k = 0; k < 8; ++k) { const f32x4 a = *(const GF_LAS f32x4*)(lds + L_SSX + (8 * w + (lane & 7)) * PSX + 16 * k); ws[k] = (a[0] + a[1]) + (a[2] + a[3]); }
            ssp = ((ws[0] + ws[1]) + (ws[2] + ws[3])) + ((ws[4] + ws[5]) + (ws[6] + ws[7])); }
    }
    GF_PUBLISH(31); GF_RSTD(30);
    asm volatile("s_waitcnt lgkmcnt(0)" ::: "memory"); __syncthreads();
    GF_FINAL(30);
#pragma unroll
    for (int it = 0; it < 4; ++it) ovq[it] = ovp[it];
    ssq = ssp; pv = -1.f;
    __syncthreads();
    GF_RSTD(31);
    asm volatile("s_waitcnt lgkmcnt(0)" ::: "memory"); __syncthreads();
    GF_FINAL(31);
    __syncthreads();
#undef GF_RSTD
#undef GF_PUBLISH
#undef GF_PEEK
#undef GF_FINAL
#undef GF_LOAD
#undef GF_LOAD_Q
#undef GF_LOAD_K
#undef GF_LOAD_V
}
#undef GF_FRAG
}

constexpr int D_MODEL = 4096, BATCH = 4, SEQ = 2048, MTOK = BATCH * SEQ;
constexpr int IN_COLS = 26640, IN_PAD = 26624;
constexpr int OFF_MQ = 0, OFF_MK = 2048, OFF_MV = 4096, OFF_GQ = 6144, OFF_GK = 8192, OFF_GV = 10240, OFF_GR = 14336, OFF_SM = 18432, OFF_SG = 22528, GA_SRC = 18432  , GA_ROW = 26624  ;
constexpr int D_FF = 11008;
constexpr float EPS = 1e-6f;
constexpr int NWAVES = 8, NTHR = 512;
constexpr int WD_SPLIT = 256;
constexpr int LDS_BYTES = 147456, MISC_OFF = 131072;

struct Params {
    const float* in[15]; float* out; unsigned char* ws; unsigned* ctl;
    int ph_lo, ph_hi;
};
struct Ctx { int tid, lane, wave, G, bid; LAS unsigned char* lds; };

template <int MODE, int KG = 8> __device__ __forceinline__ void conv_items(const Ctx& c, const float* __restrict__ W, int K, int N, bf16_t* __restrict__ Bt, int row_off, int u_begin = 0, int u_end = 0x7fffffff) {
    LAS unsigned* scr = (LAS unsigned*)(c.lds + c.wave * 8448);
    typedef float f4v_ __attribute__((ext_vector_type(4)));
    const int lane = c.lane, cq = lane & 15, r = lane >> 4; constexpr int NG = 8 / KG; const int nblk = (N + 63) / 64, nbg = (nblk + NG - 1) / NG, nunits_all = nbg * (K / (64 * KG)), nunits = nunits_all < u_end ? nunits_all : u_end;
#define CV_COORD(U_) const int kb_ = ((U_) / nbg) * KG + (c.wave % KG), nb_ = ((U_) % nbg) * NG + (c.wave / KG); const int k0 = kb_ * 64, n0 = nb_ * 64; const bool live = ((U_) < nunits) && (nb_ < nblk); const bool ok = (n0 + 4 * cq) < N;
  \

#define CV_LOAD(v_, U_) do { const int Uc_ = ((U_) < nunits) ? (U_) : nunits - 1; int kb_ = (Uc_ / nbg) * KG + (c.wave % KG), nb_ = (Uc_ % nbg) * NG + (c.wave / KG); nb_ = nb_ < nblk ? nb_ : nblk - 1; \
        const int k0 = kb_ * 64, n0 = nb_ * 64; const bool ok = (n0 + 4 * cq) < N; const int nc_ = ok ? (n0 + 4 * cq) : (N - 4); \
        _Pragma("unroll") for (int i = 0; i < 16; ++i) { const int kk = 8 * (i >> 1) + 2 * r + (i & 1); f4v_ t_ = __builtin_nontemporal_load((const f4v_*)(W + (size_t)(k0 + kk) * N + nc_)); \
            if (!ok) t_ = (f4v_){0.f, 0.f, 0.f, 0.f}; v_[i] = t_; } } while (0)
#define CV_PROC(v_, U_) do { CV_COORD(U_) (void)ok; if (live) { \
        _Pragma("unroll") for (int m = 0; m < 8; ++m) { const int kp = 4 * m + r;         \
            scr[(4 * cq + 0) * 33 + kp] = pk2(v_[2 * m][0], v_[2 * m + 1][0]); scr[(4 * cq + 1) * 33 + kp] = pk2(v_[2 * m][1], v_[2 * m + 1][1]); \
            scr[(4 * cq + 2) * 33 + kp] = pk2(v_[2 * m][2], v_[2 * m + 1][2]); scr[(4 * cq + 3) * 33 + kp] = pk2(v_[2 * m][3], v_[2 * m + 1][3]); } \
        LDS_WAIT(); asm volatile("" ::: "memory"); \
        _Pragma("unroll") for (int ps = 0; ps < 4; ++ps) { const int nn = (lane >> 2) + 16 * ps, q = lane & 3; const LAS unsigned* sp = scr + nn * 33 + 8 * q; \
            uint4 o0, o1; o0.x = sp[0]; o0.y = sp[1]; o0.z = sp[2]; o0.w = sp[3]; o1.x = sp[4]; o1.y = sp[5]; o1.z = sp[6]; o1.w = sp[7]; \
            const int n = n0 + nn; const int drow = (MODE == 0) ? (row_off + n) : (MODE == 1) ? ((n >> 7) * 256 + (n & 127) + row_off) : ((n < 4096) ? ((n & ~127) + 8 * ((n & 63) >> 2) + 4 * ((n >> 6) & 1) + (n & 3)) : (n < GA_SRC) ? n : (n < GA_SRC + 16) ? (GA_ROW + n - GA_SRC) : (n - 16)) + row_off; \
            if (n < N) { uint4* dp = (uint4*)(Bt + (size_t)drow * K + k0 + 16 * q); dp[0] = o0; dp[1] = o1; } } \
        LDS_WAIT(); asm volatile("" ::: "memory"); } } while (0)
    f4v_ va[16], vb[16];
    CV_LOAD(va, u_begin + c.bid);
    for (int U = u_begin + c.bid; U < nunits; U += 2 * c.G) {
        CV_LOAD(vb, U + c.G);
        CV_PROC(va, U);
        CV_LOAD(va, U + 2 * c.G);
        CV_PROC(vb, U + c.G);
    }
#undef CV_COORD
#undef CV_LOAD
#undef CV_PROC
}
__device__ __forceinline__ void rmsnorm_rows_bf16(const Ctx& c, const float* __restrict__ x, const float* __restrict__ g, bf16_t* __restrict__ out) {
    typedef float f4v_ __attribute__((ext_vector_type(4)));
    const int lane = c.lane, stride = c.G * NWAVES; const float4* gr = (const float4*)g + lane;
#define RN_LOAD(v_, row_) do { if ((row_) < MTOK) { const f4v_* xr = (const f4v_*)(x + (size_t)(row_) * D_MODEL) + lane; _Pragma("unroll") for (int j = 0; j < 16; ++j) v_[j] = xr[64 * j]; } } while (0)
#define RN_PROC(v_, row_) do { if ((row_) < MTOK) { float s = 0.f; \
        _Pragma("unroll") for (int j = 0; j < 16; ++j) s += v_[j][0] * v_[j][0] + v_[j][1] * v_[j][1] + v_[j][2] * v_[j][2] + v_[j][3] * v_[j][3]; \
        const float rstd = rsqrtf(wave_sum(s) * (1.f / D_MODEL) + EPS); uint2* o = (uint2*)(out + (size_t)(row_) * D_MODEL) + lane; \
        _Pragma("unroll") for (int j = 0; j < 16; ++j) { const float4 gg = gr[64 * j]; uint2 w; w.x = pk2(v_[j][0] * rstd * gg.x, v_[j][1] * rstd * gg.y); w.y = pk2(v_[j][2] * rstd * gg.z, v_[j][3] * rstd * gg.w); o[64 * j] = w; \
            if ((j & 3) == 3) asm volatile("" ::: "memory"); } } } while (0)
    f4v_ va[16], vb[16];
    const int row0 = c.bid * NWAVES + c.wave; RN_LOAD(va, row0);
    for (int row = row0; row < MTOK; row += 2 * stride) { RN_LOAD(vb, row + stride); RN_PROC(va, row); RN_LOAD(va, row + 2 * stride); RN_PROC(vb, row + stride); }
#undef RN_LOAD
#undef RN_PROC
}
__device__ __forceinline__ void rope_table_phase(const Ctx& c, float* __restrict__ CS, float* __restrict__ SN) {
    for (int i = c.bid * NTHR + c.tid; i < SEQ * 64; i += c.G * NTHR) { const int j = i & 63, pos = i >> 6;
        const float inv_freq = powf(10000.f, -(float)j / 64.f); const float ang = (float)pos * inv_freq; CS[i] = cosf(ang); SN[i] = sinf(ang); }
}
__device__ __forceinline__ void gla_prep_phase(const Ctx& c, const bf16_t* __restrict__ u, const bf16_t* __restrict__ hrows, const bf16_t* __restrict__ wga, const float* __restrict__ up, const float* __restrict__ bias, float* __restrict__ DEC,
                                               bf16_t* __restrict__ Qd, bf16_t* __restrict__ Ki) {
    LAS float* ga = (LAS float*)c.lds; LAS float* gap = ga + 1024;
    for (int item = c.bid; item < (MTOK / 64) * 2; item += c.G) { const int ci = item >> 1, col = (item & 1) * 1024 + 2 * c.tid;
        __syncthreads();
        unsigned qc[16], kc[16], qn[16], kn[16];
#define PREP_LOAD(q_, k_, tb_) do { _Pragma("unroll") for (int i = 0; i < 16; ++i) { const size_t row_ = (size_t)ci * 64 + (tb_) + i; q_[i] = *(const unsigned*)(u + row_ * IN_PAD + OFF_GQ + col); k_[i] = *(const unsigned*)(u + row_ * IN_PAD + OFF_GK + col); } } while (0)
        PREP_LOAD(qc, kc, 0);
        {
            const int mt = c.wave & 3, kh = c.wave >> 2, l15 = c.lane & 15, lq = c.lane >> 4; pg8::f32x4 a4 = {0.f, 0.f, 0.f, 0.f};
            const bf16_t* hp = hrows + (size_t)(ci * 64 + 16 * mt + l15) * 4096 + 2048 * kh + 8 * lq; const bf16_t* wp = wga + (size_t)l15 * 4096 + 2048 * kh + 8 * lq;
#pragma unroll 16
            for (int ks = 0; ks < 64; ++ks) { const pg8::bf16x8 hf = *(const pg8::bf16x8*)(hp + 32 * ks), wf = *(const pg8::bf16x8*)(wp + 32 * ks); a4 = __builtin_amdgcn_mfma_f32_16x16x32_bf16(hf, wf, a4, 0, 0, 0); }
#pragma unroll
            for (int r = 0; r < 4; ++r) gap[kh * 1024 + (16 * mt + 4 * lq + r) * 16 + l15] = a4[r];
            asm volatile("s_waitcnt lgkmcnt(0)" ::: "memory"); __syncthreads();
            ga[c.tid] = gap[c.tid] + gap[1024 + c.tid]; ga[512 + c.tid] = gap[512 + c.tid] + gap[1536 + c.tid]; }
        float up0[16], up1[16];
#pragma unroll
        for (int r = 0; r < 16; ++r) { const float2 v = *(const float2*)(up + r * 2048 + col); up0[r] = v.x; up1[r] = v.y; }
        const float2 bs = *(const float2*)(bias + col);
        asm volatile("s_waitcnt lgkmcnt(0)" ::: "memory"); __syncthreads();
        float bl0 = 0.f, bl1 = 0.f;
        for (int t = 0; t < 64; ++t) { float x0 = bs.x, x1 = bs.y;
#pragma unroll
            for (int r = 0; r < 16; ++r) { const float g = ga[t * 16 + r]; x0 += g * up0[r]; x1 += g * up1[r]; }
            bl0 += (fminf(x0, 0.f) - __logf(1.f + __expf(-fabsf(x0)))) * 0.0625f; bl1 += (fminf(x1, 0.f) - __logf(1.f + __expf(-fabsf(x1)))) * 0.0625f; }
        *(float2*)(DEC + (size_t)ci * 2048 + col) = make_float2(__expf(bl0), __expf(bl1));
        float bc0 = 0.f, bc1 = 0.f;
#pragma unroll 1
        for (int tb = 0; tb < 64; tb += 16) {
            if (tb + 16 < 64) PREP_LOAD(qn, kn, tb + 16);
            asm volatile("" ::: "memory");
#pragma unroll
          for (int i = 0; i < 16; ++i) { const int t = tb + i; float x0 = bs.x, x1 = bs.y; const size_t row = (size_t)ci * 64 + t;
            const unsigned qw = qc[i], kw = kc[i];
#pragma unroll
            for (int r = 0; r < 16; ++r) { const float g = ga[t * 16 + r]; x0 += g * up0[r]; x1 += g * up1[r]; }
            bc0 += (fminf(x0, 0.f) - __logf(1.f + __expf(-fabsf(x0)))) * 0.0625f; bc1 += (fminf(x1, 0.f) - __logf(1.f + __expf(-fabsf(x1)))) * 0.0625f;
            const float q0 = __uint_as_float(qw << 16), q1 = __uint_as_float(qw & 0xffff0000u), k0 = __uint_as_float(kw << 16), k1 = __uint_as_float(kw & 0xffff0000u);
            const float e0 = __expf(bc0), e1 = __expf(bc1);
            *(unsigned*)(Qd + row * 2048 + col) = pk2(q0 * 0.0625f * e0, q1 * 0.0625f * e1);
            *(unsigned*)(Ki + row * 2048 + col) = pk2(k0 * __expf(-bc0), k1 * __expf(-bc1)); }
            asm volatile("" ::: "memory");
#pragma unroll
            for (int i = 0; i < 16; ++i) { qc[i] = qn[i]; kc[i] = kn[i]; }
        }
#undef PREP_LOAD
    }
    __syncthreads();
}
__device__ __forceinline__ void resnorm1_phase(const Ctx& c, const float* __restrict__ x, const bf16_t* y, const float* __restrict__ g1, const float* __restrict__ g2, float* __restrict__ rstd1, bf16_t* __restrict__ h2, bf16_t* x1b) {
    const int lane = c.lane;
    for (int row = c.bid * NWAVES + c.wave; row < MTOK; row += c.G * NWAVES) {
        const uint2* yr = (const uint2*)(y + (size_t)row * D_MODEL) + lane; uint2* x1o = (uint2*)(x1b + (size_t)row * D_MODEL) + lane; const float4* xr = (const float4*)(x + (size_t)row * D_MODEL) + lane;
        uint2 yw[16]; float4 v[16]; float s = 0.f;
#pragma unroll
        for (int j = 0; j < 16; ++j) yw[j] = yr[64 * j];
#pragma unroll
        for (int j = 0; j < 16; ++j) v[j] = xr[64 * j];
        asm volatile("" ::: "memory");
#pragma unroll
        for (int j = 0; j < 16; ++j) { const float a = __uint_as_float(yw[j].x << 16), b = __uint_as_float(yw[j].x & 0xffff0000u), cc = __uint_as_float(yw[j].y << 16), d = __uint_as_float(yw[j].y & 0xffff0000u); s += a * a + b * b + cc * cc + d * d; }
        const float rstd = rsqrtf(wave_sum(s) * (1.f / D_MODEL) + EPS); float s2 = 0.f;
        if (lane == 0) rstd1[row] = rstd;
#pragma unroll
        for (int j = 0; j < 16; ++j) asm volatile("" : "+v"(yw[j].x), "+v"(yw[j].y));
#pragma unroll
        for (int j = 0; j < 16; ++j) { const float4 gg = ((const float4*)g1)[lane + 64 * j];
            v[j].x = v[j].x + __uint_as_float(yw[j].x << 16) * rstd * gg.x; v[j].y = v[j].y + __uint_as_float(yw[j].x & 0xffff0000u) * rstd * gg.y;
            v[j].z = v[j].z + __uint_as_float(yw[j].y << 16) * rstd * gg.z; v[j].w = v[j].w + __uint_as_float(yw[j].y & 0xffff0000u) * rstd * gg.w;
            s2 += v[j].x * v[j].x + v[j].y * v[j].y + v[j].z * v[j].z + v[j].w * v[j].w;
            { uint2 w1; w1.x = pk2(v[j].x, v[j].y); w1.y = pk2(v[j].z, v[j].w); x1o[64 * j] = w1; }
            if ((j & 3) == 3) asm volatile("" ::: "memory"); }
        const float rstd2 = rsqrtf(wave_sum(s2) * (1.f / D_MODEL) + EPS);
        uint2* o = (uint2*)(h2 + (size_t)row * D_MODEL) + lane;
#pragma unroll
        for (int j = 0; j < 16; ++j) { const float4 gg = ((const float4*)g2)[lane + 64 * j]; uint2 w; w.x = pk2(v[j].x * rstd2 * gg.x, v[j].y * rstd2 * gg.y); w.y = pk2(v[j].z * rstd2 * gg.z, v[j].w * rstd2 * gg.w); o[64 * j] = w; if ((j & 3) == 3) asm volatile("" ::: "memory"); }
    }
}
__device__ __forceinline__ void resnorm2_phase(const Ctx& c, const bf16_t* __restrict__ x1b, const bf16_t* __restrict__ y2, const float* __restrict__ g2, float* __restrict__ out) {
    const int lane = c.lane;
    for (int row = c.bid * NWAVES + c.wave; row < MTOK; row += c.G * NWAVES) {
        const uint2* yr = (const uint2*)(y2 + (size_t)row * D_MODEL) + lane; const uint2* xr = (const uint2*)(x1b + (size_t)row * D_MODEL) + lane; float4* xo = (float4*)(out + (size_t)row * D_MODEL) + lane;
        uint2 yw[16], xw[16]; float s = 0.f;
#pragma unroll
        for (int j = 0; j < 16; ++j) yw[j] = yr[64 * j];
#pragma unroll
        for (int j = 0; j < 16; ++j) xw[j] = xr[64 * j];
        asm volatile("" ::: "memory");
#pragma unroll
        for (int j = 0; j < 16; ++j) { const float a = __uint_as_float(yw[j].x << 16), b = __uint_as_float(yw[j].x & 0xffff0000u), cc = __uint_as_float(yw[j].y << 16), d = __uint_as_float(yw[j].y & 0xffff0000u); s += a * a + b * b + cc * cc + d * d; }
        const float rstd = rsqrtf(wave_sum(s) * (1.f / D_MODEL) + EPS);
#pragma unroll
        for (int j = 0; j < 16; ++j) asm volatile("" : "+v"(yw[j].x), "+v"(yw[j].y));
#pragma unroll
        for (int j = 0; j < 16; ++j) { const float4 gg = ((const float4*)g2)[lane + 64 * j]; const uint2 xq = xw[j], y2q = yw[j];
            float4 o;
            o.x = __uint_as_float(xq.x << 16) + __uint_as_float(y2q.x << 16) * rstd * gg.x; o.y = __uint_as_float(xq.x & 0xffff0000u) + __uint_as_float(y2q.x & 0xffff0000u) * rstd * gg.y;
            o.z = __uint_as_float(xq.y << 16) + __uint_as_float(y2q.y << 16) * rstd * gg.z; o.w = __uint_as_float(xq.y & 0xffff0000u) + __uint_as_float(y2q.y & 0xffff0000u) * rstd * gg.w;
            xo[64 * j] = o; if ((j & 3) == 3) asm volatile("" ::: "memory"); }
    }
}

__device__ __forceinline__ void gla_norm_apply_phase(const Ctx& c, bf16_t* __restrict__ A, const float* __restrict__ SSQ) {
    const int lane = c.lane, stride = c.G * NWAVES;
    for (int row0 = c.bid * NWAVES + c.wave; row0 < MTOK; row0 += 4 * stride) {
        uint4 v[4][8]; float sq[4];
#pragma unroll
        for (int q = 0; q < 4; ++q) { const int row = row0 + q * stride; sq[q] = 0.f;
            if (row < MTOK) { const uint4* ar = (const uint4*)(A + (size_t)row * 4096) + lane;
#pragma unroll
                for (int j = 0; j < 8; ++j) v[q][j] = ar[64 * j];
                sq[q] = SSQ[(size_t)row * 32 + (lane & 31)]; } }
        asm volatile("" ::: "memory");
#pragma unroll
        for (int q = 0; q < 4; ++q) { const int row = row0 + q * stride;
            if (row < MTOK) { uint4* ar = (uint4*)(A + (size_t)row * 4096) + lane;
                float t = sq[q]; t += __shfl_xor(t, 1); t += __shfl_xor(t, 2); const float rr = rsqrtf(t * (1.f / 512.f) + EPS);
#pragma unroll
                for (int j = 0; j < 8; ++j) { const float rj = __int_as_float(__builtin_amdgcn_readlane(__float_as_int(rr), 4 * j)); uint4 o; const unsigned w4[4] = {v[q][j].x, v[q][j].y, v[q][j].z, v[q][j].w}; unsigned o4[4];
#pragma unroll
                    for (int e = 0; e < 4; ++e) o4[e] = pk2(__uint_as_float(w4[e] << 16) * rj, __uint_as_float(w4[e] & 0xffff0000u) * rj);
                    o.x = o4[0]; o.y = o4[1]; o.z = o4[2]; o.w = o4[3]; ar[64 * j] = o; } } }
    }
}

constexpr size_t MiB = 1u << 20;
constexpr size_t WS_CTL = 0, CTL_ZERO_BYTES = 512 * 1024;
constexpr size_t WS_KS = 128 * 1024, WS_CS = 512 * 1024;
constexpr int CW_BAR = 0, CW_QHEAD = 8192, CW_QCONV = 8192 + 64;
constexpr size_t WS_WM = 1 * MiB;
constexpr size_t WS_WG = WS_WM + (size_t)4096 * 2048 * 2;
constexpr size_t WS_WO = WS_WG + (size_t)4096 * 4096 * 2;
constexpr size_t WS_WGU = WS_WO + (size_t)4096 * 4096 * 2;
constexpr size_t WS_WD = WS_WGU + (size_t)22016 * 4096 * 2;
constexpr size_t WS_RA = WS_WD + (size_t)4096 * 11008 * 2;
constexpr size_t RA_BYTES = (size_t)IN_COLS * 4096 * 2;
constexpr size_t WS_RU = WS_RA + RA_BYTES;
constexpr size_t RU_BYTES = (size_t)MTOK * IN_PAD * 2;
constexpr size_t WS_RH = WS_RU + RU_BYTES;
constexpr size_t WS_RO = WS_RH + (size_t)MTOK * 4096 * 2;
constexpr size_t WS_AM = WS_RO + (size_t)MTOK * 4096 * 4;
constexpr size_t WS_AG = WS_AM + (size_t)MTOK * 2048 * 2;
constexpr size_t WS_MG = WS_AG + (size_t)MTOK * 4096 * 2;
constexpr size_t WS_KM = WS_MG + (size_t)MTOK * 4096 * 2;
constexpr size_t WS_HID = WS_KM + 1 * MiB;
constexpr size_t WS_ST = WS_HID;
constexpr size_t WS_END = WS_ST + (size_t)BATCH * 8 * 32 * 512 * 256 * 2;

template <class Epi> __device__ __forceinline__ void gemm_run(const Ctx& c, const bf16_t* A, const bf16_t* Bt, int M, int N, int K, const Epi& E) {
    pg8::Gemm g{A, Bt, M, N, K}; pg8::StaticOrder S; S.init(M, N, c.G, c.bid);
    pg8::gemm_phase<Epi, pg8::StaticOrder, true, true>(c.lds, g, S, E);
}
template <int EPI> __device__ __forceinline__ void gemm_call(const Ctx& c, const bf16_t* A, const bf16_t* Bt, void* C, int M, int N, int K, int ldc) {
    if constexpr (EPI == 0) { pg8::EpiBf16Plain E{(bf16_t*)C, ldc}; gemm_run(c, A, Bt, M, N, K, E); }
    else { pg8::EpiF32 E{(float*)C, ldc, nullptr}; gemm_run(c, A, Bt, M, N, K, E); }
}

__global__ void __launch_bounds__(NTHR, 2) mk_fwd(Params p) {
    extern __shared__ __attribute__((aligned(16))) unsigned char lds_raw[];
    Ctx c; c.lds = (LAS unsigned char*)lds_raw; c.tid = threadIdx.x; c.lane = c.tid & 63; c.wave = __builtin_amdgcn_readfirstlane(c.tid >> 6); c.G = gridDim.x; c.bid = blockIdx.x;
    volatile LAS unsigned* MISC = (volatile LAS unsigned*)(c.lds + MISC_OFF);
    if (c.tid < 64) MISC[c.tid] = 0u;
    __syncthreads();
    XcdBarrier bar = xcd_barrier_post(p.ctl + CW_BAR, MISC + 8);
    const int lo = p.ph_lo, hi = p.ph_hi;
#define IN(k) (lo <= (k) && (k) < hi)
#define FRESH() do { int t_ = threadIdx.x; asm volatile("" : "+v"(t_)); c.tid = t_; c.lane = t_ & 63; c.wave = __builtin_amdgcn_readfirstlane(t_ >> 6); { size_t wso_ = 0; asm volatile("" : "+s"(wso_)); ws = p.ws + wso_; } } while (0)
#define SEAM(k) do { if (IN(k)) xcd_barrier(bar); } while (0)
    unsigned char* ws = p.ws;
#define xin ((const float*)p.in[0])
#define g_premix ((const float*)p.in[1])
#define w_in ((const float*)p.in[2])
#define gate_up ((const float*)p.in[3])
#define gate_bias ((const float*)p.in[4])
#define g_glanorm ((const float*)p.in[5])
#define w_bm ((const float*)p.in[6])
#define w_bg ((const float*)p.in[7])
#define w_out ((const float*)p.in[8])
#define g_postmix ((const float*)p.in[9])
#define g_preffn ((const float*)p.in[10])
#define w_fg ((const float*)p.in[11])
#define w_fu ((const float*)p.in[12])
#define w_fd ((const float*)p.in[13])
#define g_postffn ((const float*)p.in[14])
#define outp (p.out)
#define WmT ((bf16_t*)(ws + WS_WM))
#define WgT ((bf16_t*)(ws + WS_WG))
#define WoT ((bf16_t*)(ws + WS_WO))
#define WguT ((bf16_t*)(ws + WS_WGU))
#define WdT ((bf16_t*)(ws + WS_WD))
#define WinT ((bf16_t*)(ws + WS_RA))
#define MQ ((bf16_t*)(ws + WS_RA))
#define MK (MQ + (size_t)MTOK * 2048)
#define MV (MQ + (size_t)MTOK * 2048 * 2)
#define BC ((float*)(MQ + (size_t)MTOK * 2048 * 3))
#define ymoba ((bf16_t*)(ws + WS_RA + 2 * MiB))
#define ybuf ((bf16_t*)(ws + WS_RA + 2 * MiB))
#define ubuf ((bf16_t*)(ws + WS_RU))
#define gu ((bf16_t*)(ws + WS_RU))
#define hbuf ((bf16_t*)(ws + WS_RH))
#define h2 ((bf16_t*)(ws + WS_RH))
#define Qd ((bf16_t*)(ws + WS_RO))
#define Ki (Qd + (size_t)MTOK * 2048)
#define Ke (Qd + (size_t)MTOK * 2048 * 2)
#define ygla ((float*)(ws + WS_RO))
#define y2 ((bf16_t*)(ws + WS_RO))
#define ST ((bf16_t*)(ws + WS_ST))
#define Am ((bf16_t*)(ws + WS_AM))
#define Ag ((bf16_t*)(ws + WS_AG))
#define mg ((bf16_t*)(ws + WS_MG))
#define KS ((float*)(ws + WS_KS))
#define SSQb ((float*)(ws + WS_RO + 100 * MiB))
#define RS1 ((float*)(ws + WS_KM + 524288))
#define CSt ((float*)(ws + WS_CS))
#define SNt ((float*)(ws + WS_KM))
#define DEC ((float*)(ws + WS_RA))
#define hid ((bf16_t*)(ws + WS_HID))

    if (IN(0)) { FRESH(); } if (IN(0)) {
        conv_items<2>(c, w_in, 4096, IN_COLS, WinT, 0);
                rmsnorm_rows_bf16(c, xin, g_premix, hbuf);
        rope_table_phase(c, CSt, SNt);
    }
    SEAM(0);
    if (IN(1)) { FRESH(); } if (IN(1)) { pg8::EpiIn E{ubuf, IN_PAD, CSt, SNt, KS}; gemm_run(c, hbuf, WinT, MTOK, IN_PAD, 4096, E); }
    SEAM(1);
    if (IN(2)) { FRESH(); } if (IN(2)) { gla_prep_phase(c, ubuf, hbuf, WinT + (size_t)GA_ROW * 4096, gate_up, gate_bias, DEC, Qd, Ki);
        for (int i = c.bid * NTHR + c.tid; i < MTOK * 32; i += c.G * NTHR) __hip_atomic_store(SSQb + i, -1.f, __ATOMIC_RELAXED, __HIP_MEMORY_SCOPE_AGENT); }
    SEAM(2);
    if (IN(4)) { FRESH(); } if (IN(4)) {
        const int half = c.G >> 1;
        if (c.bid < half) {
            for (int it = c.bid; it < BATCH * 8 * 4; it += half) { const int hh = it & 7, dvs = (it >> 3) & 3, b = it >> 5; const size_t t0 = (size_t)(b * SEQ);
                gf::fused_unit(Qd + t0 * 2048 + hh * 256, Ki + t0 * 2048 + hh * 256, ubuf + t0 * IN_PAD + OFF_GV + hh * 512 + dvs * 128, IN_PAD,
                               ubuf + t0 * IN_PAD + OFF_GR + hh * 512 + dvs * 128, IN_PAD, DEC + (size_t)(b * 32) * 2048 + hh * 256, g_glanorm + dvs * 128,
                               Ag + t0 * 4096 + hh * 512 + dvs * 128, 4096, SSQb + (size_t)((b * 8 + hh) * 32) * 256, dvs, c.lds); }
        }
        for (;;) { __syncthreads(); if (c.tid == 0) *(volatile LAS unsigned*)(c.lds + MISC_OFF + 64) = atomicAdd(p.ctl + CW_QHEAD, 1u); __syncthreads();
            const int it = (int)__builtin_amdgcn_readfirstlane(*(volatile LAS unsigned*)(c.lds + MISC_OFF + 64)); if (it >= BATCH * 16 * 4) break;
            const int pr = (it >> 3) & 3, hd = (it & 7) + 8 * ((it >> 5) & 1), b = it >> 6;
#pragma unroll 1
            for (int k = 0; k < 2; ++k) { const int qb = k ? 7 - pr : pr; const size_t q0 = (size_t)(b * SEQ + qb * 256) * IN_PAD + hd * 128, k0 = (size_t)(b * SEQ) * IN_PAD + hd * 128;
                mb::moba_unit(ubuf + OFF_MQ + q0, ubuf + OFF_MK + k0, ubuf + OFF_MV + k0, Am + (size_t)(b * SEQ + qb * 256) * 2048 + hd * 128, KS + (size_t)((b * 16 + hd) * 8) * 128, qb, (char*)lds_raw); } }
        if (c.bid >= half) { FRESH();
            Ctx c2 = c; c2.bid = c.bid - half; c2.G = c.G - half;
            conv_items<0>(c2, w_bg, 4096, 4096, WgT, 0); conv_items<0>(c2, w_out, 4096, 4096, WoT, 0); }
        else if (half > 0) { FRESH(); Ctx c2 = c; c2.G = half; conv_items<0>(c2, w_bm, 2048, 4096, WmT, 0); }
        for (;;) { __syncthreads(); if (c.tid == 0) *(volatile LAS unsigned*)(c.lds + MISC_OFF + 64) = atomicAdd(p.ctl + CW_QCONV, 1u); __syncthreads();
            const int q = (int)__builtin_amdgcn_readfirstlane(*(volatile LAS unsigned*)(c.lds + MISC_OFF + 64)); if (q >= 2 * 344 + WD_SPLIT / 4) break;
            FRESH(); Ctx c1 = c; c1.bid = 0; c1.G = 1;
            if (q >= 2 * 344) { const int u0 = 4 * (q - 2 * 344); conv_items<0, 4>(c1, w_fd, D_FF, 4096, WdT, 0, u0, u0 + 4); }
            else { const int up = q >= 344, u0 = 4 * (up ? q - 344 : q);
                if (up) conv_items<1>(c1, w_fu, 4096, D_FF, WguT, 128, u0, u0 + 4); else conv_items<1>(c1, w_fg, 4096, D_FF, WguT, 0, u0, u0 + 4); } }
    }
    SEAM(4);
    if (IN(6)) { FRESH(); } if (IN(6)) {
        { pg8::EpiGateF32 E{ymoba, 4096, ubuf + OFF_SM, IN_PAD}; gemm_run(c, Am, WmT, MTOK, 4096, 2048, E); }
        { pg8::EpiMergeBf16 E{mg, 4096, ymoba, ubuf + OFF_SG, IN_PAD}; gemm_run(c, Ag, WgT, MTOK, 4096, 4096, E); } }
    SEAM(6);
    if (IN(8)) { FRESH(); } if (IN(8)) gemm_call<0>(c, mg, WoT, ybuf, MTOK, 4096, 4096, 4096);
    SEAM(8);
    if (IN(9)) { FRESH(); } if (IN(9)) resnorm1_phase(c, xin, ybuf, g_postmix, g_preffn, RS1, h2, ybuf);
    SEAM(9);
    if (IN(10)) { FRESH(); } if (IN(10)) { pg8::EpiSwiGLU E{hid, D_FF}; gemm_run(c, h2, WguT, MTOK, 2 * D_FF, 4096, E);
        const int nun = (MTOK / 256) * (2 * D_FF / 256), full = nun / c.G, rem = nun - full * c.G;
        if (rem > 0 && c.bid >= rem) { FRESH(); Ctx c2 = c; c2.bid = c.bid - rem; c2.G = c.G - rem; __syncthreads(); conv_items<0, 4>(c2, w_fd, D_FF, 4096, WdT, 0, WD_SPLIT); }
        else if (rem == 0) { conv_items<0, 4>(c, w_fd, D_FF, 4096, WdT, 0, WD_SPLIT); } }
    SEAM(10);
    if (IN(12)) { FRESH(); } if (IN(12)) gemm_call<0>(c, hid, WdT, y2, MTOK, 4096, D_FF, 4096);
    SEAM(12);
    if (IN(13)) { FRESH(); } if (IN(13)) resnorm2_phase(c, ybuf, y2, g_postffn, outp);
#undef IN
#undef SEAM
}
#undef xin
#undef g_premix
#undef w_in
#undef gate_up
#undef gate_bias
#undef g_glanorm
#undef w_bm
#undef w_bg
#undef w_out
#undef g_postmix
#undef g_preffn
#undef w_fg
#undef w_fu
#undef w_fd
#undef g_postffn
#undef outp
#undef WmT
#undef WgT
#undef WoT
#undef WguT
#undef WdT
#undef WinT
#undef MQ
#undef MK
#undef MV
#undef BC
#undef ymoba
#undef ybuf
#undef ubuf
#undef gu
#undef hbuf
#undef h2
#undef Qd
#undef Ki
#undef Ke
#undef ygla
#undef y2
#undef ST
#undef Am
#undef Ag
#undef mg
#undef KS
#undef SSQb
#undef RS1
#undef CSt
#undef SNt
#undef DEC
#undef hid


extern "C" void kernel_launch(void* const* d_in, const int* in_sizes, int n_in, void* d_out, int out_size, void* d_ws, size_t ws_size, hipStream_t stream) {
    static int grid = 0;
    if (grid == 0) {
        if (n_in != 15 || in_sizes[0] != MTOK * D_MODEL || out_size != MTOK * D_MODEL || ws_size < WS_END) {
            fprintf(stderr, "kernel_launch: shape/ws mismatch n_in %d in0 %d out %d ws %zu need %zu\n", n_in, n_in > 0 ? in_sizes[0] : -1, out_size, ws_size, (size_t)WS_END); grid = -1; return; }
        if (hipFuncSetAttribute((const void*)mk_fwd, hipFuncAttributeMaxDynamicSharedMemorySize, LDS_BYTES) != hipSuccess) { fprintf(stderr, "kernel_launch: hipFuncSetAttribute failed\n"); grid = -1; return; }
        int dev = 0, cus = 0, per_cu = 0;
        if (hipGetDevice(&dev) != hipSuccess || hipDeviceGetAttribute(&cus, hipDeviceAttributeMultiprocessorCount, dev) != hipSuccess) { grid = -1; return; }
        if (hipOccupancyMaxActiveBlocksPerMultiprocessor(&per_cu, (const void*)mk_fwd, NTHR, LDS_BYTES) != hipSuccess || per_cu < 1) { fprintf(stderr, "kernel_launch: occupancy query says %d blocks/CU\n", per_cu); grid = -1; (void)hipGetLastError(); return; }
        grid = cus;
    }
    if (grid < 0) return;
    (void)hipMemsetAsync((char*)d_ws + WS_CTL, 0, CTL_ZERO_BYTES, stream);
    Params p; memset(&p, 0, sizeof(p));
    for (int i = 0; i < 15; ++i) p.in[i] = (const float*)d_in[i];
    p.out = (float*)d_out; p.ws = (unsigned char*)d_ws; p.ctl = (unsigned*)((char*)d_ws + WS_CTL); p.ph_lo = 0; p.ph_hi = 14;
    hipLaunchKernelGGL(mk_fwd, dim3(grid), dim3(NTHR), LDS_BYTES, stream, p);
    const hipError_t le = hipPeekAtLastError();
    if (le != hipSuccess) fprintf(stderr, "kernel_launch: launch failed: %s\n", hipGetErrorName(le));
}
```

```cpp
#include <hip/hip_runtime.h>
#include <cstdio>
#include <cstdint>
#include <cstring>
namespace pg8 {
#define PG8_LAS __attribute__((address_space(3)))
typedef unsigned short bf16_t;
typedef short bf16x8 __attribute__((ext_vector_type(8)));
typedef float f32x4 __attribute__((ext_vector_type(4)));
typedef unsigned u32x4 __attribute__((ext_vector_type(4)));
constexpr int BM = 256, BK = 64, HALF = 128, HTB = HALF * BK * 2  , STAGE_BYTES = 8 * HTB, NXCD = 8, WGM = 8;

__host__ __device__ __forceinline__ int lds_byte(int r, int c) { const int st = (r >> 4) * 2 + (c >> 5), rr = r & 15, cc = c & 31, ob = rr * 64 + cc * 2; return st * 1024 + (ob ^ (((ob >> 9) & 1) << 5)); }
__host__ __device__ __forceinline__ void stage_rc(int b, int& R, int& C) { const int st = b / 1024, sb = b % 1024, swz = sb ^ (((sb >> 9) & 1) << 5); R = (st >> 1) * 16 + swz / 64; C = (st & 1) * 32 + (swz % 64) / 2; }
__host__ __device__ __forceinline__ int perm32(int rho) { const int n = rho >> 4, i = rho & 15; return 8 * (i >> 2) + 4 * n + (i & 3); }

struct Unit { int pm, pn; };
struct Gemm { const bf16_t* A; const bf16_t* Bt; int M, N, K; };

struct StaticOrder {
    int nM, nN, nwg, G, c;
    __host__ __device__ void init(int M, int N, int G_, int c_) { nM = M / BM; nN = N / BM; nwg = nM * nN; G = G_; c = c_; }
    __host__ __device__ bool next(int i, Unit& u) const {
        const long L = (long)i * G + c; if (L >= nwg) return false;
        int wgid = (int)L; { const int q = nwg / NXCD, r = nwg % NXCD, xcd = wgid % NXCD, off = wgid / NXCD; wgid = (xcd < r ? xcd * (q + 1) : r * (q + 1) + (xcd - r) * q) + off; }
        const int nig = WGM * nN, gid = wgid / nig, fm = gid * WGM, gsz = (nM - fm) < WGM ? (nM - fm) : WGM;
        u.pm = fm + ((wgid % nig) % gsz); u.pn = (wgid % nig) / gsz; return true;
    }
    __device__ __forceinline__ void a_ready(const Unit&) const {}
    __device__ __forceinline__ void done(const Unit&) const {}
};
__device__ __forceinline__ unsigned cvt_pk_bf16(float lo, float hi) { typedef __bf16 bf2_ __attribute__((ext_vector_type(2))); typedef float f2_ __attribute__((ext_vector_type(2))); const f2_ f = {lo, hi}; return __builtin_bit_cast(unsigned, __builtin_convertvector(f, bf2_)); }
typedef float f32x2 __attribute__((ext_vector_type(2)));
struct EpiF32 {
    static constexpr bool PERM = false, AFTER_DRAIN = false;
    float* C; int ldc; const float* bias;
    __device__ __forceinline__ void operator()(const f32x4 (&acc)[2][2][4][2], const Unit& u, int wr, int wc, int fr, int fq) const {
        const int row0 = u.pm * BM + wr * 64 + fr, col0 = u.pn * BM + wc * 32 + 4 * fq;
        f32x4 bv[2][2];
#pragma unroll
        for (int bj = 0; bj < 2; ++bj)
#pragma unroll
            for (int n = 0; n < 2; ++n) bv[bj][n] = bias ? *(const f32x4*)(bias + col0 + bj * HALF + n * 16) : (f32x4){0.f, 0.f, 0.f, 0.f};
#pragma unroll
        for (int ai = 0; ai < 2; ++ai)
#pragma unroll
            for (int m = 0; m < 4; ++m) { float* rowp = C + (size_t)(row0 + ai * HALF + m * 16) * ldc + col0;
#pragma unroll
                for (int bj = 0; bj < 2; ++bj)
#pragma unroll
                    for (int n = 0; n < 2; ++n) *(f32x4*)(rowp + bj * HALF + n * 16) = acc[ai][bj][m][n] + bv[bj][n]; }
    }
};
template <class Epi, class Sched, bool ALIGN_EPI = false, bool SP2 = false>
__device__ __forceinline__ void gemm_phase(PG8_LAS unsigned char* lds, const Gemm g, const Sched& S, const Epi& E) {
    const int tid = threadIdx.x, wid = __builtin_amdgcn_readfirstlane(tid >> 6), lane = tid & 63, wr = wid >> 2, wc = wid & 3, fr = lane & 15, fq = lane >> 4;
    const int K = g.K, nt = K / BK;
    unsigned voffA[2], voffB[2];
#pragma unroll
    for (int i = 0; i < 2; ++i) { int R, C; stage_rc(tid * 16 + i * 8192, R, C); const int Rb = Epi::PERM ? ((R & ~31) + perm32(R & 31)) : R;
        voffA[i] = (unsigned)(R * K + C) * 2u; voffB[i] = (unsigned)(Rb * K + C) * 2u; }
    const size_t kstep = (size_t)(BK * 2);
    const size_t hstep = (size_t)HALF * K * 2;
    const size_t tstep = 2 * hstep;
    const unsigned ldsw = (unsigned)wid * 1024u;
    const int aoff = lds_byte(wr * 64 + fr, fq * 8), boff = lds_byte(wc * 32 + fr, fq * 8);
#define PG8_SA(b, h) (((b) * 2 + (h)) * HTB)
#define PG8_SB(b, h) ((4 + (b) * 2 + (h)) * HTB)
#define PG8_STAGE(bufoff, gbase, voff) do { _Pragma("unroll") for (int _i = 0; _i < 2; ++_i) \
        __builtin_amdgcn_global_load_lds((const unsigned*)((const char*)(gbase) + (voff)[_i]), (PG8_LAS unsigned*)(lds + (bufoff) + ldsw + _i * 8192), 16, 0, 0); } while (0)
#define PG8_LDA(dst, b, h) do { _Pragma("unroll") for (int m = 0; m < 4; ++m) _Pragma("unroll") for (int k = 0; k < 2; ++k) dst[m][k] = *(const PG8_LAS bf16x8*)(lds + PG8_SA(b, h) + aoff + m * 2048 + k * 1024); } while (0)
#define PG8_LDB(dst, b, h) do { _Pragma("unroll") for (int n = 0; n < 2; ++n) _Pragma("unroll") for (int k = 0; k < 2; ++k) dst[n][k] = *(const PG8_LAS bf16x8*)(lds + PG8_SB(b, h) + boff + n * 2048 + k * 1024); } while (0)
#define PG8_MMA(ai, bj, At, Bt) do { __builtin_amdgcn_s_setprio(1); _Pragma("unroll") for (int m = 0; m < 4; ++m) _Pragma("unroll") for (int n = 0; n < 2; ++n) _Pragma("unroll") for (int k = 0; k < 2; ++k) \
        acc[ai][bj][m][n] = __builtin_amdgcn_mfma_f32_16x16x32_bf16(Bt[n][k], At[m][k], acc[ai][bj][m][n], 0, 0, 0); __builtin_amdgcn_s_setprio(0); } while (0)
#define PG8_WAIT_V(n) asm volatile("s_waitcnt vmcnt(" #n ")" ::: "memory")
#define PG8_WAIT_L(n) asm volatile("s_waitcnt lgkmcnt(" #n ")" ::: "memory")
#define PG8_BAR __builtin_amdgcn_s_barrier()
#define PG8_SCHED __builtin_amdgcn_sched_barrier(0)
    Unit cur, nxt; int ui = 0;
    if (!S.next(0, cur)) return;
    f32x4 acc[2][2][4][2];
#pragma unroll
    for (int a = 0; a < 2; ++a)
#pragma unroll
        for (int b = 0; b < 2; ++b)
#pragma unroll
            for (int m = 0; m < 4; ++m)
#pragma unroll
                for (int n = 0; n < 2; ++n) acc[a][b][m][n] = (f32x4){0.f, 0.f, 0.f, 0.f};
    bf16x8 At[4][2], B0[2][2], B1[2][2];
    const char* cA = (const char*)g.A + (size_t)cur.pm * tstep; const char* cB = (const char*)g.Bt + (size_t)cur.pn * tstep;
    S.a_ready(cur);
    if constexpr (SP2) {
        PG8_STAGE(PG8_SB(0, 0), cB, voffB); PG8_STAGE(PG8_SB(0, 1), cB + hstep, voffB); PG8_STAGE(PG8_SA(0, 0), cA, voffA); PG8_STAGE(PG8_SA(0, 1), cA + hstep, voffA);
        if (wr == 1) PG8_BAR;
        PG8_WAIT_V(2); PG8_BAR;
        PG8_STAGE(PG8_SB(1, 0), cB + kstep, voffB); PG8_STAGE(PG8_SA(1, 0), cA + kstep, voffA); PG8_STAGE(PG8_SB(1, 1), cB + hstep + kstep, voffB);
        PG8_WAIT_V(6); PG8_BAR;
    } else {
        PG8_STAGE(PG8_SB(0, 0), cB, voffB); PG8_STAGE(PG8_SA(0, 0), cA, voffA); PG8_STAGE(PG8_SB(0, 1), cB + hstep, voffB); PG8_STAGE(PG8_SA(0, 1), cA + hstep, voffA);
        if (wr == 1) PG8_BAR;
        PG8_WAIT_V(4); PG8_BAR;
        PG8_STAGE(PG8_SB(1, 0), cB + kstep, voffB); PG8_STAGE(PG8_SA(1, 0), cA + kstep, voffA); PG8_STAGE(PG8_SB(1, 1), cB + hstep + kstep, voffB);
        PG8_WAIT_V(6); PG8_BAR;
    }
    for (;;) {
        const bool has_next = S.next(ui + 1, nxt);
        const char* nA = has_next ? (const char*)g.A + (size_t)nxt.pm * tstep : cA; const char* nB = has_next ? (const char*)g.Bt + (size_t)nxt.pn * tstep : cB;
        for (int t = 0; t < nt; t += 2) {
            const bool last = (t == nt - 2);
            const char* a1 = cA + (size_t)(t + 1) * kstep;
            const char* a2 = last ? nA : cA + (size_t)(t + 2) * kstep; const char* b2 = last ? nB : cB + (size_t)(t + 2) * kstep;
            const char* a3 = a2 + kstep; const char* b3 = b2 + kstep;
            if (last && has_next) S.a_ready(nxt);
            if constexpr (SP2) {
            PG8_LDB(B0, 0, 0); PG8_LDB(B1, 0, 1); PG8_SCHED; PG8_LDA(At, 0, 0); PG8_STAGE(PG8_SA(1, 1), a1 + hstep, voffA);
            PG8_WAIT_V(8); PG8_WAIT_L(0); PG8_BAR; PG8_MMA(0, 0, At, B0); PG8_MMA(0, 1, At, B1); PG8_BAR; PG8_SCHED;
            PG8_LDA(At, 0, 1); PG8_STAGE(PG8_SB(0, 0), b2, voffB); PG8_STAGE(PG8_SB(0, 1), b2 + hstep, voffB); PG8_STAGE(PG8_SA(0, 0), a2, voffA);
            PG8_WAIT_V(8); PG8_WAIT_L(0); PG8_BAR; PG8_MMA(1, 0, At, B0); PG8_MMA(1, 1, At, B1); PG8_BAR; PG8_SCHED;
            PG8_LDB(B0, 1, 0); PG8_LDB(B1, 1, 1); PG8_SCHED; PG8_LDA(At, 1, 0); PG8_STAGE(PG8_SA(0, 1), a2 + hstep, voffA);
            PG8_WAIT_V(8); PG8_WAIT_L(0); PG8_BAR; PG8_MMA(0, 0, At, B0); PG8_MMA(0, 1, At, B1); PG8_BAR; PG8_SCHED;
            PG8_LDA(At, 1, 1); PG8_STAGE(PG8_SB(1, 0), b3, voffB); PG8_STAGE(PG8_SB(1, 1), b3 + hstep, voffB); PG8_STAGE(PG8_SA(1, 0), a3, voffA);
            PG8_WAIT_V(8); PG8_WAIT_L(0); PG8_BAR; PG8_MMA(1, 0, At, B0); PG8_MMA(1, 1, At, B1); PG8_BAR; PG8_SCHED;
            } else {
            PG8_LDB(B0, 0, 0); PG8_SCHED; PG8_LDA(At, 0, 0); PG8_STAGE(PG8_SA(1, 1), a1 + hstep, voffA);
            PG8_WAIT_L(8); PG8_BAR; PG8_WAIT_L(0); PG8_MMA(0, 0, At, B0); PG8_BAR; PG8_SCHED;
            PG8_LDB(B1, 0, 1); PG8_STAGE(PG8_SB(0, 0), b2, voffB);
            PG8_BAR; PG8_WAIT_L(0); PG8_MMA(0, 1, At, B1); PG8_BAR;
            PG8_LDA(At, 0, 1); PG8_STAGE(PG8_SA(0, 0), a2, voffA);
            PG8_BAR; PG8_WAIT_L(0); PG8_MMA(1, 0, At, B0); PG8_BAR; PG8_SCHED;
            PG8_STAGE(PG8_SB(0, 1), b2 + hstep, voffB);
            PG8_WAIT_V(6); PG8_BAR; PG8_MMA(1, 1, At, B1); PG8_BAR;
            PG8_LDB(B0, 1, 0); PG8_SCHED; PG8_LDA(At, 1, 0); PG8_STAGE(PG8_SA(0, 1), a2 + hstep, voffA);
            PG8_WAIT_L(8); PG8_BAR; PG8_WAIT_L(0); PG8_MMA(0, 0, At, B0); PG8_BAR; PG8_SCHED;
            PG8_LDB(B1, 1, 1); PG8_STAGE(PG8_SB(1, 0), b3, voffB);
            PG8_BAR; PG8_WAIT_L(0); PG8_MMA(0, 1, At, B1); PG8_BAR;
            PG8_LDA(At, 1, 1); PG8_STAGE(PG8_SA(1, 0), a3, voffA);
            PG8_BAR; PG8_WAIT_L(0); PG8_MMA(1, 0, At, B0); PG8_BAR; PG8_SCHED;
            PG8_STAGE(PG8_SB(1, 1), b3 + hstep, voffB);
            PG8_WAIT_V(6); PG8_BAR; PG8_MMA(1, 1, At, B1); PG8_BAR;
            }
        }
        if constexpr (ALIGN_EPI) { if (wr == 0) PG8_BAR; }
        if constexpr (!Epi::AFTER_DRAIN) { E(acc, cur, wr, wc, fr, fq); S.done(cur); }
        if (!has_next) break;
#pragma unroll
        for (int a = 0; a < 2; ++a)
#pragma unroll
            for (int b = 0; b < 2; ++b)
#pragma unroll
                for (int m = 0; m < 4; ++m)
#pragma unroll
                    for (int n = 0; n < 2; ++n) acc[a][b][m][n] = (f32x4){0.f, 0.f, 0.f, 0.f};
        cur = nxt; cA = nA; cB = nB; ++ui;
        if constexpr (ALIGN_EPI) { if (wr == 1) PG8_BAR; }
    }
    PG8_WAIT_V(0);
    if constexpr (!ALIGN_EPI) { if (wr == 0) PG8_BAR; }
    PG8_BAR;
    if constexpr (Epi::AFTER_DRAIN) { E.fused(acc, cur, wr, wc, fr, fq, lds, wid, lane); S.done(cur); }
#undef PG8_SA
#undef PG8_SB
#undef PG8_STAGE
#undef PG8_LDA
#undef PG8_LDB
#undef PG8_MMA
#undef PG8_WAIT_V
#undef PG8_WAIT_L
#undef PG8_BAR
#undef PG8_SCHED
}
}

namespace pg8 {
struct EpiBf16Plain {
    static constexpr bool PERM = true, AFTER_DRAIN = false;
    bf16_t* O; int ldc;
    __device__ __forceinline__ void operator()(const f32x4 (&acc)[2][2][4][2], const Unit& u, int wr, int wc, int fr, int fq) const {
        const int row0 = u.pm * BM + wr * 64 + fr; const int col0 = u.pn * BM + wc * 32 + 8 * fq;
#pragma unroll
        for (int ai = 0; ai < 2; ++ai)
#pragma unroll
            for (int m = 0; m < 4; ++m) { bf16_t* rowp = O + (size_t)(row0 + ai * HALF + m * 16) * ldc + col0;
#pragma unroll
                for (int bj = 0; bj < 2; ++bj) { const f32x4 v0 = acc[ai][bj][m][0], v1 = acc[ai][bj][m][1];
                    u32x4 w; w.x = cvt_pk_bf16(v0[0], v0[1]); w.y = cvt_pk_bf16(v0[2], v0[3]); w.z = cvt_pk_bf16(v1[0], v1[1]); w.w = cvt_pk_bf16(v1[2], v1[3]);
                    *(u32x4*)(rowp + bj * HALF) = w; } }
    }
};
}

namespace pg8 {
__device__ __forceinline__ float sigm(float x) { return __builtin_amdgcn_rcpf(1.f + __expf(-x)); }
struct EpiSwiGLU {
    static constexpr bool PERM = true, AFTER_DRAIN = false;
    bf16_t* O; int ldc;
    __device__ __forceinline__ void operator()(const f32x4 (&acc)[2][2][4][2], const Unit& u, int wr, int wc, int fr, int fq) const {
        const int row0 = u.pm * BM + wr * 64 + fr; const int col0 = u.pn * HALF + wc * 32 + 8 * fq;
#pragma unroll
        for (int ai = 0; ai < 2; ++ai)
#pragma unroll
            for (int m = 0; m < 4; ++m) { bf16_t* rowp = O + (size_t)(row0 + ai * HALF + m * 16) * ldc + col0; float v[8];
#pragma unroll
                for (int n = 0; n < 2; ++n)
#pragma unroll
                    for (int e = 0; e < 4; ++e) { const float g = acc[ai][0][m][n][e], up = acc[ai][1][m][n][e]; v[4 * n + e] = g * sigm(g) * up; }
                u32x4 w; w.x = cvt_pk_bf16(v[0], v[1]); w.y = cvt_pk_bf16(v[2], v[3]); w.z = cvt_pk_bf16(v[4], v[5]); w.w = cvt_pk_bf16(v[6], v[7]);
                *(u32x4*)rowp = w; }
    }
};
struct EpiGateF32 {
    static constexpr bool PERM = true, AFTER_DRAIN = false;
    bf16_t* Y; int ldc; const bf16_t* G; int ldg;
    __device__ __forceinline__ void operator()(const f32x4 (&acc)[2][2][4][2], const Unit& u, int wr, int wc, int fr, int fq) const {
        const int row0 = u.pm * BM + wr * 64 + fr; const int col0 = u.pn * BM + wc * 32 + 8 * fq;
#pragma unroll
        for (int ai = 0; ai < 2; ++ai)
#pragma unroll
            for (int m = 0; m < 4; ++m) { const size_t r = (size_t)(row0 + ai * HALF + m * 16);
#pragma unroll
                for (int bj = 0; bj < 2; ++bj) { const u32x4 g = *(const u32x4*)(G + r * ldg + col0 + bj * HALF); f32x4 o0, o1;
#pragma unroll
                    for (int e = 0; e < 2; ++e) { o0[2 * e] = sigm(__uint_as_float(g[e] << 16)) * acc[ai][bj][m][0][2 * e]; o0[2 * e + 1] = sigm(__uint_as_float(g[e] & 0xffff0000u)) * acc[ai][bj][m][0][2 * e + 1];
                        o1[2 * e] = sigm(__uint_as_float(g[2 + e] << 16)) * acc[ai][bj][m][1][2 * e]; o1[2 * e + 1] = sigm(__uint_as_float(g[2 + e] & 0xffff0000u)) * acc[ai][bj][m][1][2 * e + 1]; }
                    u32x4 w; w.x = cvt_pk_bf16(o0[0], o0[1]); w.y = cvt_pk_bf16(o0[2], o0[3]); w.z = cvt_pk_bf16(o1[0], o1[1]); w.w = cvt_pk_bf16(o1[2], o1[3]);
                    *(u32x4*)(Y + r * ldc + col0 + bj * HALF) = w; } }
    }
};
struct EpiMergeBf16 {
    static constexpr bool PERM = true, AFTER_DRAIN = false;
    bf16_t* O; int ldc; const bf16_t* Y; const bf16_t* G; int ldg;
    __device__ __forceinline__ void operator()(const f32x4 (&acc)[2][2][4][2], const Unit& u, int wr, int wc, int fr, int fq) const {
        const int row0 = u.pm * BM + wr * 64 + fr; const int col0 = u.pn * BM + wc * 32 + 8 * fq;
#pragma unroll
        for (int ai = 0; ai < 2; ++ai)
#pragma unroll
            for (int m = 0; m < 4; ++m) { const size_t r = (size_t)(row0 + ai * HALF + m * 16);
#pragma unroll
                for (int bj = 0; bj < 2; ++bj) { const u32x4 g = *(const u32x4*)(G + r * ldg + col0 + bj * HALF); const u32x4 yw = *(const u32x4*)(Y + r * ldc + col0 + bj * HALF); const f32x4 y0 = {__uint_as_float(yw[0] << 16), __uint_as_float(yw[0] & 0xffff0000u), __uint_as_float(yw[1] << 16), __uint_as_float(yw[1] & 0xffff0000u)}, y1 = {__uint_as_float(yw[2] << 16), __uint_as_float(yw[2] & 0xffff0000u), __uint_as_float(yw[3] << 16), __uint_as_float(yw[3] & 0xffff0000u)}; f32x4 o0, o1;
#pragma unroll
                    for (int e = 0; e < 2; ++e) { o0[2 * e] = y0[2 * e] + sigm(__uint_as_float(g[e] << 16)) * acc[ai][bj][m][0][2 * e]; o0[2 * e + 1] = y0[2 * e + 1] + sigm(__uint_as_float(g[e] & 0xffff0000u)) * acc[ai][bj][m][0][2 * e + 1];
                        o1[2 * e] = y1[2 * e] + sigm(__uint_as_float(g[2 + e] << 16)) * acc[ai][bj][m][1][2 * e]; o1[2 * e + 1] = y1[2 * e + 1] + sigm(__uint_as_float(g[2 + e] & 0xffff0000u)) * acc[ai][bj][m][1][2 * e + 1]; }
                    u32x4 w; w.x = cvt_pk_bf16(o0[0], o0[1]); w.y = cvt_pk_bf16(o0[2], o0[3]); w.z = cvt_pk_bf16(o1[0], o1[1]); w.w = cvt_pk_bf16(o1[2], o1[3]);
                    *(u32x4*)(O + r * ldc + col0 + bj * HALF) = w; } }
    }
};
}

namespace pg8 {
struct EpiIn {
    static constexpr bool PERM = true, AFTER_DRAIN = false;
    bf16_t* O; int ldc; const float* CS; const float* SN; float* KS;
    __device__ __forceinline__ void operator()(const f32x4 (&acc)[2][2][4][2], const Unit& u, int wr, int wc, int fr_, int fq_) const {
        int fr = fr_, fq = fq_; asm volatile("" : "+v"(fr), "+v"(fq));
        const int row0 = u.pm * BM + wr * 64 + fr; const int col0 = u.pn * BM + wc * 32 + 8 * fq;
        if (u.pn >= 16) {
#pragma unroll
            for (int ai = 0; ai < 2; ++ai)
#pragma unroll
                for (int m = 0; m < 4; ++m) { bf16_t* rowp = O + (size_t)(row0 + ai * HALF + m * 16) * ldc + col0;
#pragma unroll
                    for (int bj = 0; bj < 2; ++bj) { const f32x4 v0 = acc[ai][bj][m][0], v1 = acc[ai][bj][m][1];
                        u32x4 w; w.x = cvt_pk_bf16(v0[0], v0[1]); w.y = cvt_pk_bf16(v0[2], v0[3]); w.z = cvt_pk_bf16(v1[0], v1[1]); w.w = cvt_pk_bf16(v1[2], v1[3]);
                        *(u32x4*)(rowp + bj * HALF) = w; } }
        } else {
            const int q4 = 4 * (4 * wc + fq);
            f32x4 s1[2] = {(f32x4){0.f, 0.f, 0.f, 0.f}, (f32x4){0.f, 0.f, 0.f, 0.f}}, s2[2] = {(f32x4){0.f, 0.f, 0.f, 0.f}, (f32x4){0.f, 0.f, 0.f, 0.f}};
#pragma unroll
            for (int ai = 0; ai < 2; ++ai)
#pragma unroll
                for (int m = 0; m < 4; ++m) { int row = row0 + ai * HALF + m * 16; asm volatile("" : "+v"(row));
                    const int pos = row & 2047;
                    const f32x4 cs = *(const f32x4*)(CS + (unsigned)(pos * 64 + q4)), sn = *(const f32x4*)(SN + (unsigned)(pos * 64 + q4));
                    bf16_t* rowp = O + ((unsigned)row * (unsigned)ldc + (unsigned)col0);
#pragma unroll
                    for (int bj = 0; bj < 2; ++bj) { const f32x4 x1 = acc[ai][bj][m][0], x2 = acc[ai][bj][m][1]; const f32x4 o1 = x1 * cs - x2 * sn, o2 = x2 * cs + x1 * sn;
                        s1[bj] += o1; s2[bj] += o2;
                        u32x4 w; w.x = cvt_pk_bf16(o1[0], o1[1]); w.y = cvt_pk_bf16(o1[2], o1[3]); w.z = cvt_pk_bf16(o2[0], o2[1]); w.w = cvt_pk_bf16(o2[2], o2[3]);
                        *(u32x4*)(rowp + bj * HALF) = w; }
                    asm volatile("" : "+v"(s1[0]), "+v"(s1[1]), "+v"(s2[0]), "+v"(s2[1]) :: "memory"); }
            if (u.pn >= 8) {
#pragma unroll
                for (int bj = 0; bj < 2; ++bj)
#pragma unroll
                    for (int e = 0; e < 4; ++e) { float a = s1[bj][e], b = s2[bj][e];
#pragma unroll
                        for (int o = 1; o < 16; o <<= 1) { a += __shfl_xor(a, o); b += __shfl_xor(b, o); }
                        s1[bj][e] = a; s2[bj][e] = b; }
                if (fr == 0) { const int b = u.pm >> 3, blk = u.pm & 7;
#pragma unroll
                    for (int bj = 0; bj < 2; ++bj) { const int hd = (u.pn - 8) * 2 + bj; float* kp = KS + (size_t)(((b * 16 + hd) * 8 + blk) * 128 + wc * 32 + 8 * fq);
#pragma unroll
                        for (int e = 0; e < 4; ++e) { atomicAdd(kp + e, s1[bj][e]); atomicAdd(kp + 4 + e, s2[bj][e]); } } }
            }
        }
    }
};
}

typedef unsigned short bf16_t;
#define LAS __attribute__((address_space(3)))
#define LDS_WAIT() asm volatile("s_waitcnt lgkmcnt(0)" ::: "memory")
__device__ __forceinline__ float bf2f(bf16_t b) { return __uint_as_float(((unsigned)b) << 16); }
__device__ __forceinline__ unsigned f2bf(float f) { unsigned u = __float_as_uint(f); return (u + 0x7fffu + ((u >> 16) & 1u)) >> 16; }
__device__ __forceinline__ unsigned pk2(float lo, float hi) { return f2bf(lo) | (f2bf(hi) << 16); }
__device__ __forceinline__ float wave_sum(float v) {
#pragma unroll
    for (int o = 1; o < 64; o <<= 1) v += __shfl_xor(v, o);
    return v;
}
__device__ __forceinline__ float wave_max(float v) {
#pragma unroll
    for (int o = 1; o < 64; o <<= 1) v = fmaxf(v, __shfl_xor(v, o));
    return v;
}
__device__ __forceinline__ float sigmoidf_(float x) { return __builtin_amdgcn_rcpf(1.f + __expf(-x)); }
__device__ __forceinline__ float siluf_(float x) { return x * __builtin_amdgcn_rcpf(1.f + __expf(-x)); }

#define XB_TMO      128
#define XB_XCNT(j)  (256  + 64 * (j))
#define XB_XSUB(j)  (1280 + 64 * (j))
#define XB_XGEN(j)  (2304 + 64 * (j))
#define XB_TOP      3328
#define XB_TOPGEN   3392
#define XCD_BAR_WORDS 3456
#define XB_SPIN_CAP (1u << 18)

__device__ __forceinline__ unsigned xb_ld(unsigned* p)              { return __hip_atomic_load(p, __ATOMIC_RELAXED, __HIP_MEMORY_SCOPE_AGENT); }
__device__ __forceinline__ unsigned xb_add(unsigned* p, unsigned v) { return __hip_atomic_fetch_add(p, v, __ATOMIC_RELAXED, __HIP_MEMORY_SCOPE_AGENT); }
__device__ __forceinline__ unsigned xb_xcc_id() { return (unsigned)__builtin_amdgcn_s_getreg((3 << 11) | 20) & 0xFu; }
#define XB_SPIN(cond, bar) do { unsigned _sp = 0; while (cond) { __builtin_amdgcn_s_sleep(1); \
    if ((++_sp & 255u) == 0u) { if (xb_ld(&(bar)[XB_TMO])) break; if (_sp > XB_SPIN_CAP) { atomicAdd(&(bar)[XB_TMO], 1u); break; } } } } while (0)

struct XcdBarrier {
    unsigned* bar; unsigned x;
    volatile LAS unsigned* st;
};

__device__ __forceinline__ XcdBarrier xcd_barrier_post(unsigned* bar, volatile LAS unsigned* st) {
    XcdBarrier b; b.bar = bar; b.x = xb_xcc_id(); b.st = st;
    if (threadIdx.x == 0) (void)xb_add(&bar[XB_XCNT(b.x)], 1u);
    return b;
}
__device__ __forceinline__ void xcd_barrier_complete(unsigned* bar, unsigned x, unsigned& nloc, unsigned& nx) {
    const unsigned G = gridDim.x * gridDim.y * gridDim.z;
    unsigned sum, cnt, mine, sp = 0u;
    for (;;) {
        sum = 0u; cnt = 0u; mine = 0u;
#pragma unroll
        for (unsigned j = 0; j < 16; ++j) { const unsigned c = xb_ld(&bar[XB_XCNT(j)]); sum += c; cnt += (c > 0u) ? 1u : 0u; mine = (j == x) ? c : mine; }
        if (sum == G) break;
        __builtin_amdgcn_s_sleep(1);
        if ((++sp & 255u) == 0u) { if (xb_ld(&bar[XB_TMO])) break; if (sp > XB_SPIN_CAP) { atomicAdd(&bar[XB_TMO], 1u); break; } }
    }
    nloc = mine > 0u ? mine : 1u; nx = cnt > 0u ? cnt : 1u;
}

__device__ __forceinline__ void xcd_barrier(const XcdBarrier& b) {
    asm volatile("s_waitcnt vmcnt(0)" ::: "memory");
    __syncthreads();
    if (threadIdx.x == 0) {
        unsigned* bar = b.bar;
        __builtin_amdgcn_s_waitcnt(0);
        unsigned nloc = b.st[0], nx = b.st[1];
        if (nloc == 0u) { xcd_barrier_complete(bar, b.x, nloc, nx); b.st[0] = nloc; b.st[1] = nx; }
        const unsigned old = xb_add(&bar[XB_XSUB(b.x)], 1u);
        const unsigned gen = old / nloc;
        if (old + 1u == (gen + 1u) * nloc) {
            __builtin_amdgcn_fence(__ATOMIC_RELEASE, "agent");
            asm volatile("s_waitcnt vmcnt(0)" ::: "memory");
            const unsigned og = xb_add(&bar[XB_TOP], 1u);
            const unsigned tg = og / nx;
            if (og + 1u == (tg + 1u) * nx) xb_add(&bar[XB_TOPGEN], 1u);
            else XB_SPIN(xb_ld(&bar[XB_TOPGEN]) == tg, bar);
            __builtin_amdgcn_fence(__ATOMIC_ACQUIRE, "agent");
            xb_add(&bar[XB_XGEN(b.x)], 1u);
            asm volatile("s_waitcnt vmcnt(0)" ::: "memory");
        } else {
            XB_SPIN(xb_ld(&bar[XB_XGEN(b.x)]) == gen, bar);
            __builtin_amdgcn_fence(__ATOMIC_ACQUIRE, "agent");
            asm volatile("s_waitcnt vmcnt(0)" ::: "memory");
        }
    }
    __syncthreads();
}

namespace mb {
using bf16x8 = __attribute__((ext_vector_type(8))) short;
using s16x4  = __attribute__((ext_vector_type(4))) short;
using f32x16 = __attribute__((ext_vector_type(16))) float;
using u32x4  = __attribute__((ext_vector_type(4))) unsigned;
constexpr int   D = 128, NW = 8, QBLK = 32, KVBLK = 64, LD = 26624  , LDO = 2048  ;
constexpr float SCALE = 0.088388347648318440f, THR = 8.f, NEG = -1e30f;
constexpr int SHM_V = KVBLK * D * 2, SHM_K = KVBLK * D * 2, SHM_ATTN = 2 * SHM_V + 2 * SHM_K + NW * 64 * 4;
#define KSWZ(row, colB) ((row) * 256 + ((colB) ^ (((row) & 7) << 4)))
#define SBAR() __builtin_amdgcn_sched_barrier(0)
__device__ __forceinline__ int crow(int r, int hi) { return (r & 3) + 8 * (r >> 2) + 4 * hi; }
__device__ __forceinline__ unsigned cvtpk(float lo, float hi) { typedef __bf16 bf2_ __attribute__((ext_vector_type(2))); typedef float f2_ __attribute__((ext_vector_type(2))); const f2_ f = {lo, hi}; return __builtin_bit_cast(unsigned, __builtin_convertvector(f, bf2_)); }
__device__ __forceinline__ void partialSM(f32x16& p0, f32x16& p1, float& m_reg, float& mn, float& alpha) {
  constexpr float C = SCALE * 1.4426950408889634f;
  float pmax = p0[0]; for (int r = 1; r < 16; ++r) pmax = fmaxf(pmax, p0[r]); for (int r = 0; r < 16; ++r) pmax = fmaxf(pmax, p1[r]);
  { auto rr = __builtin_amdgcn_permlane32_swap(__float_as_uint(pmax), __float_as_uint(pmax), false, false);
    pmax = fmaxf(__uint_as_float(rr[0]), __uint_as_float(rr[1])); }
  if (__builtin_expect(__all(pmax - m_reg <= THR / SCALE), 1)) { mn = m_reg; alpha = 1.f; }
  else { mn = fmaxf(m_reg, pmax); alpha = __builtin_amdgcn_exp2f((m_reg - mn) * C); m_reg = mn; }
  float mnC = -mn * C;
  for (int r = 0; r < 16; ++r) p0[r] = fmaf(p0[r], C, mnC); for (int r = 0; r < 16; ++r) p1[r] = fmaf(p1[r], C, mnC);
  for (int r = 0; r < 16; ++r) p0[r] = __builtin_amdgcn_exp2f(p0[r]);
}
__device__ __forceinline__ void finishSM(f32x16& p0, f32x16& p1, float alpha, float& l_reg, bf16x8& pa0, bf16x8& pa1, bf16x8& pa2, bf16x8& pa3) {
  for (int r = 0; r < 16; ++r) p1[r] = __builtin_amdgcn_exp2f(p1[r]);
  float ps = 0; for (int r = 0; r < 16; ++r) ps += p0[r]; for (int r = 0; r < 16; ++r) ps += p1[r];
  { auto rr = __builtin_amdgcn_permlane32_swap(__float_as_uint(ps), __float_as_uint(ps), false, false);
    ps = __uint_as_float(rr[0]) + __uint_as_float(rr[1]); }
  l_reg = l_reg * alpha + ps;
#define PK4(P, BASE, OUT) do { unsigned a0 = cvtpk(P[BASE + 0], P[BASE + 1]), a1 = cvtpk(P[BASE + 2], P[BASE + 3]);   \
    unsigned b0 = cvtpk(P[BASE + 4], P[BASE + 5]), b1 = cvtpk(P[BASE + 6], P[BASE + 7]);                              \
    auto r0 = __builtin_amdgcn_permlane32_swap(a0, b0, false, false); auto r1 = __builtin_amdgcn_permlane32_swap(a1, b1, false, false); \
    u32x4 w = {r0[0], r1[0], r0[1], r1[1]}; OUT = *reinterpret_cast<bf16x8*>(&w); } while (0)
  PK4(p0, 0, pa0); PK4(p0, 8, pa1); PK4(p1, 0, pa2); PK4(p1, 8, pa3);
#undef PK4
}
__device__ __forceinline__ void qkt(f32x16& p0, f32x16& p1, const char* Ks, const bf16x8* qr, const int (&kb4)[4]) {
  p0 = f32x16{}; p1 = f32x16{};
#pragma unroll
  for (int d0 = 0; d0 < 8; ++d0) {
    bf16x8 b0 = *reinterpret_cast<const bf16x8*>(Ks + kb4[d0 & 3] + (d0 >> 2) * 128);
    bf16x8 b1 = *reinterpret_cast<const bf16x8*>(Ks + kb4[d0 & 3] + (d0 >> 2) * 128 + 32 * 256);
    p0 = __builtin_amdgcn_mfma_f32_32x32x16_bf16(b0, qr[d0], p0, 0, 0, 0);
    p1 = __builtin_amdgcn_mfma_f32_32x32x16_bf16(b1, qr[d0], p1, 0, 0, 0); }
}
__device__ __forceinline__ int v_st(int k, int c) { const int kk = (k & ~0xC) | ((k & 4) << 1) | ((k & 8) >> 1); return ((kk >> 3) * 4 + (c >> 5)) * 512 + ((kk & 7) * 32 + (c & 31)) * 2; }
__device__ __forceinline__ int v_rd_base(int lane) { return ((lane & 3) << 3) | (((lane >> 2) & 3) << 6) | (((lane >> 4) & 1) << 5) | (((lane >> 5) & 1) << 8); }
constexpr int v_rd_off(int d0, int ks, int half) { return d0 * 512 + ks * 4096 + half * 2048; }
template <int OFF> __device__ __forceinline__ s16x4 tr_read(int vb) {
  s16x4 r; asm volatile("ds_read_b64_tr_b16 %0, %1 offset:%2" : "=&v"(r) : "v"(vb), "i"(OFF) : "memory"); return r;
}
template <int D0> __device__ __forceinline__ void pv_one(f32x16& od, int vb, bf16x8 pa0, bf16x8 pa1, bf16x8 pa2, bf16x8 pa3) {
  const s16x4 l0 = tr_read<v_rd_off(D0, 0, 0)>(vb), h0 = tr_read<v_rd_off(D0, 0, 1)>(vb), l1 = tr_read<v_rd_off(D0, 1, 0)>(vb), h1 = tr_read<v_rd_off(D0, 1, 1)>(vb);
  const s16x4 l2 = tr_read<v_rd_off(D0, 2, 0)>(vb), h2 = tr_read<v_rd_off(D0, 2, 1)>(vb), l3 = tr_read<v_rd_off(D0, 3, 0)>(vb), h3 = tr_read<v_rd_off(D0, 3, 1)>(vb);
  asm volatile("s_waitcnt lgkmcnt(0)" ::: "memory"); SBAR();
#define PK(L, H) (bf16x8){L[0], L[1], L[2], L[3], H[0], H[1], H[2], H[3]}
  od = __builtin_amdgcn_mfma_f32_32x32x16_bf16(pa0, PK(l0, h0), od, 0, 0, 0);
  od = __builtin_amdgcn_mfma_f32_32x32x16_bf16(pa1, PK(l1, h1), od, 0, 0, 0);
  od = __builtin_amdgcn_mfma_f32_32x32x16_bf16(pa2, PK(l2, h2), od, 0, 0, 0);
  od = __builtin_amdgcn_mfma_f32_32x32x16_bf16(pa3, PK(l3, h3), od, 0, 0, 0);
#undef PK
}
__device__ __forceinline__ void pv_d0(f32x16* o, int vb, bf16x8 pa0, bf16x8 pa1, bf16x8 pa2, bf16x8 pa3) {
  pv_one<0>(o[0], vb, pa0, pa1, pa2, pa3); pv_one<1>(o[1], vb, pa0, pa1, pa2, pa3); pv_one<2>(o[2], vb, pa0, pa1, pa2, pa3); pv_one<3>(o[3], vb, pa0, pa1, pa2, pa3);
}
__device__ __forceinline__ int key0(int j, int qb) { return j < 4 ? qb * 256 + j * 64 : ((j - 4) >> 2) * 256 + ((j - 4) & 3) * 64; }
__device__ __forceinline__ void mask_tile(f32x16& p0, f32x16& p1, int j, unsigned selmask, int rowb, int hi) {
  int rb = rowb; asm volatile("" : "+v"(rb));
  const int lim = (j < 4) ? (rb - 64 * j) : (((selmask >> ((j - 4) >> 2)) & 1u) ? 4096 : -4096);
  if (__all(lim >= 63)) return;
  const int limh = lim - 4 * hi;
#pragma unroll
  for (int r = 0; r < 16; ++r) { const int cr = (r & 3) + 8 * (r >> 2); p0[r] = (cr > limh) ? NEG : p0[r]; p1[r] = (cr + 32 > limh) ? NEG : p1[r]; }
}
__device__ __forceinline__ void moba_unit(const unsigned short* __restrict__ Qb, const unsigned short* __restrict__ Kh, const unsigned short* __restrict__ Vh,
                                          unsigned short* __restrict__ Ob, const float* __restrict__ KS, int qb, char* lds) {
  int tid_ = threadIdx.x; asm volatile("" : "+v"(tid_));
  const int tid = tid_, wid = tid >> 6, lane = tid & 63, r32 = lane & 31, hi = lane >> 5;
  char* V_lds = lds; char* K_lds = lds + 2 * SHM_V;
  float* ws = (float*)(lds + 2 * SHM_V + 2 * SHM_K) + wid * 64; float* li_l = ws; float* al_l = ws + 32;
  float m_reg = NEG, l_reg = 0; f32x16 o[4] = {}; bf16x8 qr[8];
  const unsigned short* Qw = Qb + (long)(wid * QBLK + r32) * LD + hi * 8;
#pragma unroll
  for (int d0 = 0; d0 < 8; ++d0) qr[d0] = *reinterpret_cast<const bf16x8*>(Qw + d0 * 16);
  unsigned selmask = 0u;
  {
    float gate[8];
#pragma unroll
    for (int n = 0; n < 8; ++n) { float g = 0.f;
      if (n < qb) {
#pragma unroll
        for (int d0 = 0; d0 < 8; ++d0) { const float4 k0 = *(const float4*)(KS + n * 128 + d0 * 16 + hi * 8), k1 = *(const float4*)(KS + n * 128 + d0 * 16 + hi * 8 + 4);
          const u32x4 qw = *reinterpret_cast<const u32x4*>(&qr[d0]);
          g += __uint_as_float(qw[0] << 16) * k0.x + __uint_as_float(qw[0] & 0xffff0000u) * k0.y + __uint_as_float(qw[1] << 16) * k0.z + __uint_as_float(qw[1] & 0xffff0000u) * k0.w
             + __uint_as_float(qw[2] << 16) * k1.x + __uint_as_float(qw[2] & 0xffff0000u) * k1.y + __uint_as_float(qw[3] << 16) * k1.z + __uint_as_float(qw[3] & 0xffff0000u) * k1.w; }
        g += __shfl_xor(g, 32); }
      gate[n] = (n < qb) ? g : -INFINITY; }
#pragma unroll
    for (int r = 0; r < 3; ++r) { float best = -INFINITY; int bi = -1;
#pragma unroll
      for (int n = 0; n < 8; ++n) { const bool ok = !((selmask >> n) & 1u) && gate[n] > best; if (ok) { best = gate[n]; bi = n; } }
      if (bi >= 0) selmask |= 1u << bi; }
  }
  const int rowb = wid * QBLK + r32;
  int kb4[4];
#pragma unroll
  for (int q = 0; q < 4; ++q) kb4[q] = r32 * 256 + (((q << 5) | (hi << 4)) ^ ((r32 & 7) << 4));
  const int sr = tid >> 4, sc = (tid & 15) * 8, vst0 = v_st(sr, sc), vst1 = v_st(32 + sr, sc);
  const int vb0 = (int)(uintptr_t)V_lds + v_rd_base(lane);
  struct { bf16x8 vs0, vs1, ks0, ks1; } sr_[1];
  const unsigned voff = (unsigned)((sr * LD + sc) * 2);
#define SLOAD(i, k0) do { const char* vb_ = (const char*)Vh + (size_t)(k0) * (LD * 2); const char* kb_ = (const char*)Kh + (size_t)(k0) * (LD * 2); \
    sr_[i].vs0 = *reinterpret_cast<const bf16x8*>(vb_ + voff); sr_[i].vs1 = *reinterpret_cast<const bf16x8*>(vb_ + 32 * LD * 2 + voff); \
    sr_[i].ks0 = *reinterpret_cast<const bf16x8*>(kb_ + voff); sr_[i].ks1 = *reinterpret_cast<const bf16x8*>(kb_ + 32 * LD * 2 + voff); } while (0)
#define SWRITE(b, i) do { *(bf16x8*)(V_lds + (b) * SHM_V + vst0) = sr_[i].vs0;          \
    *(bf16x8*)(V_lds + (b) * SHM_V + vst1) = sr_[i].vs1; int kc = sc * 2;               \
    *(bf16x8*)(K_lds + (b) * SHM_K + KSWZ(sr, kc)) = sr_[i].ks0;                       \
    *(bf16x8*)(K_lds + (b) * SHM_K + KSWZ(32 + sr, kc)) = sr_[i].ks1; } while (0)
#define SWAIT() asm volatile("s_waitcnt vmcnt(0)" ::: "memory")
#define RESC(a) do { if (__any((a) < 1.f)) { if (hi == 0) al_l[r32] = (a); asm volatile("s_waitcnt lgkmcnt(0)" ::: "memory"); \
    for (int d = 0; d < 4; ++d) for (int r = 0; r < 16; ++r) o[d][r] *= al_l[crow(r, hi)]; } } while (0)
  f32x16 pA0, pA1, pB0, pB1; float mnA, mnB, alA, alB; bf16x8 pa0, pa1, pa2, pa3; const int NT = 4 * (qb + 1);
  constexpr int SE = 0, SO = 0;
  SLOAD(SE, key0(0, qb)); asm volatile("s_waitcnt vmcnt(0)" ::: "memory"); SWRITE(0, SE); __syncthreads();
  qkt(pA0, pA1, K_lds, qr, kb4); mask_tile(pA0, pA1, 0, selmask, rowb, hi); partialSM(pA0, pA1, m_reg, mnA, alA);
  SLOAD(SO, key0(1, qb));
  SWAIT(); SWRITE(1, SO); __syncthreads();
  for (int j = 1; j + 1 < NT; j += 2) {
    SBAR(); qkt(pB0, pB1, K_lds + SHM_K, qr, kb4);
    finishSM(pA0, pA1, alA, l_reg, pa0, pa1, pa2, pa3); SBAR();
    SLOAD(SO, key0(j + 1, qb)); SBAR();
    pv_d0(o, vb0, pa0, pa1, pa2, pa3); mask_tile(pB0, pB1, j, selmask, rowb, hi); partialSM(pB0, pB1, m_reg, mnB, alB);
    __syncthreads(); SWAIT(); SWRITE(0, SE);
    RESC(alB); __syncthreads();
    SBAR(); qkt(pA0, pA1, K_lds, qr, kb4);
    finishSM(pB0, pB1, alB, l_reg, pa0, pa1, pa2, pa3); SBAR();
    SLOAD(SE, key0(j + 2, qb)); SBAR();
    pv_d0(o, vb0 + (int)SHM_V, pa0, pa1, pa2, pa3); mask_tile(pA0, pA1, j + 1, selmask, rowb, hi); partialSM(pA0, pA1, m_reg, mnA, alA);
    __syncthreads(); SWAIT(); SWRITE(1, SO);
    RESC(alA); __syncthreads();
  }
  SBAR(); qkt(pB0, pB1, K_lds + SHM_K, qr, kb4);
  finishSM(pA0, pA1, alA, l_reg, pa0, pa1, pa2, pa3); SBAR();
  pv_d0(o, vb0, pa0, pa1, pa2, pa3); mask_tile(pB0, pB1, NT - 1, selmask, rowb, hi); partialSM(pB0, pB1, m_reg, mnB, alB);
  __syncthreads(); RESC(alB);
  finishSM(pB0, pB1, alB, l_reg, pa0, pa1, pa2, pa3); SBAR();
  pv_d0(o, vb0 + (int)SHM_V, pa0, pa1, pa2, pa3);
  if (hi == 0) li_l[r32] = l_reg; asm volatile("s_waitcnt lgkmcnt(0)" ::: "memory");
  float rli[16];
#pragma unroll
  for (int r = 0; r < 16; ++r) rli[r] = __builtin_amdgcn_rcpf(li_l[crow(r, hi)]);
  unsigned ooff = (unsigned)((wid * QBLK + 4 * hi) * LDO + r32); asm volatile("" : "+v"(ooff));
#pragma unroll
  for (int r = 0; r < 16; ++r) { const int cr = (r & 3) + 8 * (r >> 2);
#pragma unroll
    for (int d0 = 0; d0 < 4; ++d0) { const float v = o[d0][r] * rli[r]; unsigned u = __float_as_uint(v); u = (u + 0x7fffu + ((u >> 16) & 1u)) >> 16; Ob[ooff + (unsigned)(cr * LDO + d0 * 32)] = (unsigned short)u; } }
  asm volatile("s_waitcnt lgkmcnt(0)" ::: "memory"); __syncthreads();
#undef SLOAD
#undef SWRITE
#undef SWAIT
#undef RESC
}
#undef KSWZ
#undef SBAR
}

namespace gf {
typedef short bf16x8 __attribute__((ext_vector_type(8)));
typedef short s16x4 __attribute__((ext_vector_type(4)));
typedef float f32x4 __attribute__((ext_vector_type(4)));
typedef unsigned u32x2 __attribute__((ext_vector_type(2)));
typedef unsigned u32x4 __attribute__((ext_vector_type(4)));
#define GF_LAS __attribute__((address_space(3)))
constexpr int PK = 528, PV = 272, PJ = 144;
constexpr int L_QD = 0, L_KI = 64 * PK, L_VV = 2 * 64 * PK, L_PP = L_VV + 64 * PV, L_DEC = L_PP + 64 * PJ, L_END = L_DEC + 1024;
constexpr int L_SSX = 131072 + 1024, PSX = 144, L_RS = L_SSX + 64 * 144;
static_assert(L_END <= 131072 && L_RS + 256 <= 147456, "fused GLA LDS map");
constexpr float GF_EPS = 1e-6f;
constexpr unsigned GF_SPIN_CAP = 1u << 16;
__device__ __forceinline__ unsigned cvtpk(float lo, float hi) { typedef __bf16 bf2_ __attribute__((ext_vector_type(2))); typedef float f2_ __attribute__((ext_vector_type(2))); const f2_ f = {lo, hi}; return __builtin_bit_cast(unsigned, __builtin_convertvector(f, bf2_)); }
__device__ __forceinline__ s16x4 trrd(int addr) { s16x4 r; asm volatile("ds_read_b64_tr_b16 %0, %1" : "=&v"(r) : "v"(addr) : "memory"); return r; }
template <int OFF> __device__ __forceinline__ s16x4 trrdo(int addr) { static_assert(OFF >= 0 && OFF < 65536, "ds offset"); s16x4 r; asm volatile("ds_read_b64_tr_b16 %0, %1 offset:%2" : "=&v"(r) : "v"(addr), "n"(OFF) : "memory"); return r; }
#define GF_FRAG(base, row, pitch, kbyte) (*(const GF_LAS bf16x8*)((base) + (row) * (pitch) + (kbyte)))

__device__ __forceinline__ void fused_unit(const unsigned short* __restrict__ Qd, const unsigned short* __restrict__ Ki, const unsigned short* __restrict__ V, int ldv,
                                           const unsigned short* __restrict__ SGR, int ldsgr, const float* __restrict__ DEC, const float* __restrict__ gn, unsigned short* __restrict__ Out, int ldo,
                                           float* SSQh, int dvs, GF_LAS unsigned char* lds) {
    int tid = threadIdx.x; asm volatile("" : "+v"(tid));
    const int w = __builtin_amdgcn_readfirstlane(tid >> 6); int lane = tid & 63, l15 = lane & 15, g = lane >> 4;
    const int ldsb = (int)(unsigned)(size_t)lds;
    int tr_r = 8 * g + (l15 >> 2), tr_c = 8 * (l15 & 3);
    f32x4 S[16];
#pragma unroll
    for (int tt = 0; tt < 16; ++tt) S[tt] = (f32x4){0.f, 0.f, 0.f, 0.f};
    const f32x4 g4 = *(const f32x4*)(gn + 16 * w + 4 * g);
    u32x4 rq[4], rk[4], rv[2]; float rd = 0.f;
    unsigned vq = (unsigned)(((tid >> 5) * 2048 + 8 * (tid & 31)) * 2), vv = (unsigned)(((tid >> 4) * ldv + 8 * (tid & 15)) * 2), vs = (unsigned)((l15 * ldsgr + 4 * g) * 2), vo = (unsigned)((l15 * ldo + 4 * g) * 2);
    int lq = (tid >> 5) * PK + 16 * (tid & 31), lv = (tid >> 4) * PV + 16 * (tid & 15);
#define GF_LOAD_Q(c) do { _Pragma("unroll") for (int q = 0; q < 4; ++q) rq[q] = *(const u32x4*)((const char*)Qd + (size_t)((c) * 64 + 16 * q) * 4096 + vq); } while (0)
#define GF_LOAD_K(c) do { _Pragma("unroll") for (int q = 0; q < 4; ++q) rk[q] = *(const u32x4*)((const char*)Ki + (size_t)((c) * 64 + 16 * q) * 4096 + vq); } while (0)
#define GF_LOAD_V(c) do { _Pragma("unroll") for (int q = 0; q < 2; ++q) rv[q] = *(const u32x4*)((const char*)V + (size_t)((c) * 64 + 32 * q) * (size_t)(2 * ldv) + vv); \
        if (tid < 256) rd = *(const float*)((const char*)DEC + (size_t)((c) > 0 ? (c) - 1 : 0) * 8192 + 4u * (unsigned)tid); } while (0)
#define GF_LOAD(c) do { GF_LOAD_Q(c); GF_LOAD_K(c); GF_LOAD_V(c); } while (0)
    u32x2 ovp[4], ovq[4]; float ssp = 0.f, ssq = 0.f, pv = 0.f;
#pragma unroll
    for (int it = 0; it < 4; ++it) { ovp[it] = (u32x2){0u, 0u}; ovq[it] = (u32x2){0u, 0u}; }
#define GF_RSTD(CH_) do { const int sl_ = (lane >> 3) & 3, tk_ = 8 * w + (lane & 7); const float* sp_ = SSQh + (size_t)(CH_) * 256 + 64 * sl_ + tk_; float p_ = (sl_ == dvs) ? ssq : pv; \
        for (unsigned n_ = 0; n_ < GF_SPIN_CAP && !(p_ >= 0.f); ++n_) { __builtin_amdgcn_s_sleep(1); p_ = __hip_atomic_load(sp_, __ATOMIC_RELAXED, __HIP_MEMORY_SCOPE_AGENT); } \
        p_ = p_ + __shfl_xor(p_, 8); p_ = p_ + __shfl_xor(p_, 16); \
        if ((lane >> 3) == 0) *(GF_LAS float*)(lds + L_RS + 4 * tk_) = rsqrtf(p_ * (1.f / 512.f) + GF_EPS); } while (0)
#define GF_PUBLISH(CH_) do { if ((lane >> 3) == 0) __hip_atomic_store(SSQh + (size_t)(CH_) * 256 + 64 * dvs + 8 * w + (lane & 7), ssp, __ATOMIC_RELAXED, __HIP_MEMORY_SCOPE_AGENT); } while (0)
#define GF_PEEK(CH_) do { pv = __hip_atomic_load(SSQh + (size_t)(CH_) * 256 + 64 * ((lane >> 3) & 3) + 8 * w + (lane & 7), __ATOMIC_RELAXED, __HIP_MEMORY_SCOPE_AGENT); } while (0)
#define GF_FINAL(CH_) do { _Pragma("unroll") for (int it = 0; it < 4; ++it) { const float rs_ = *(const GF_LAS float*)(lds + L_RS + 4 * (16 * it + l15)); u32x2 o_; \
            o_.x = cvtpk(__uint_as_float(ovq[it].x << 16) * rs_, __uint_as_float(ovq[it].x & 0xffff0000u) * rs_); o_.y = cvtpk(__uint_as_float(ovq[it].y << 16) * rs_, __uint_as_float(ovq[it].y & 0xffff0000u) * rs_); \
            *(u32x2*)((char*)Out + ((size_t)((CH_) * 64 + 16 * it) * ldo + 16 * w) * 2 + vo) = o_; } } while (0)
    GF_LOAD(0);
    for (int c = 0; c < 32; ++c) {
        { int t_ = threadIdx.x; asm volatile("" : "+v"(t_)); tid = t_; lane = t_ & 63; l15 = lane & 15; g = lane >> 4; tr_r = 8 * g + (l15 >> 2); tr_c = 8 * (l15 & 3);
          vq = (unsigned)(((tid >> 5) * 2048 + 8 * (tid & 31)) * 2); vv = (unsigned)(((tid >> 4) * ldv + 8 * (tid & 15)) * 2); vs = (unsigned)((l15 * ldsgr + 4 * g) * 2); vo = (unsigned)((l15 * ldo + 4 * g) * 2);
          lq = (tid >> 5) * PK + 16 * (tid & 31); lv = (tid >> 4) * PV + 16 * (tid & 15); }
#pragma unroll
        for (int q = 0; q < 4; ++q) { *(GF_LAS u32x4*)(lds + L_QD + 16 * q * PK + lq) = rq[q]; *(GF_LAS u32x4*)(lds + L_KI + 16 * q * PK + lq) = rk[q]; }
#pragma unroll
        for (int q = 0; q < 2; ++q) *(GF_LAS u32x4*)(lds + L_VV + 32 * q * PV + lv) = rv[q];
        if (tid < 256) *(GF_LAS float*)(lds + L_DEC + 4 * tid) = rd;
        if (c > 0) GF_PUBLISH(c - 1);
        if (c > 1) GF_RSTD(c - 2);
        u32x2 sg[4];
#pragma unroll
        for (int it = 0; it < 4; ++it) sg[it] = *(const u32x2*)((const char*)SGR + ((size_t)(c * 64 + 16 * it) * ldsgr + 16 * w) * 2 + vs);
        if (c + 1 < 32) GF_LOAD_Q(c + 1);
        asm volatile("s_waitcnt lgkmcnt(0)" ::: "memory"); __syncthreads();
        if (c > 1) GF_FINAL(c - 2);
#pragma unroll
        for (int it = 0; it < 4; ++it) ovq[it] = ovp[it];
        ssq = ssp;
        { const int it = w >> 1; f32x4 pa[2] = {(f32x4){0.f, 0.f, 0.f, 0.f}, (f32x4){0.f, 0.f, 0.f, 0.f}};
          bf16x8 pq[8], pk[8][2];
#define GF_LP(k_) do { pq[k_] = GF_FRAG(lds + L_QD, 16 * it + l15, PK, 64 * (k_) + 16 * g); pk[k_][0] = GF_FRAG(lds + L_KI, 16 * (2 * (w & 1)) + l15, PK, 64 * (k_) + 16 * g); \
              pk[k_][1] = GF_FRAG(lds + L_KI, 16 * (2 * (w & 1) + 1) + l15, PK, 64 * (k_) + 16 * g); } while (0)
          GF_LP(0); GF_LP(1);
#pragma unroll
          for (int ks = 0; ks < 8; ++ks) {
              if (ks + 2 < 8) GF_LP(ks + 2);
              __builtin_amdgcn_sched_barrier(0);
#pragma unroll
              for (int jj = 0; jj < 2; ++jj) pa[jj] = __builtin_amdgcn_mfma_f32_16x16x32_bf16(pk[ks][jj], pq[ks], pa[jj], 0, 0, 0);
              __builtin_amdgcn_sched_barrier(0); }
#undef GF_LP
#pragma unroll
          for (int jj = 0; jj < 2; ++jj) { const int i = 16 * it + l15, j0 = 16 * (2 * (w & 1) + jj) + 4 * g; f32x4 v = pa[jj];
#pragma unroll
              for (int r = 0; r < 4; ++r) v[r] = (j0 + r <= i) ? v[r] : 0.f;
              u32x2 o; o.x = cvtpk(v[0], v[1]); o.y = cvtpk(v[2], v[3]); *(GF_LAS u32x2*)(lds + L_PP + i * PJ + 2 * j0) = o; } }
        if (c + 1 < 32) GF_LOAD_K(c + 1);
        asm volatile("s_waitcnt lgkmcnt(0)" ::: "memory"); __syncthreads();
        bf16x8 vf[2];
        { const int a0 = ldsb + L_VV + tr_r * PV + 2 * (16 * w) + tr_c;
          const s16x4 x0 = trrd(a0), x1 = trrd(a0 + 4 * PV), x2 = trrd(a0 + 32 * PV), x3 = trrd(a0 + 36 * PV);
          asm volatile("s_waitcnt lgkmcnt(0)" ::: "memory"); __builtin_amdgcn_sched_barrier(0);
          vf[0] = (bf16x8){x0[0], x0[1], x0[2], x0[3], x1[0], x1[1], x1[2], x1[3]}; vf[1] = (bf16x8){x2[0], x2[1], x2[2], x2[3], x3[0], x3[1], x3[2], x3[3]}; }
        f32x4 oa[4];
#pragma unroll
        for (int it = 0; it < 4; ++it) oa[it] = (f32x4){0.f, 0.f, 0.f, 0.f};
#pragma unroll
        for (int ks = 0; ks < 2; ++ks)
#pragma unroll
            for (int it = 0; it < 4; ++it) { const bf16x8 pf = GF_FRAG(lds + L_PP, 16 * it + l15, PJ, 64 * ks + 16 * g); oa[it] = __builtin_amdgcn_mfma_f32_16x16x32_bf16(vf[ks], pf, oa[it], 0, 0, 0); }
        if (c + 1 < 32) GF_LOAD_V(c + 1);
        { const int cp = c > 0 ? c - 1 : 0; GF_PEEK(cp); }
        if (c > 0) {
            u32x4 qf[8][4];
            f32x4 dq[8][2];
#define GF_LQ(s_) do { _Pragma("unroll") for (int it = 0; it < 4; ++it) { const GF_LAS unsigned char* qp = lds + L_QD + (16 * it + l15) * PK + 2 * (32 * (s_) + 4 * g); \
                const u32x2 q0 = *(const GF_LAS u32x2*)qp, q1 = *(const GF_LAS u32x2*)(qp + 32); qf[s_][it] = (u32x4){q0.x, q0.y, q1.x, q1.y}; } \
                dq[s_][0] = *(const GF_LAS f32x4*)(lds + L_DEC + 4 * (16 * (2 * (s_)) + 4 * g)); dq[s_][1] = *(const GF_LAS f32x4*)(lds + L_DEC + 4 * (16 * (2 * (s_) + 1) + 4 * g)); } while (0)
            GF_LQ(0); GF_LQ(1);
#pragma unroll
            for (int s = 0; s < 8; ++s) {
                if (s + 2 < 8) GF_LQ(s + 2);
                __builtin_amdgcn_sched_barrier(0);
                { float z_ = 0.f; asm volatile("" : "+v"(z_));
                  _Pragma("unroll") for (int h = 0; h < 2; ++h) { f32x4 t = S[2 * s + h]; const f32x4 d = dq[s][h]; t[0] = t[0] * d[0]; t[1] = __builtin_fmaf(t[1], d[1], z_); t[2] = t[2] * d[2]; t[3] = __builtin_fmaf(t[3], d[3], z_); S[2 * s + h] = t; } }
                u32x4 sw; sw.x = cvtpk(S[2 * s][0], S[2 * s][1]); sw.y = cvtpk(S[2 * s][2], S[2 * s][3]); sw.z = cvtpk(S[2 * s + 1][0], S[2 * s + 1][1]); sw.w = cvtpk(S[2 * s + 1][2], S[2 * s + 1][3]);
                const bf16x8 sf = __builtin_bit_cast(bf16x8, sw);
#pragma unroll
                for (int it = 0; it < 4; ++it) oa[it] = __builtin_amdgcn_mfma_f32_16x16x32_bf16(sf, __builtin_bit_cast(bf16x8, qf[s][it]), oa[it], 0, 0, 0);
                __builtin_amdgcn_sched_barrier(0); }
#undef GF_LQ
        }
#define GF_TR4(T4_, U_) x[U_][0] = trrdo<2 * 16 * (4 * T4_ + U_)>(a0); x[U_][1] = trrdo<2 * 16 * (4 * T4_ + U_) + 4 * PK>(a0); x[U_][2] = trrdo<2 * 16 * (4 * T4_ + U_) + 32 * PK>(a0); x[U_][3] = trrdo<2 * 16 * (4 * T4_ + U_) + 36 * PK>(a0);
#define GF_SUPD(T4_) { s16x4 x[4][4]; const int a0 = ldsb + L_KI + tr_r * PK + tr_c;         \
            GF_TR4(T4_, 0) GF_TR4(T4_, 1) GF_TR4(T4_, 2) GF_TR4(T4_, 3) \
            asm volatile("s_waitcnt lgkmcnt(0)" ::: "memory"); __builtin_amdgcn_sched_barrier(0); \
            _Pragma("unroll") for (int u = 0; u < 4; ++u) { const int tt = 4 * T4_ + u; \
                const bf16x8 k0 = (bf16x8){x[u][0][0], x[u][0][1], x[u][0][2], x[u][0][3], x[u][1][0], x[u][1][1], x[u][1][2], x[u][1][3]}, k1 = (bf16x8){x[u][2][0], x[u][2][1], x[u][2][2], x[u][2][3], x[u][3][0], x[u][3][1], x[u][3][2], x[u][3][3]}; \
                f32x4 a = S[tt]; a = __builtin_amdgcn_mfma_f32_16x16x32_bf16(k0, vf[0], a, 0, 0, 0); a = __builtin_amdgcn_mfma_f32_16x16x32_bf16(k1, vf[1], a, 0, 0, 0); S[tt] = a; } }
        GF_SUPD(0) GF_SUPD(1) GF_SUPD(2) GF_SUPD(3)
#undef GF_SUPD
#undef GF_TR4
#pragma unroll
        for (int it = 0; it < 4; ++it) { const f32x4 o = oa[it]; float sq = (o[0] * o[0] + o[1] * o[1]) + (o[2] * o[2] + o[3] * o[3]);
            *(GF_LAS float*)(lds + L_SSX + (16 * it + l15) * PSX + (4 * w + g) * 4) = sq;
            float m0 = __uint_as_float(sg[it].x << 16), m1 = __uint_as_float(sg[it].x & 0xffff0000u), m2 = __uint_as_float(sg[it].y << 16), m3 = __uint_as_float(sg[it].y & 0xffff0000u);
            m0 = m0 * __builtin_amdgcn_rcpf(1.f + __expf(-m0)); m1 = m1 * __builtin_amdgcn_rcpf(1.f + __expf(-m1)); m2 = m2 * __builtin_amdgcn_rcpf(1.f + __expf(-m2)); m3 = m3 * __builtin_amdgcn_rcpf(1.f + __expf(-m3));
            u32x2 ov; ov.x = cvtpk(o[0] * g4[0] * m0, o[1] * g4[1] * m1); ov.y = cvtpk(o[2] * g4[2] * m2, o[3] * g4[3] * m3);
            ovp[it] = ov; }
        asm volatile("s_waitcnt lgkmcnt(0)" ::: "memory"); __syncthreads();
        { float ws[8];
#pragma unroll
            for (int k = 0; k < 8; ++k) { const f32x4 a = *(const GF_LAS f32x4*)(lds + L_SSX + (8 * w + (lane & 7)) * PSX + 16 * k); ws[k] = (a[0] + a[1]) + (a[2] + a[3]); }
            ssp = ((ws[0] + ws[1]) + (ws[2] + ws[3])) + ((ws[4] + ws[5]) + (ws[6] + ws[7])); }
    }
    GF_PUBLISH(31); GF_RSTD(30);
    asm volatile("s_waitcnt lgkmcnt(0)" ::: "memory"); __syncthreads();
    GF_FINAL(30);
#pragma unroll
    for (int it = 0; it < 4; ++it) ovq[it] = ovp[it];
    ssq = ssp; pv = -1.f;
    __syncthreads();
    GF_RSTD(31);
    asm volatile("s_waitcnt lgkmcnt(0)" ::: "memory"); __syncthreads();
    GF_FINAL(31);
    __syncthreads();
#undef GF_RSTD
#undef GF_PUBLISH
#undef GF_PEEK
#undef GF_FINAL
#undef GF_LOAD
#undef GF_LOAD_Q
#undef GF_LOAD_K
#undef GF_LOAD_V
}
#undef GF_FRAG
}

constexpr int D_MODEL = 4096, BATCH = 4, SEQ = 2048, MTOK = BATCH * SEQ;
constexpr int IN_COLS = 26640, IN_PAD = 26624;
constexpr int OFF_MQ = 0, OFF_MK = 2048, OFF_MV = 4096, OFF_GQ = 6144, OFF_GK = 8192, OFF_GV = 10240, OFF_GR = 14336, OFF_SM = 18432, OFF_SG = 22528, GA_SRC = 18432  , GA_ROW = 26624  ;
constexpr int D_FF = 11008;
constexpr float EPS = 1e-6f;
constexpr int NWAVES = 8, NTHR = 512;
constexpr int WD_SPLIT = 256;
constexpr int LDS_BYTES = 147456, MISC_OFF = 131072;

struct Params {
    const float* in[15]; float* out; unsigned char* ws; unsigned* ctl;
    int ph_lo, ph_hi;
};
struct Ctx { int tid, lane, wave, G, bid; LAS unsigned char* lds; };

template <int MODE, int KG = 8> __device__ __forceinline__ void conv_items(const Ctx& c, const float* __restrict__ W, int K, int N, bf16_t* __restrict__ Bt, int row_off, int u_begin = 0, int u_end = 0x7fffffff) {
    LAS unsigned* scr = (LAS unsigned*)(c.lds + c.wave * 8448);
    typedef float f4v_ __attribute__((ext_vector_type(4)));
    const int lane = c.lane, cq = lane & 15, r = lane >> 4; constexpr int NG = 8 / KG; const int nblk = (N + 63) / 64, nbg = (nblk + NG - 1) / NG, nunits_all = nbg * (K / (64 * KG)), nunits = nunits_all < u_end ? nunits_all : u_end;
#define CV_COORD(U_) const int kb_ = ((U_) / nbg) * KG + (c.wave % KG), nb_ = ((U_) % nbg) * NG + (c.wave / KG); const int k0 = kb_ * 64, n0 = nb_ * 64; const bool live = ((U_) < nunits) && (nb_ < nblk); const bool ok = (n0 + 4 * cq) < N;
  \

#define CV_LOAD(v_, U_) do { const int Uc_ = ((U_) < nunits) ? (U_) : nunits - 1; int kb_ = (Uc_ / nbg) * KG + (c.wave % KG), nb_ = (Uc_ % nbg) * NG + (c.wave / KG); nb_ = nb_ < nblk ? nb_ : nblk - 1; \
        const int k0 = kb_ * 64, n0 = nb_ * 64; const bool ok = (n0 + 4 * cq) < N; const int nc_ = ok ? (n0 + 4 * cq) : (N - 4); \
        _Pragma("unroll") for (int i = 0; i < 16; ++i) { const int kk = 8 * (i >> 1) + 2 * r + (i & 1); f4v_ t_ = __builtin_nontemporal_load((const f4v_*)(W + (size_t)(k0 + kk) * N + nc_)); \
            if (!ok) t_ = (f4v_){0.f, 0.f, 0.f, 0.f}; v_[i] = t_; } } while (0)
#define CV_PROC(v_, U_) do { CV_COORD(U_) (void)ok; if (live) { \
        _Pragma("unroll") for (int m = 0; m < 8; ++m) { const int kp = 4 * m + r;         \
            scr[(4 * cq + 0) * 33 + kp] = pk2(v_[2 * m][0], v_[2 * m + 1][0]); scr[(4 * cq + 1) * 33 + kp] = pk2(v_[2 * m][1], v_[2 * m + 1][1]); \
            scr[(4 * cq + 2) * 33 + kp] = pk2(v_[2 * m][2], v_[2 * m + 1][2]); scr[(4 * cq + 3) * 33 + kp] = pk2(v_[2 * m][3], v_[2 * m + 1][3]); } \
        LDS_WAIT(); asm volatile("" ::: "memory"); \
        _Pragma("unroll") for (int ps = 0; ps < 4; ++ps) { const int nn = (lane >> 2) + 16 * ps, q = lane & 3; const LAS unsigned* sp = scr + nn * 33 + 8 * q; \
            uint4 o0, o1; o0.x = sp[0]; o0.y = sp[1]; o0.z = sp[2]; o0.w = sp[3]; o1.x = sp[4]; o1.y = sp[5]; o1.z = sp[6]; o1.w = sp[7]; \
            const int n = n0 + nn; const int drow = (MODE == 0) ? (row_off + n) : (MODE == 1) ? ((n >> 7) * 256 + (n & 127) + row_off) : ((n < 4096) ? ((n & ~127) + 8 * ((n & 63) >> 2) + 4 * ((n >> 6) & 1) + (n & 3)) : (n < GA_SRC) ? n : (n < GA_SRC + 16) ? (GA_ROW + n - GA_SRC) : (n - 16)) + row_off; \
            if (n < N) { uint4* dp = (uint4*)(Bt + (size_t)drow * K + k0 + 16 * q); dp[0] = o0; dp[1] = o1; } } \
        LDS_WAIT(); asm volatile("" ::: "memory"); } } while (0)
    f4v_ va[16], vb[16];
    CV_LOAD(va, u_begin + c.bid);
    for (int U = u_begin + c.bid; U < nunits; U += 2 * c.G) {
        CV_LOAD(vb, U + c.G);
        CV_PROC(va, U);
        CV_LOAD(va, U + 2 * c.G);
        CV_PROC(vb, U + c.G);
    }
#undef CV_COORD
#undef CV_LOAD
#undef CV_PROC
}
__device__ __forceinline__ void rmsnorm_rows_bf16(const Ctx& c, const float* __restrict__ x, const float* __restrict__ g, bf16_t* __restrict__ out) {
    typedef float f4v_ __attribute__((ext_vector_type(4)));
    const int lane = c.lane, stride = c.G * NWAVES; const float4* gr = (const float4*)g + lane;
#define RN_LOAD(v_, row_) do { if ((row_) < MTOK) { const f4v_* xr = (const f4v_*)(x + (size_t)(row_) * D_MODEL) + lane; _Pragma("unroll") for (int j = 0; j < 16; ++j) v_[j] = xr[64 * j]; } } while (0)
#define RN_PROC(v_, row_) do { if ((row_) < MTOK) { float s = 0.f; \
        _Pragma("unroll") for (int j = 0; j < 16; ++j) s += v_[j][0] * v_[j][0] + v_[j][1] * v_[j][1] + v_[j][2] * v_[j][2] + v_[j][3] * v_[j][3]; \
        const float rstd = rsqrtf(wave_sum(s) * (1.f / D_MODEL) + EPS); uint2* o = (uint2*)(out + (size_t)(row_) * D_MODEL) + lane; \
        _Pragma("unroll") for (int j = 0; j < 16; ++j) { const float4 gg = gr[64 * j]; uint2 w; w.x = pk2(v_[j][0] * rstd * gg.x, v_[j][1] * rstd * gg.y); w.y = pk2(v_[j][2] * rstd * gg.z, v_[j][3] * rstd * gg.w); o[64 * j] = w; \
            if ((j & 3) == 3) asm volatile("" ::: "memory"); } } } while (0)
    f4v_ va[16], vb[16];
    const int row0 = c.bid * NWAVES + c.wave; RN_LOAD(va, row0);
    for (int row = row0; row < MTOK; row += 2 * stride) { RN_LOAD(vb, row + stride); RN_PROC(va, row); RN_LOAD(va, row + 2 * stride); RN_PROC(vb, row + stride); }
#undef RN_LOAD
#undef RN_PROC
}
__device__ __forceinline__ void rope_table_phase(const Ctx& c, float* __restrict__ CS, float* __restrict__ SN) {
    for (int i = c.bid * NTHR + c.tid; i < SEQ * 64; i += c.G * NTHR) { const int j = i & 63, pos = i >> 6;
        const float inv_freq = powf(10000.f, -(float)j / 64.f); const float ang = (float)pos * inv_freq; CS[i] = cosf(ang); SN[i] = sinf(ang); }
}
__device__ __forceinline__ void gla_prep_phase(const Ctx& c, const bf16_t* __restrict__ u, const bf16_t* __restrict__ hrows, const bf16_t* __restrict__ wga, const float* __restrict__ up, const float* __restrict__ bias, float* __restrict__ DEC,
                                               bf16_t* __restrict__ Qd, bf16_t* __restrict__ Ki) {
    LAS float* ga = (LAS float*)c.lds; LAS float* gap = ga + 1024;
    for (int item = c.bid; item < (MTOK / 64) * 2; item += c.G) { const int ci = item >> 1, col = (item & 1) * 1024 + 2 * c.tid;
        __syncthreads();
        unsigned qc[16], kc[16], qn[16], kn[16];
#define PREP_LOAD(q_, k_, tb_) do { _Pragma("unroll") for (int i = 0; i < 16; ++i) { const size_t row_ = (size_t)ci * 64 + (tb_) + i; q_[i] = *(const unsigned*)(u + row_ * IN_PAD + OFF_GQ + col); k_[i] = *(const unsigned*)(u + row_ * IN_PAD + OFF_GK + col); } } while (0)
        PREP_LOAD(qc, kc, 0);
        {
            const int mt = c.wave & 3, kh = c.wave >> 2, l15 = c.lane & 15, lq = c.lane >> 4; pg8::f32x4 a4 = {0.f, 0.f, 0.f, 0.f};
            const bf16_t* hp = hrows + (size_t)(ci * 64 + 16 * mt + l15) * 4096 + 2048 * kh + 8 * lq; const bf16_t* wp = wga + (size_t)l15 * 4096 + 2048 * kh + 8 * lq;
#pragma unroll 16
            for (int ks = 0; ks < 64; ++ks) { const pg8::bf16x8 hf = *(const pg8::bf16x8*)(hp + 32 * ks), wf = *(const pg8::bf16x8*)(wp + 32 * ks); a4 = __builtin_amdgcn_mfma_f32_16x16x32_bf16(hf, wf, a4, 0, 0, 0); }
#pragma unroll
            for (int r = 0; r < 4; ++r) gap[kh * 1024 + (16 * mt + 4 * lq + r) * 16 + l15] = a4[r];
            asm volatile("s_waitcnt lgkmcnt(0)" ::: "memory"); __syncthreads();
            ga[c.tid] = gap[c.tid] + gap[1024 + c.tid]; ga[512 + c.tid] = gap[512 + c.tid] + gap[1536 + c.tid]; }
        float up0[16], up1[16];
#pragma unroll
        for (int r = 0; r < 16; ++r) { const float2 v = *(const float2*)(up + r * 2048 + col); up0[r] = v.x; up1[r] = v.y; }
        const float2 bs = *(const float2*)(bias + col);
        asm volatile("s_waitcnt lgkmcnt(0)" ::: "memory"); __syncthreads();
        float bl0 = 0.f, bl1 = 0.f;
        for (int t = 0; t < 64; ++t) { float x0 = bs.x, x1 = bs.y;
#pragma unroll
            for (int r = 0; r < 16; ++r) { const float g = ga[t * 16 + r]; x0 += g * up0[r]; x1 += g * up1[r]; }
            bl0 += (fminf(x0, 0.f) - __logf(1.f + __expf(-fabsf(x0)))) * 0.0625f; bl1 += (fminf(x1, 0.f) - __logf(1.f + __expf(-fabsf(x1)))) * 0.0625f; }
        *(float2*)(DEC + (size_t)ci * 2048 + col) = make_float2(__expf(bl0), __expf(bl1));
        float bc0 = 0.f, bc1 = 0.f;
#pragma unroll 1
        for (int tb = 0; tb < 64; tb += 16) {
            if (tb + 16 < 64) PREP_LOAD(qn, kn, tb + 16);
            asm volatile("" ::: "memory");
#pragma unroll
          for (int i = 0; i < 16; ++i) { const int t = tb + i; float x0 = bs.x, x1 = bs.y; const size_t row = (size_t)ci * 64 + t;
            const unsigned qw = qc[i], kw = kc[i];
#pragma unroll
            for (int r = 0; r < 16; ++r) { const float g = ga[t * 16 + r]; x0 += g * up0[r]; x1 += g * up1[r]; }
            bc0 += (fminf(x0, 0.f) - __logf(1.f + __expf(-fabsf(x0)))) * 0.0625f; bc1 += (fminf(x1, 0.f) - __logf(1.f + __expf(-fabsf(x1)))) * 0.0625f;
            const float q0 = __uint_as_float(qw << 16), q1 = __uint_as_float(qw & 0xffff0000u), k0 = __uint_as_float(kw << 16), k1 = __uint_as_float(kw & 0xffff0000u);
            const float e0 = __expf(bc0), e1 = __expf(bc1);
            *(unsigned*)(Qd + row * 2048 + col) = pk2(q0 * 0.0625f * e0, q1 * 0.0625f * e1);
            *(unsigned*)(Ki + row * 2048 + col) = pk2(k0 * __expf(-bc0), k1 * __expf(-bc1)); }
            asm volatile("" ::: "memory");
#pragma unroll
            for (int i = 0; i < 16; ++i) { qc[i] = qn[i]; kc[i] = kn[i]; }
        }
#undef PREP_LOAD
    }
    __syncthreads();
}
__device__ __forceinline__ void resnorm1_phase(const Ctx& c, const float* __restrict__ x, const bf16_t* y, const float* __restrict__ g1, const float* __restrict__ g2, float* __restrict__ rstd1, bf16_t* __restrict__ h2, bf16_t* x1b) {
    const int lane = c.lane;
    for (int row = c.bid * NWAVES + c.wave; row < MTOK; row += c.G * NWAVES) {
        const uint2* yr = (const uint2*)(y + (size_t)row * D_MODEL) + lane; uint2* x1o = (uint2*)(x1b + (size_t)row * D_MODEL) + lane; const float4* xr = (const float4*)(x + (size_t)row * D_MODEL) + lane;
        uint2 yw[16]; float4 v[16]; float s = 0.f;
#pragma unroll
        for (int j = 0; j < 16; ++j) yw[j] = yr[64 * j];
#pragma unroll
        for (int j = 0; j < 16; ++j) v[j] = xr[64 * j];
        asm volatile("" ::: "memory");
#pragma unroll
        for (int j = 0; j < 16; ++j) { const float a = __uint_as_float(yw[j].x << 16), b = __uint_as_float(yw[j].x & 0xffff0000u), cc = __uint_as_float(yw[j].y << 16), d = __uint_as_float(yw[j].y & 0xffff0000u); s += a * a + b * b + cc * cc + d * d; }
        const float rstd = rsqrtf(wave_sum(s) * (1.f / D_MODEL) + EPS); float s2 = 0.f;
        if (lane == 0) rstd1[row] = rstd;
#pragma unroll
        for (int j = 0; j < 16; ++j) asm volatile("" : "+v"(yw[j].x), "+v"(yw[j].y));
#pragma unroll
        for (int j = 0; j < 16; ++j) { const float4 gg = ((const float4*)g1)[lane + 64 * j];
            v[j].x = v[j].x + __uint_as_float(yw[j].x << 16) * rstd * gg.x; v[j].y = v[j].y + __uint_as_float(yw[j].x & 0xffff0000u) * rstd * gg.y;
            v[j].z = v[j].z + __uint_as_float(yw[j].y << 16) * rstd * gg.z; v[j].w = v[j].w + __uint_as_float(yw[j].y & 0xffff0000u) * rstd * gg.w;
            s2 += v[j].x * v[j].x + v[j].y * v[j].y + v[j].z * v[j].z + v[j].w * v[j].w;
            { uint2 w1; w1.x = pk2(v[j].x, v[j].y); w1.y = pk2(v[j].z, v[j].w); x1o[64 * j] = w1; }
            if ((j & 3) == 3) asm volatile("" ::: "memory"); }
        const float rstd2 = rsqrtf(wave_sum(s2) * (1.f / D_MODEL) + EPS);
        uint2* o = (uint2*)(h2 + (size_t)row * D_MODEL) + lane;
#pragma unroll
        for (int j = 0; j < 16; ++j) { const float4 gg = ((const float4*)g2)[lane + 64 * j]; uint2 w; w.x = pk2(v[j].x * rstd2 * gg.x, v[j].y * rstd2 * gg.y); w.y = pk2(v[j].z * rstd2 * gg.z, v[j].w * rstd2 * gg.w); o[64 * j] = w; if ((j & 3) == 3) asm volatile("" ::: "memory"); }
    }
}
__device__ __forceinline__ void resnorm2_phase(const Ctx& c, const bf16_t* __restrict__ x1b, const bf16_t* __restrict__ y2, const float* __restrict__ g2, float* __restrict__ out) {
    const int lane = c.lane;
    for (int row = c.bid * NWAVES + c.wave; row < MTOK; row += c.G * NWAVES) {
        const uint2* yr = (const uint2*)(y2 + (size_t)row * D_MODEL) + lane; const uint2* xr = (const uint2*)(x1b + (size_t)row * D_MODEL) + lane; float4* xo = (float4*)(out + (size_t)row * D_MODEL) + lane;
        uint2 yw[16], xw[16]; float s = 0.f;
#pragma unroll
        for (int j = 0; j < 16; ++j) yw[j] = yr[64 * j];
#pragma unroll
        for (int j = 0; j < 16; ++j) xw[j] = xr[64 * j];
        asm volatile("" ::: "memory");
#pragma unroll
        for (int j = 0; j < 16; ++j) { const float a = __uint_as_float(yw[j].x << 16), b = __uint_as_float(yw[j].x & 0xffff0000u), cc = __uint_as_float(yw[j].y << 16), d = __uint_as_float(yw[j].y & 0xffff0000u); s += a * a + b * b + cc * cc + d * d; }
        const float rstd = rsqrtf(wave_sum(s) * (1.f / D_MODEL) + EPS);
#pragma unroll
        for (int j = 0; j < 16; ++j) asm volatile("" : "+v"(yw[j].x), "+v"(yw[j].y));
#pragma unroll
        for (int j = 0; j < 16; ++j) { const float4 gg = ((const float4*)g2)[lane + 64 * j]; const uint2 xq = xw[j], y2q = yw[j];
            float4 o;
            o.x = __uint_as_float(xq.x << 16) + __uint_as_float(y2q.x << 16) * rstd * gg.x; o.y = __uint_as_float(xq.x & 0xffff0000u) + __uint_as_float(y2q.x & 0xffff0000u) * rstd * gg.y;
            o.z = __uint_as_float(xq.y << 16) + __uint_as_float(y2q.y << 16) * rstd * gg.z; o.w = __uint_as_float(xq.y & 0xffff0000u) + __uint_as_float(y2q.y & 0xffff0000u) * rstd * gg.w;
            xo[64 * j] = o; if ((j & 3) == 3) asm volatile("" ::: "memory"); }
    }
}

__device__ __forceinline__ void gla_norm_apply_phase(const Ctx& c, bf16_t* __restrict__ A, const float* __restrict__ SSQ) {
    const int lane = c.lane, stride = c.G * NWAVES;
    for (int row0 = c.bid * NWAVES + c.wave; row0 < MTOK; row0 += 4 * stride) {
        uint4 v[4][8]; float sq[4];
#pragma unroll
        for (int q = 0; q < 4; ++q) { const int row = row0 + q * stride; sq[q] = 0.f;
            if (row < MTOK) { const uint4* ar = (const uint4*)(A + (size_t)row * 4096) + lane;
#pragma unroll
                for (int j = 0; j < 8; ++j) v[q][j] = ar[64 * j];
                sq[q] = SSQ[(size_t)row * 32 + (lane & 31)]; } }
        asm volatile("" ::: "memory");
#pragma unroll
        for (int q = 0; q < 4; ++q) { const int row = row0 + q * stride;
            if (row < MTOK) { uint4* ar = (uint4*)(A + (size_t)row * 4096) + lane;
                float t = sq[q]; t += __shfl_xor(t, 1); t += __shfl_xor(t, 2); const float rr = rsqrtf(t * (1.f / 512.f) + EPS);
#pragma unroll
                for (int j = 0; j < 8; ++j) { const float rj = __int_as_float(__builtin_amdgcn_readlane(__float_as_int(rr), 4 * j)); uint4 o; const unsigned w4[4] = {v[q][j].x, v[q][j].y, v[q][j].z, v[q][j].w}; unsigned o4[4];
#pragma unroll
                    for (int e = 0; e < 4; ++e) o4[e] = pk2(__uint_as_float(w4[e] << 16) * rj, __uint_as_float(w4[e] & 0xffff0000u) * rj);
                    o.x = o4[0]; o.y = o4[1]; o.z = o4[2]; o.w = o4[3]; ar[64 * j] = o; } } }
    }
}

constexpr size_t MiB = 1u << 20;
constexpr size_t WS_CTL = 0, CTL_ZERO_BYTES = 512 * 1024;
constexpr size_t WS_KS = 128 * 1024, WS_CS = 512 * 1024;
constexpr int CW_BAR = 0, CW_QHEAD = 8192, CW_QCONV = 8192 + 64;
constexpr size_t WS_WM = 1 * MiB;
constexpr size_t WS_WG = WS_WM + (size_t)4096 * 2048 * 2;
constexpr size_t WS_WO = WS_WG + (size_t)4096 * 4096 * 2;
constexpr size_t WS_WGU = WS_WO + (size_t)4096 * 4096 * 2;
constexpr size_t WS_WD = WS_WGU + (size_t)22016 * 4096 * 2;
constexpr size_t WS_RA = WS_WD + (size_t)4096 * 11008 * 2;
constexpr size_t RA_BYTES = (size_t)IN_COLS * 4096 * 2;
constexpr size_t WS_RU = WS_RA + RA_BYTES;
constexpr size_t RU_BYTES = (size_t)MTOK * IN_PAD * 2;
constexpr size_t WS_RH = WS_RU + RU_BYTES;
constexpr size_t WS_RO = WS_RH + (size_t)MTOK * 4096 * 2;
constexpr size_t WS_AM = WS_RO + (size_t)MTOK * 4096 * 4;
constexpr size_t WS_AG = WS_AM + (size_t)MTOK * 2048 * 2;
constexpr size_t WS_MG = WS_AG + (size_t)MTOK * 4096 * 2;
constexpr size_t WS_KM = WS_MG + (size_t)MTOK * 4096 * 2;
constexpr size_t WS_HID = WS_KM + 1 * MiB;
constexpr size_t WS_ST = WS_HID;
constexpr size_t WS_END = WS_ST + (size_t)BATCH * 8 * 32 * 512 * 256 * 2;

template <class Epi> __device__ __forceinline__ void gemm_run(const Ctx& c, const bf16_t* A, const bf16_t* Bt, int M, int N, int K, const Epi& E) {
    pg8::Gemm g{A, Bt, M, N, K}; pg8::StaticOrder S; S.init(M, N, c.G, c.bid);
    pg8::gemm_phase<Epi, pg8::StaticOrder, true, true>(c.lds, g, S, E);
}
template <int EPI> __device__ __forceinline__ void gemm_call(const Ctx& c, const bf16_t* A, const bf16_t* Bt, void* C, int M, int N, int K, int ldc) {
    if constexpr (EPI == 0) { pg8::EpiBf16Plain E{(bf16_t*)C, ldc}; gemm_run(c, A, Bt, M, N, K, E); }
    else { pg8::EpiF32 E{(float*)C, ldc, nullptr}; gemm_run(c, A, Bt, M, N, K, E); }
}

__global__ void __launch_bounds__(NTHR, 2) mk_fwd(Params p) {
    extern __shared__ __attribute__((aligned(16))) unsigned char lds_raw[];
    Ctx c; c.lds = (LAS unsigned char*)lds_raw; c.tid = threadIdx.x; c.lane = c.tid & 63; c.wave = __builtin_amdgcn_readfirstlane(c.tid >> 6); c.G = gridDim.x; c.bid = blockIdx.x;
    volatile LAS unsigned* MISC = (volatile LAS unsigned*)(c.lds + MISC_OFF);
    if (c.tid < 64) MISC[c.tid] = 0u;
    __syncthreads();
    XcdBarrier bar = xcd_barrier_post(p.ctl + CW_BAR, MISC + 8);
    const int lo = p.ph_lo, hi = p.ph_hi;
#define IN(k) (lo <= (k) && (k) < hi)
#define FRESH() do { int t_ = threadIdx.x; asm volatile("" : "+v"(t_)); c.tid = t_; c.lane = t_ & 63; c.wave = __builtin_amdgcn_readfirstlane(t_ >> 6); { size_t wso_ = 0; asm volatile("" : "+s"(wso_)); ws = p.ws + wso_; } } while (0)
#define SEAM(k) do { if (IN(k)) xcd_barrier(bar); } while (0)
    unsigned char* ws = p.ws;
#define xin ((const float*)p.in[0])
#define g_premix ((const float*)p.in[1])
#define w_in ((const float*)p.in[2])
#define gate_up ((const float*)p.in[3])
#define gate_bias ((const float*)p.in[4])
#define g_glanorm ((const float*)p.in[5])
#define w_bm ((const float*)p.in[6])
#define w_bg ((const float*)p.in[7])
#define w_out ((const float*)p.in[8])
#define g_postmix ((const float*)p.in[9])
#define g_preffn ((const float*)p.in[10])
#define w_fg ((const float*)p.in[11])
#define w_fu ((const float*)p.in[12])
#define w_fd ((const float*)p.in[13])
#define g_postffn ((const float*)p.in[14])
#define outp (p.out)
#define WmT ((bf16_t*)(ws + WS_WM))
#define WgT ((bf16_t*)(ws + WS_WG))
#define WoT ((bf16_t*)(ws + WS_WO))
#define WguT ((bf16_t*)(ws + WS_WGU))
#define WdT ((bf16_t*)(ws + WS_WD))
#define WinT ((bf16_t*)(ws + WS_RA))
#define MQ ((bf16_t*)(ws + WS_RA))
#define MK (MQ + (size_t)MTOK * 2048)
#define MV (MQ + (size_t)MTOK * 2048 * 2)
#define BC ((float*)(MQ + (size_t)MTOK * 2048 * 3))
#define ymoba ((bf16_t*)(ws + WS_RA + 2 * MiB))
#define ybuf ((bf16_t*)(ws + WS_RA + 2 * MiB))
#define ubuf ((bf16_t*)(ws + WS_RU))
#define gu ((bf16_t*)(ws + WS_RU))
#define hbuf ((bf16_t*)(ws + WS_RH))
#define h2 ((bf16_t*)(ws + WS_RH))
#define Qd ((bf16_t*)(ws + WS_RO))
#define Ki (Qd + (size_t)MTOK * 2048)
#define Ke (Qd + (size_t)MTOK * 2048 * 2)
#define ygla ((float*)(ws + WS_RO))
#define y2 ((bf16_t*)(ws + WS_RO))
#define ST ((bf16_t*)(ws + WS_ST))
#define Am ((bf16_t*)(ws + WS_AM))
#define Ag ((bf16_t*)(ws + WS_AG))
#define mg ((bf16_t*)(ws + WS_MG))
#define KS ((float*)(ws + WS_KS))
#define SSQb ((float*)(ws + WS_RO + 100 * MiB))
#define RS1 ((float*)(ws + WS_KM + 524288))
#define CSt ((float*)(ws + WS_CS))
#define SNt ((float*)(ws + WS_KM))
#define DEC ((float*)(ws + WS_RA))
#define hid ((bf16_t*)(ws + WS_HID))

    if (IN(0)) { FRESH(); } if (IN(0)) {
        conv_items<2>(c, w_in, 4096, IN_COLS, WinT, 0);
        conv_items<0, 4>(c, w_fd, D_FF, 4096, WdT, 0, 0, WD_SPLIT);
        rmsnorm_rows_bf16(c, xin, g_premix, hbuf);
        rope_table_phase(c, CSt, SNt);
    }
    SEAM(0);
    if (IN(1)) { FRESH(); } if (IN(1)) { pg8::EpiIn E{ubuf, IN_PAD, CSt, SNt, KS}; gemm_run(c, hbuf, WinT, MTOK, IN_PAD, 4096, E); }
    SEAM(1);
    if (IN(2)) { FRESH(); } if (IN(2)) { gla_prep_phase(c, ubuf, hbuf, WinT + (size_t)GA_ROW * 4096, gate_up, gate_bias, DEC, Qd, Ki);
        for (int i = c.bid * NTHR + c.tid; i < MTOK * 32; i += c.G * NTHR) __hip_atomic_store(SSQb + i, -1.f, __ATOMIC_RELAXED, __HIP_MEMORY_SCOPE_AGENT); }
    SEAM(2);
    if (IN(4)) { FRESH(); } if (IN(4)) {
        const int half = c.G >> 1;
        if (c.bid < half) {
            for (int it = c.bid; it < BATCH * 8 * 4; it += half) { const int hh = it & 7, dvs = (it >> 3) & 3, b = it >> 5; const size_t t0 = (size_t)(b * SEQ);
                gf::fused_unit(Qd + t0 * 2048 + hh * 256, Ki + t0 * 2048 + hh * 256, ubuf + t0 * IN_PAD + OFF_GV + hh * 512 + dvs * 128, IN_PAD,
                               ubuf + t0 * IN_PAD + OFF_GR + hh * 512 + dvs * 128, IN_PAD, DEC + (size_t)(b * 32) * 2048 + hh * 256, g_glanorm + dvs * 128,
                               Ag + t0 * 4096 + hh * 512 + dvs * 128, 4096, SSQb + (size_t)((b * 8 + hh) * 32) * 256, dvs, c.lds); }
        }
        const bool upper = c.bid >= half, early = upper && ((c.bid & 1) == 0);
        constexpr int EARLY_GRABS = 6;
        const int order = early ? 0x3120 : upper ? 0x4301 : 0x4310;
#pragma unroll 1
        for (int st = 0; st < 4; ++st) { const int op = (order >> (4 * st)) & 15;
            if (op == 0) {
                if (upper) { FRESH(); Ctx c2 = c; c2.bid = c.bid - half; c2.G = c.G - half; conv_items<0>(c2, w_bg, 4096, 4096, WgT, 0); conv_items<0>(c2, w_out, 4096, 4096, WoT, 0); }
                else if (half > 0) { FRESH(); Ctx c2 = c; c2.G = half; conv_items<0>(c2, w_bm, 2048, 4096, WmT, 0); } }
            else if (op == 1) {
                for (;;) { __syncthreads(); if (c.tid == 0) *(volatile LAS unsigned*)(c.lds + MISC_OFF + 64) = atomicAdd(p.ctl + CW_QHEAD, 1u); __syncthreads();
                    const int it = (int)__builtin_amdgcn_readfirstlane(*(volatile LAS unsigned*)(c.lds + MISC_OFF + 64)); if (it >= BATCH * 16 * 8) break;
                    const int qb = 7 - (it >> 6), hd = it & 15, b = (it >> 4) & 3;
                    const size_t q0 = (size_t)(b * SEQ + qb * 256) * IN_PAD + hd * 128, k0 = (size_t)(b * SEQ) * IN_PAD + hd * 128;
                    mb::moba_unit(ubuf + OFF_MQ + q0, ubuf + OFF_MK + k0, ubuf + OFF_MV + k0, Am + (size_t)(b * SEQ + qb * 256) * 2048 + hd * 128, KS + (size_t)((b * 16 + hd) * 8) * 128, qb, (char*)lds_raw); } }
            else if (op == 2 || op == 3) { const int limit = op == 2 ? EARLY_GRABS : (1 << 30);
#pragma unroll 1
                for (int ng = 0; ng < limit; ++ng) { __syncthreads(); if (c.tid == 0) *(volatile LAS unsigned*)(c.lds + MISC_OFF + 64) = atomicAdd(p.ctl + CW_QCONV, 1u); __syncthreads();
                    const int q = (int)__builtin_amdgcn_readfirstlane(*(volatile LAS unsigned*)(c.lds + MISC_OFF + 64)); if (q >= 2 * 344) break;
                    FRESH(); Ctx c1 = c; c1.bid = 0; c1.G = 1; const int up = q >= 344, u0 = 4 * (up ? q - 344 : q);
                    if (up) conv_items<1>(c1, w_fu, 4096, D_FF, WguT, 128, u0, u0 + 4); else conv_items<1>(c1, w_fg, 4096, D_FF, WguT, 0, u0, u0 + 4); } }
        }
    }
    SEAM(4);
    if (IN(6)) { FRESH(); } if (IN(6)) {
        { pg8::EpiGateF32 E{ymoba, 4096, ubuf + OFF_SM, IN_PAD}; gemm_run(c, Am, WmT, MTOK, 4096, 2048, E); }
        { pg8::EpiMergeBf16 E{mg, 4096, ymoba, ubuf + OFF_SG, IN_PAD}; gemm_run(c, Ag, WgT, MTOK, 4096, 4096, E); } }
    SEAM(6);
    if (IN(8)) { FRESH(); } if (IN(8)) gemm_call<0>(c, mg, WoT, ybuf, MTOK, 4096, 4096, 4096);
    SEAM(8);
    if (IN(9)) { FRESH(); } if (IN(9)) resnorm1_phase(c, xin, ybuf, g_postmix, g_preffn, RS1, h2, ybuf);
    SEAM(9);
    if (IN(10)) { FRESH(); } if (IN(10)) { pg8::EpiSwiGLU E{hid, D_FF}; gemm_run(c, h2, WguT, MTOK, 2 * D_FF, 4096, E);
        const int nun = (MTOK / 256) * (2 * D_FF / 256), full = nun / c.G, rem = nun - full * c.G;
        if (rem > 0 && c.bid >= rem) { FRESH(); Ctx c2 = c; c2.bid = c.bid - rem; c2.G = c.G - rem; __syncthreads(); conv_items<0, 4>(c2, w_fd, D_FF, 4096, WdT, 0, WD_SPLIT); }
        else if (rem == 0) { conv_items<0, 4>(c, w_fd, D_FF, 4096, WdT, 0, WD_SPLIT); } }
    SEAM(10);
    if (IN(12)) { FRESH(); } if (IN(12)) gemm_call<0>(c, hid, WdT, y2, MTOK, 4096, D_FF, 4096);
    SEAM(12);
    if (IN(13)) { FRESH(); } if (IN(13)) resnorm2_phase(c, ybuf, y2, g_postffn, outp);
#undef IN
#undef SEAM
}
#undef xin
#undef g_premix
#undef w_in
#undef gate_up
#undef gate_bias
#undef g_glanorm
#undef w_bm
#undef w_bg
#undef w_out
#undef g_postmix
#undef g_preffn
#undef w_fg
#undef w_fu
#undef w_fd
#undef g_postffn
#undef outp
#undef WmT
#undef WgT
#undef WoT
#undef WguT
#undef WdT
#undef WinT
#undef MQ
#undef MK
#undef MV
#undef BC
#undef ymoba
#undef ybuf
#undef ubuf
#undef gu
#undef hbuf
#undef h2
#undef Qd
#undef Ki
#undef Ke
#undef ygla
#undef y2
#undef ST
#undef Am
#undef Ag
#undef mg
#undef KS
#undef SSQb
#undef RS1
#undef CSt
#undef SNt
#undef DEC
#undef hid


extern "C" void kernel_launch(void* const* d_in, const int* in_sizes, int n_in, void* d_out, int out_size, void* d_ws, size_t ws_size, hipStream_t stream) {
    static int grid = 0;
    if (grid == 0) {
        if (n_in != 15 || in_sizes[0] != MTOK * D_MODEL || out_size != MTOK * D_MODEL || ws_size < WS_END) {
            fprintf(stderr, "kernel_launch: shape/ws mismatch n_in %d in0 %d out %d ws %zu need %zu\n", n_in, n_in > 0 ? in_sizes[0] : -1, out_size, ws_size, (size_t)WS_END); grid = -1; return; }
        if (hipFuncSetAttribute((const void*)mk_fwd, hipFuncAttributeMaxDynamicSharedMemorySize, LDS_BYTES) != hipSuccess) { fprintf(stderr, "kernel_launch: hipFuncSetAttribute failed\n"); grid = -1; return; }
        int dev = 0, cus = 0, per_cu = 0;
        if (hipGetDevice(&dev) != hipSuccess || hipDeviceGetAttribute(&cus, hipDeviceAttributeMultiprocessorCount, dev) != hipSuccess) { grid = -1; return; }
        if (hipOccupancyMaxActiveBlocksPerMultiprocessor(&per_cu, (const void*)mk_fwd, NTHR, LDS_BYTES) != hipSuccess || per_cu < 1) { fprintf(stderr, "kernel_launch: occupancy query says %d blocks/CU\n", per_cu); grid = -1; (void)hipGetLastError(); return; }
        grid = cus;
    }
    if (grid < 0) return;
    (void)hipMemsetAsync((char*)d_ws + WS_CTL, 0, CTL_ZERO_BYTES, stream);
    Params p; memset(&p, 0, sizeof(p));
    for (int i = 0; i < 15; ++i) p.in[i] = (const float*)d_in[i];
    p.out = (float*)d_out; p.ws = (unsigned char*)d_ws; p.ctl = (unsigned*)((char*)d_ws + WS_CTL); p.ph_lo = 0; p.ph_hi = 14;
    hipLaunchKernelGGL(mk_fwd, dim3(grid), dim3(NTHR), LDS_BYTES, stream, p);
    const hipError_t le = hipPeekAtLastError();
    if (le != hipSuccess) fprintf(stderr, "kernel_launch: launch failed: %s\n", hipGetErrorName(le));
}
```

```cpp
#include <hip/hip_runtime.h>
#include <cstdio>
#include <cstdint>
#include <cstring>
namespace pg8 {
#define PG8_LAS __attribute__((address_space(3)))
typedef unsigned short bf16_t;
typedef short bf16x8 __attribute__((ext_vector_type(8)));
typedef float f32x4 __attribute__((ext_vector_type(4)));
typedef unsigned u32x4 __attribute__((ext_vector_type(4)));
constexpr int BM = 256, BK = 64, HALF = 128, HTB = HALF * BK * 2  , STAGE_BYTES = 8 * HTB, NXCD = 8, WGM = 8;

__host__ __device__ __forceinline__ int lds_byte(int r, int c) { const int st = (r >> 4) * 2 + (c >> 5), rr = r & 15, cc = c & 31, ob = rr * 64 + cc * 2; return st * 1024 + (ob ^ (((ob >> 9) & 1) << 5)); }
__host__ __device__ __forceinline__ void stage_rc(int b, int& R, int& C) { const int st = b / 1024, sb = b % 1024, swz = sb ^ (((sb >> 9) & 1) << 5); R = (st >> 1) * 16 + swz / 64; C = (st & 1) * 32 + (swz % 64) / 2; }
__host__ __device__ __forceinline__ int perm32(int rho) { const int n = rho >> 4, i = rho & 15; return 8 * (i >> 2) + 4 * n + (i & 3); }

struct Unit { int pm, pn; };
struct Gemm { const bf16_t* A; const bf16_t* Bt; int M, N, K; };

struct StaticOrder {
    int nM, nN, nwg, G, c;
    __host__ __device__ void init(int M, int N, int G_, int c_) { nM = M / BM; nN = N / BM; nwg = nM * nN; G = G_; c = c_; }
    __host__ __device__ bool next(int i, Unit& u) const {
        const long L = (long)i * G + c; if (L >= nwg) return false;
        int wgid = (int)L; { const int q = nwg / NXCD, r = nwg % NXCD, xcd = wgid % NXCD, off = wgid / NXCD; wgid = (xcd < r ? xcd * (q + 1) : r * (q + 1) + (xcd - r) * q) + off; }
        const int nig = WGM * nN, gid = wgid / nig, fm = gid * WGM, gsz = (nM - fm) < WGM ? (nM - fm) : WGM;
        u.pm = fm + ((wgid % nig) % gsz); u.pn = (wgid % nig) / gsz; return true;
    }
    __device__ __forceinline__ void a_ready(const Unit&) const {}
    __device__ __forceinline__ void done(const Unit&) const {}
};
__device__ __forceinline__ unsigned cvt_pk_bf16(float lo, float hi) { typedef __bf16 bf2_ __attribute__((ext_vector_type(2))); typedef float f2_ __attribute__((ext_vector_type(2))); const f2_ f = {lo, hi}; return __builtin_bit_cast(unsigned, __builtin_convertvector(f, bf2_)); }
typedef float f32x2 __attribute__((ext_vector_type(2)));
struct EpiF32 {
    static constexpr bool PERM = false, AFTER_DRAIN = false;
    float* C; int ldc; const float* bias;
    __device__ __forceinline__ void operator()(const f32x4 (&acc)[2][2][4][2], const Unit& u, int wr, int wc, int fr, int fq) const {
        const int row0 = u.pm * BM + wr * 64 + fr, col0 = u.pn * BM + wc * 32 + 4 * fq;
        f32x4 bv[2][2];
#pragma unroll
        for (int bj = 0; bj < 2; ++bj)
#pragma unroll
            for (int n = 0; n < 2; ++n) bv[bj][n] = bias ? *(const f32x4*)(bias + col0 + bj * HALF + n * 16) : (f32x4){0.f, 0.f, 0.f, 0.f};
#pragma unroll
        for (int ai = 0; ai < 2; ++ai)
#pragma unroll
            for (int m = 0; m < 4; ++m) { float* rowp = C + (size_t)(row0 + ai * HALF + m * 16) * ldc + col0;
#pragma unroll
                for (int bj = 0; bj < 2; ++bj)
#pragma unroll
                    for (int n = 0; n < 2; ++n) *(f32x4*)(rowp + bj * HALF + n * 16) = acc[ai][bj][m][n] + bv[bj][n]; }
    }
};
template <class Epi, class Sched, bool ALIGN_EPI = false, bool SP2 = false>
__device__ __forceinline__ void gemm_phase(PG8_LAS unsigned char* lds, const Gemm g, const Sched& S, const Epi& E) {
    const int tid = threadIdx.x, wid = __builtin_amdgcn_readfirstlane(tid >> 6), lane = tid & 63, wr = wid >> 2, wc = wid & 3, fr = lane & 15, fq = lane >> 4;
    const int K = g.K, nt = K / BK;
    unsigned voffA[2], voffB[2];
#pragma unroll
    for (int i = 0; i < 2; ++i) { int R, C; stage_rc(tid * 16 + i * 8192, R, C); const int Rb = Epi::PERM ? ((R & ~31) + perm32(R & 31)) : R;
        voffA[i] = (unsigned)(R * K + C) * 2u; voffB[i] = (unsigned)(Rb * K + C) * 2u; }
    const size_t kstep = (size_t)(BK * 2);
    const size_t hstep = (size_t)HALF * K * 2;
    const size_t tstep = 2 * hstep;
    const unsigned ldsw = (unsigned)wid * 1024u;
    const int aoff = lds_byte(wr * 64 + fr, fq * 8), boff = lds_byte(wc * 32 + fr, fq * 8);
#define PG8_SA(b, h) (((b) * 2 + (h)) * HTB)
#define PG8_SB(b, h) ((4 + (b) * 2 + (h)) * HTB)
#define PG8_STAGE(bufoff, gbase, voff) do { _Pragma("unroll") for (int _i = 0; _i < 2; ++_i) \
        __builtin_amdgcn_global_load_lds((const unsigned*)((const char*)(gbase) + (voff)[_i]), (PG8_LAS unsigned*)(lds + (bufoff) + ldsw + _i * 8192), 16, 0, 0); } while (0)
#define PG8_LDA(dst, b, h) do { _Pragma("unroll") for (int m = 0; m < 4; ++m) _Pragma("unroll") for (int k = 0; k < 2; ++k) dst[m][k] = *(const PG8_LAS bf16x8*)(lds + PG8_SA(b, h) + aoff + m * 2048 + k * 1024); } while (0)
#define PG8_LDB(dst, b, h) do { _Pragma("unroll") for (int n = 0; n < 2; ++n) _Pragma("unroll") for (int k = 0; k < 2; ++k) dst[n][k] = *(const PG8_LAS bf16x8*)(lds + PG8_SB(b, h) + boff + n * 2048 + k * 1024); } while (0)
#define PG8_MMA(ai, bj, At, Bt) do { __builtin_amdgcn_s_setprio(1); _Pragma("unroll") for (int m = 0; m < 4; ++m) _Pragma("unroll") for (int n = 0; n < 2; ++n) _Pragma("unroll") for (int k = 0; k < 2; ++k) \
        acc[ai][bj][m][n] = __builtin_amdgcn_mfma_f32_16x16x32_bf16(Bt[n][k], At[m][k], acc[ai][bj][m][n], 0, 0, 0); __builtin_amdgcn_s_setprio(0); } while (0)
#define PG8_WAIT_V(n) asm volatile("s_waitcnt vmcnt(" #n ")" ::: "memory")
#define PG8_WAIT_L(n) asm volatile("s_waitcnt lgkmcnt(" #n ")" ::: "memory")
#define PG8_BAR __builtin_amdgcn_s_barrier()
#define PG8_SCHED __builtin_amdgcn_sched_barrier(0)
    Unit cur, nxt; int ui = 0;
    if (!S.next(0, cur)) return;
    f32x4 acc[2][2][4][2];
#pragma unroll
    for (int a = 0; a < 2; ++a)
#pragma unroll
        for (int b = 0; b < 2; ++b)
#pragma unroll
            for (int m = 0; m < 4; ++m)
#pragma unroll
                for (int n = 0; n < 2; ++n) acc[a][b][m][n] = (f32x4){0.f, 0.f, 0.f, 0.f};
    bf16x8 At[4][2], B0[2][2], B1[2][2];
    const char* cA = (const char*)g.A + (size_t)cur.pm * tstep; const char* cB = (const char*)g.Bt + (size_t)cur.pn * tstep;
    S.a_ready(cur);
    if constexpr (SP2) {
        PG8_STAGE(PG8_SB(0, 0), cB, voffB); PG8_STAGE(PG8_SB(0, 1), cB + hstep, voffB); PG8_STAGE(PG8_SA(0, 0), cA, voffA); PG8_STAGE(PG8_SA(0, 1), cA + hstep, voffA);
        if (wr == 1) PG8_BAR;
        PG8_WAIT_V(2); PG8_BAR;
        PG8_STAGE(PG8_SB(1, 0), cB + kstep, voffB); PG8_STAGE(PG8_SA(1, 0), cA + kstep, voffA); PG8_STAGE(PG8_SB(1, 1), cB + hstep + kstep, voffB);
        PG8_WAIT_V(6); PG8_BAR;
    } else {
        PG8_STAGE(PG8_SB(0, 0), cB, voffB); PG8_STAGE(PG8_SA(0, 0), cA, voffA); PG8_STAGE(PG8_SB(0, 1), cB + hstep, voffB); PG8_STAGE(PG8_SA(0, 1), cA + hstep, voffA);
        if (wr == 1) PG8_BAR;
        PG8_WAIT_V(4); PG8_BAR;
        PG8_STAGE(PG8_SB(1, 0), cB + kstep, voffB); PG8_STAGE(PG8_SA(1, 0), cA + kstep, voffA); PG8_STAGE(PG8_SB(1, 1), cB + hstep + kstep, voffB);
        PG8_WAIT_V(6); PG8_BAR;
    }
    for (;;) {
        const bool has_next = S.next(ui + 1, nxt);
        const char* nA = has_next ? (const char*)g.A + (size_t)nxt.pm * tstep : cA; const char* nB = has_next ? (const char*)g.Bt + (size_t)nxt.pn * tstep : cB;
        for (int t = 0; t < nt; t += 2) {
            const bool last = (t == nt - 2);
            const char* a1 = cA + (size_t)(t + 1) * kstep;
            const char* a2 = last ? nA : cA + (size_t)(t + 2) * kstep; const char* b2 = last ? nB : cB + (size_t)(t + 2) * kstep;
            const char* a3 = a2 + kstep; const char* b3 = b2 + kstep;
            if (last && has_next) S.a_ready(nxt);
            if constexpr (SP2) {
            PG8_LDB(B0, 0, 0); PG8_LDB(B1, 0, 1); PG8_SCHED; PG8_LDA(At, 0, 0); PG8_STAGE(PG8_SA(1, 1), a1 + hstep, voffA);
            PG8_WAIT_V(8); PG8_WAIT_L(0); PG8_BAR; PG8_MMA(0, 0, At, B0); PG8_MMA(0, 1, At, B1); PG8_BAR; PG8_SCHED;
            PG8_LDA(At, 0, 1); PG8_STAGE(PG8_SB(0, 0), b2, voffB); PG8_STAGE(PG8_SB(0, 1), b2 + hstep, voffB); PG8_STAGE(PG8_SA(0, 0), a2, voffA);
            PG8_WAIT_V(8); PG8_WAIT_L(0); PG8_BAR; PG8_MMA(1, 0, At, B0); PG8_MMA(1, 1, At, B1); PG8_BAR; PG8_SCHED;
            PG8_LDB(B0, 1, 0); PG8_LDB(B1, 1, 1); PG8_SCHED; PG8_LDA(At, 1, 0); PG8_STAGE(PG8_SA(0, 1), a2 + hstep, voffA);
            PG8_WAIT_V(8); PG8_WAIT_L(0); PG8_BAR; PG8_MMA(0, 0, At, B0); PG8_MMA(0, 1, At, B1); PG8_BAR; PG8_SCHED;
            PG8_LDA(At, 1, 1); PG8_STAGE(PG8_SB(1, 0), b3, voffB); PG8_STAGE(PG8_SB(1, 1), b3 + hstep, voffB); PG8_STAGE(PG8_SA(1, 0), a3, voffA);
            PG8_WAIT_V(8); PG8_WAIT_L(0); PG8_BAR; PG8_MMA(1, 0, At, B0); PG8_MMA(1, 1, At, B1); PG8_BAR; PG8_SCHED;
            } else {
            PG8_LDB(B0, 0, 0); PG8_SCHED; PG8_LDA(At, 0, 0); PG8_STAGE(PG8_SA(1, 1), a1 + hstep, voffA);
            PG8_WAIT_L(8); PG8_BAR; PG8_WAIT_L(0); PG8_MMA(0, 0, At, B0); PG8_BAR; PG8_SCHED;
            PG8_LDB(B1, 0, 1); PG8_STAGE(PG8_SB(0, 0), b2, voffB);
            PG8_BAR; PG8_WAIT_L(0); PG8_MMA(0, 1, At, B1); PG8_BAR;
            PG8_LDA(At, 0, 1); PG8_STAGE(PG8_SA(0, 0), a2, voffA);
            PG8_BAR; PG8_WAIT_L(0); PG8_MMA(1, 0, At, B0); PG8_BAR; PG8_SCHED;
            PG8_STAGE(PG8_SB(0, 1), b2 + hstep, voffB);
            PG8_WAIT_V(6); PG8_BAR; PG8_MMA(1, 1, At, B1); PG8_BAR;
            PG8_LDB(B0, 1, 0); PG8_SCHED; PG8_LDA(At, 1, 0); PG8_STAGE(PG8_SA(0, 1), a2 + hstep, voffA);
            PG8_WAIT_L(8); PG8_BAR; PG8_WAIT_L(0); PG8_MMA(0, 0, At, B0); PG8_BAR; PG8_SCHED;
            PG8_LDB(B1, 1, 1); PG8_STAGE(PG8_SB(1, 0), b3, voffB);
            PG8_BAR; PG8_WAIT_L(0); PG8_MMA(0, 1, At, B1); PG8_BAR;
            PG8_LDA(At, 1, 1); PG8_STAGE(PG8_SA(1, 0), a3, voffA);
            PG8_BAR; PG8_WAIT_L(0); PG8_MMA(1, 0, At, B0); PG8_BAR; PG8_SCHED;
            PG8_STAGE(PG8_SB(1, 1), b3 + hstep, voffB);
            PG8_WAIT_V(6); PG8_BAR; PG8_MMA(1, 1, At, B1); PG8_BAR;
            }
        }
        if constexpr (ALIGN_EPI) { if (wr == 0) PG8_BAR; }
        if constexpr (!Epi::AFTER_DRAIN) { E(acc, cur, wr, wc, fr, fq); S.done(cur); }
        if (!has_next) break;
#pragma unroll
        for (int a = 0; a < 2; ++a)
#pragma unroll
            for (int b = 0; b < 2; ++b)
#pragma unroll
                for (int m = 0; m < 4; ++m)
#pragma unroll
                    for (int n = 0; n < 2; ++n) acc[a][b][m][n] = (f32x4){0.f, 0.f, 0.f, 0.f};
        cur = nxt; cA = nA; cB = nB; ++ui;
        if constexpr (ALIGN_EPI) { if (wr == 1) PG8_BAR; }
    }
    PG8_WAIT_V(0);
    if constexpr (!ALIGN_EPI) { if (wr == 0) PG8_BAR; }
    PG8_BAR;
    if constexpr (Epi::AFTER_DRAIN) { E.fused(acc, cur, wr, wc, fr, fq, lds, wid, lane); S.done(cur); }
#undef PG8_SA
#undef PG8_SB
#undef PG8_STAGE
#undef PG8_LDA
#undef PG8_LDB
#undef PG8_MMA
#undef PG8_WAIT_V
#undef PG8_WAIT_L
#undef PG8_BAR
#undef PG8_SCHED
}
}

namespace pg8 {
struct EpiBf16Plain {
    static constexpr bool PERM = true, AFTER_DRAIN = false;
    bf16_t* O; int ldc;
    __device__ __forceinline__ void operator()(const f32x4 (&acc)[2][2][4][2], const Unit& u, int wr, int wc, int fr, int fq) const {
        const int row0 = u.pm * BM + wr * 64 + fr; const int col0 = u.pn * BM + wc * 32 + 8 * fq;
#pragma unroll
        for (int ai = 0; ai < 2; ++ai)
#pragma unroll
            for (int m = 0; m < 4; ++m) { bf16_t* rowp = O + (size_t)(row0 + ai * HALF + m * 16) * ldc + col0;
#pragma unroll
                for (int bj = 0; bj < 2; ++bj) { const f32x4 v0 = acc[ai][bj][m][0], v1 = acc[ai][bj][m][1];
                    u32x4 w; w.x = cvt_pk_bf16(v0[0], v0[1]); w.y = cvt_pk_bf16(v0[2], v0[3]); w.z = cvt_pk_bf16(v1[0], v1[1]); w.w = cvt_pk_bf16(v1[2], v1[3]);
                    *(u32x4*)(rowp + bj * HALF) = w; } }
    }
};
}

namespace pg8 {
__device__ __forceinline__ float sigm(float x) { return __builtin_amdgcn_rcpf(1.f + __expf(-x)); }
struct EpiSwiGLU {
    static constexpr bool PERM = true, AFTER_DRAIN = false;
    bf16_t* O; int ldc;
    __device__ __forceinline__ void operator()(const f32x4 (&acc)[2][2][4][2], const Unit& u, int wr, int wc, int fr, int fq) const {
        const int row0 = u.pm * BM + wr * 64 + fr; const int col0 = u.pn * HALF + wc * 32 + 8 * fq;
#pragma unroll
        for (int ai = 0; ai < 2; ++ai)
#pragma unroll
            for (int m = 0; m < 4; ++m) { bf16_t* rowp = O + (size_t)(row0 + ai * HALF + m * 16) * ldc + col0; float v[8];
#pragma unroll
                for (int n = 0; n < 2; ++n)
#pragma unroll
                    for (int e = 0; e < 4; ++e) { const float g = acc[ai][0][m][n][e], up = acc[ai][1][m][n][e]; v[4 * n + e] = g * sigm(g) * up; }
                u32x4 w; w.x = cvt_pk_bf16(v[0], v[1]); w.y = cvt_pk_bf16(v[2], v[3]); w.z = cvt_pk_bf16(v[4], v[5]); w.w = cvt_pk_bf16(v[6], v[7]);
                *(u32x4*)rowp = w; }
    }
};
struct EpiGateF32 {
    static constexpr bool PERM = true, AFTER_DRAIN = false;
    bf16_t* Y; int ldc; const bf16_t* G; int ldg;
    __device__ __forceinline__ void operator()(const f32x4 (&acc)[2][2][4][2], const Unit& u, int wr, int wc, int fr, int fq) const {
        const int row0 = u.pm * BM + wr * 64 + fr; const int col0 = u.pn * BM + wc * 32 + 8 * fq;
#pragma unroll
        for (int ai = 0; ai < 2; ++ai)
#pragma unroll
            for (int m = 0; m < 4; ++m) { const size_t r = (size_t)(row0 + ai * HALF + m * 16);
#pragma unroll
                for (int bj = 0; bj < 2; ++bj) { const u32x4 g = *(const u32x4*)(G + r * ldg + col0 + bj * HALF); f32x4 o0, o1;
#pragma unroll
                    for (int e = 0; e < 2; ++e) { o0[2 * e] = sigm(__uint_as_float(g[e] << 16)) * acc[ai][bj][m][0][2 * e]; o0[2 * e + 1] = sigm(__uint_as_float(g[e] & 0xffff0000u)) * acc[ai][bj][m][0][2 * e + 1];
                        o1[2 * e] = sigm(__uint_as_float(g[2 + e] << 16)) * acc[ai][bj][m][1][2 * e]; o1[2 * e + 1] = sigm(__uint_as_float(g[2 + e] & 0xffff0000u)) * acc[ai][bj][m][1][2 * e + 1]; }
                    u32x4 w; w.x = cvt_pk_bf16(o0[0], o0[1]); w.y = cvt_pk_bf16(o0[2], o0[3]); w.z = cvt_pk_bf16(o1[0], o1[1]); w.w = cvt_pk_bf16(o1[2], o1[3]);
                    *(u32x4*)(Y + r * ldc + col0 + bj * HALF) = w; } }
    }
};
struct EpiMergeBf16 {
    static constexpr bool PERM = true, AFTER_DRAIN = false;
    bf16_t* O; int ldc; const bf16_t* Y; const bf16_t* G; int ldg;
    __device__ __forceinline__ void operator()(const f32x4 (&acc)[2][2][4][2], const Unit& u, int wr, int wc, int fr, int fq) const {
        const int row0 = u.pm * BM + wr * 64 + fr; const int col0 = u.pn * BM + wc * 32 + 8 * fq;
#pragma unroll
        for (int ai = 0; ai < 2; ++ai)
#pragma unroll
            for (int m = 0; m < 4; ++m) { const size_t r = (size_t)(row0 + ai * HALF + m * 16);
#pragma unroll
                for (int bj = 0; bj < 2; ++bj) { const u32x4 g = *(const u32x4*)(G + r * ldg + col0 + bj * HALF); const u32x4 yw = *(const u32x4*)(Y + r * ldc + col0 + bj * HALF); const f32x4 y0 = {__uint_as_float(yw[0] << 16), __uint_as_float(yw[0] & 0xffff0000u), __uint_as_float(yw[1] << 16), __uint_as_float(yw[1] & 0xffff0000u)}, y1 = {__uint_as_float(yw[2] << 16), __uint_as_float(yw[2] & 0xffff0000u), __uint_as_float(yw[3] << 16), __uint_as_float(yw[3] & 0xffff0000u)}; f32x4 o0, o1;
#pragma unroll
                    for (int e = 0; e < 2; ++e) { o0[2 * e] = y0[2 * e] + sigm(__uint_as_float(g[e] << 16)) * acc[ai][bj][m][0][2 * e]; o0[2 * e + 1] = y0[2 * e + 1] + sigm(__uint_as_float(g[e] & 0xffff0000u)) * acc[ai][bj][m][0][2 * e + 1];
                        o1[2 * e] = y1[2 * e] + sigm(__uint_as_float(g[2 + e] << 16)) * acc[ai][bj][m][1][2 * e]; o1[2 * e + 1] = y1[2 * e + 1] + sigm(__uint_as_float(g[2 + e] & 0xffff0000u)) * acc[ai][bj][m][1][2 * e + 1]; }
                    u32x4 w; w.x = cvt_pk_bf16(o0[0], o0[1]); w.y = cvt_pk_bf16(o0[2], o0[3]); w.z = cvt_pk_bf16(o1[0], o1[1]); w.w = cvt_pk_bf16(o1[2], o1[3]);
                    *(u32x4*)(O + r * ldc + col0 + bj * HALF) = w; } }
    }
};
}

namespace pg8 {
struct EpiIn {
    static constexpr bool PERM = true, AFTER_DRAIN = false;
    bf16_t* O; int ldc; const float* CS; const float* SN; float* KS;
    __device__ __forceinline__ void operator()(const f32x4 (&acc)[2][2][4][2], const Unit& u, int wr, int wc, int fr_, int fq_) const {
        int fr = fr_, fq = fq_; asm volatile("" : "+v"(fr), "+v"(fq));
        const int row0 = u.pm * BM + wr * 64 + fr; const int col0 = u.pn * BM + wc * 32 + 8 * fq;
        if (u.pn >= 16) {
#pragma unroll
            for (int ai = 0; ai < 2; ++ai)
#pragma unroll
                for (int m = 0; m < 4; ++m) { bf16_t* rowp = O + (size_t)(row0 + ai * HALF + m * 16) * ldc + col0;
#pragma unroll
                    for (int bj = 0; bj < 2; ++bj) { const f32x4 v0 = acc[ai][bj][m][0], v1 = acc[ai][bj][m][1];
                        u32x4 w; w.x = cvt_pk_bf16(v0[0], v0[1]); w.y = cvt_pk_bf16(v0[2], v0[3]); w.z = cvt_pk_bf16(v1[0], v1[1]); w.w = cvt_pk_bf16(v1[2], v1[3]);
                        *(u32x4*)(rowp + bj * HALF) = w; } }
        } else {
            const int q4 = 4 * (4 * wc + fq);
            f32x4 s1[2] = {(f32x4){0.f, 0.f, 0.f, 0.f}, (f32x4){0.f, 0.f, 0.f, 0.f}}, s2[2] = {(f32x4){0.f, 0.f, 0.f, 0.f}, (f32x4){0.f, 0.f, 0.f, 0.f}};
#pragma unroll
            for (int ai = 0; ai < 2; ++ai)
#pragma unroll
                for (int m = 0; m < 4; ++m) { int row = row0 + ai * HALF + m * 16; asm volatile("" : "+v"(row));
                    const int pos = row & 2047;
                    const f32x4 cs = *(const f32x4*)(CS + (unsigned)(pos * 64 + q4)), sn = *(const f32x4*)(SN + (unsigned)(pos * 64 + q4));
                    bf16_t* rowp = O + ((unsigned)row * (unsigned)ldc + (unsigned)col0);
#pragma unroll
                    for (int bj = 0; bj < 2; ++bj) { const f32x4 x1 = acc[ai][bj][m][0], x2 = acc[ai][bj][m][1]; const f32x4 o1 = x1 * cs - x2 * sn, o2 = x2 * cs + x1 * sn;
                        s1[bj] += o1; s2[bj] += o2;
                        u32x4 w; w.x = cvt_pk_bf16(o1[0], o1[1]); w.y = cvt_pk_bf16(o1[2], o1[3]); w.z = cvt_pk_bf16(o2[0], o2[1]); w.w = cvt_pk_bf16(o2[2], o2[3]);
                        *(u32x4*)(rowp + bj * HALF) = w; }
                    asm volatile("" : "+v"(s1[0]), "+v"(s1[1]), "+v"(s2[0]), "+v"(s2[1]) :: "memory"); }
            if (u.pn >= 8) {
#pragma unroll
                for (int bj = 0; bj < 2; ++bj)
#pragma unroll
                    for (int e = 0; e < 4; ++e) { float a = s1[bj][e], b = s2[bj][e];
#pragma unroll
                        for (int o = 1; o < 16; o <<= 1) { a += __shfl_xor(a, o); b += __shfl_xor(b, o); }
                        s1[bj][e] = a; s2[bj][e] = b; }
                if (fr == 0) { const int b = u.pm >> 3, blk = u.pm & 7;
#pragma unroll
                    for (int bj = 0; bj < 2; ++bj) { const int hd = (u.pn - 8) * 2 + bj; float* kp = KS + (size_t)(((b * 16 + hd) * 8 + blk) * 128 + wc * 32 + 8 * fq);
#pragma unroll
                        for (int e = 0; e < 4; ++e) { atomicAdd(kp + e, s1[bj][e]); atomicAdd(kp + 4 + e, s2[bj][e]); } } }
            }
        }
    }
};
}

typedef unsigned short bf16_t;
#define LAS __attribute__((address_space(3)))
#define LDS_WAIT() asm volatile("s_waitcnt lgkmcnt(0)" ::: "memory")
__device__ __forceinline__ float bf2f(bf16_t b) { return __uint_as_float(((unsigned)b) << 16); }
__device__ __forceinline__ unsigned f2bf(float f) { unsigned u = __float_as_uint(f); return (u + 0x7fffu + ((u >> 16) & 1u)) >> 16; }
__device__ __forceinline__ unsigned pk2(float lo, float hi) { return f2bf(lo) | (f2bf(hi) << 16); }
__device__ __forceinline__ float wave_sum(float v) {
#pragma unroll
    for (int o = 1; o < 64; o <<= 1) v += __shfl_xor(v, o);
    return v;
}
__device__ __forceinline__ float wave_max(float v) {
#pragma unroll
    for (int o = 1; o < 64; o <<= 1) v = fmaxf(v, __shfl_xor(v, o));
    return v;
}
__device__ __forceinline__ float sigmoidf_(float x) { return __builtin_amdgcn_rcpf(1.f + __expf(-x)); }
__device__ __forceinline__ float siluf_(float x) { return x * __builtin_amdgcn_rcpf(1.f + __expf(-x)); }

#define XB_TMO      128
#define XB_XCNT(j)  (256  + 64 * (j))
#define XB_XSUB(j)  (1280 + 64 * (j))
#define XB_XGEN(j)  (2304 + 64 * (j))
#define XB_TOP      3328
#define XB_TOPGEN   3392
#define XCD_BAR_WORDS 3456
#define XB_SPIN_CAP (1u << 18)

__device__ __forceinline__ unsigned xb_ld(unsigned* p)              { return __hip_atomic_load(p, __ATOMIC_RELAXED, __HIP_MEMORY_SCOPE_AGENT); }
__device__ __forceinline__ unsigned xb_add(unsigned* p, unsigned v) { return __hip_atomic_fetch_add(p, v, __ATOMIC_RELAXED, __HIP_MEMORY_SCOPE_AGENT); }
__device__ __forceinline__ unsigned xb_xcc_id() { return (unsigned)__builtin_amdgcn_s_getreg((3 << 11) | 20) & 0xFu; }
#define XB_SPIN(cond, bar) do { unsigned _sp = 0; while (cond) { __builtin_amdgcn_s_sleep(1); \
    if ((++_sp & 255u) == 0u) { if (xb_ld(&(bar)[XB_TMO])) break; if (_sp > XB_SPIN_CAP) { atomicAdd(&(bar)[XB_TMO], 1u); break; } } } } while (0)

struct XcdBarrier {
    unsigned* bar; unsigned x;
    volatile LAS unsigned* st;
};

__device__ __forceinline__ XcdBarrier xcd_barrier_post(unsigned* bar, volatile LAS unsigned* st) {
    XcdBarrier b; b.bar = bar; b.x = xb_xcc_id(); b.st = st;
    if (threadIdx.x == 0) (void)xb_add(&bar[XB_XCNT(b.x)], 1u);
    return b;
}
__device__ __forceinline__ void xcd_barrier_complete(unsigned* bar, unsigned x, unsigned& nloc, unsigned& nx) {
    const unsigned G = gridDim.x * gridDim.y * gridDim.z;
    unsigned sum, cnt, mine, sp = 0u;
    for (;;) {
        sum = 0u; cnt = 0u; mine = 0u;
#pragma unroll
        for (unsigned j = 0; j < 16; ++j) { const unsigned c = xb_ld(&bar[XB_XCNT(j)]); sum += c; cnt += (c > 0u) ? 1u : 0u; mine = (j == x) ? c : mine; }
        if (sum == G) break;
        __builtin_amdgcn_s_sleep(1);
        if ((++sp & 255u) == 0u) { if (xb_ld(&bar[XB_TMO])) break; if (sp > XB_SPIN_CAP) { atomicAdd(&bar[XB_TMO], 1u); break; } }
    }
    nloc = mine > 0u ? mine : 1u; nx = cnt > 0u ? cnt : 1u;
}

__device__ __forceinline__ void xcd_barrier(const XcdBarrier& b) {
    asm volatile("s_waitcnt vmcnt(0)" ::: "memory");
    __syncthreads();
    if (threadIdx.x == 0) {
        unsigned* bar = b.bar;
        __builtin_amdgcn_s_waitcnt(0);
        unsigned nloc = b.st[0], nx = b.st[1];
        if (nloc == 0u) { xcd_barrier_complete(bar, b.x, nloc, nx); b.st[0] = nloc; b.st[1] = nx; }
        const unsigned old = xb_add(&bar[XB_XSUB(b.x)], 1u);
        const unsigned gen = old / nloc;
        if (old + 1u == (gen + 1u) * nloc) {
            __builtin_amdgcn_fence(__ATOMIC_RELEASE, "agent");
            asm volatile("s_waitcnt vmcnt(0)" ::: "memory");
            const unsigned og = xb_add(&bar[XB_TOP], 1u);
            const unsigned tg = og / nx;
            if (og + 1u == (tg + 1u) * nx) xb_add(&bar[XB_TOPGEN], 1u);
            else XB_SPIN(xb_ld(&bar[XB_TOPGEN]) == tg, bar);
            __builtin_amdgcn_fence(__ATOMIC_ACQUIRE, "agent");
            xb_add(&bar[XB_XGEN(b.x)], 1u);
            asm volatile("s_waitcnt vmcnt(0)" ::: "memory");
        } else {
            XB_SPIN(xb_ld(&bar[XB_XGEN(b.x)]) == gen, bar);
            __builtin_amdgcn_fence(__ATOMIC_ACQUIRE, "agent");
            asm volatile("s_waitcnt vmcnt(0)" ::: "memory");
        }
    }
    __syncthreads();
}

namespace mb {
using bf16x8 = __attribute__((ext_vector_type(8))) short;
using s16x4  = __attribute__((ext_vector_type(4))) short;
using f32x16 = __attribute__((ext_vector_type(16))) float;
using u32x4  = __attribute__((ext_vector_type(4))) unsigned;
constexpr int   D = 128, NW = 8, QBLK = 32, KVBLK = 64, LD = 26624  , LDO = 2048  ;
constexpr float SCALE = 0.088388347648318440f, THR = 8.f, NEG = -1e30f;
constexpr int SHM_V = KVBLK * D * 2, SHM_K = KVBLK * D * 2, SHM_ATTN = 2 * SHM_V + 2 * SHM_K + NW * 64 * 4;
#define KSWZ(row, colB) ((row) * 256 + ((colB) ^ (((row) & 7) << 4)))
#define SBAR() __builtin_amdgcn_sched_barrier(0)
__device__ __forceinline__ int crow(int r, int hi) { return (r & 3) + 8 * (r >> 2) + 4 * hi; }
__device__ __forceinline__ unsigned cvtpk(float lo, float hi) { typedef __bf16 bf2_ __attribute__((ext_vector_type(2))); typedef float f2_ __attribute__((ext_vector_type(2))); const f2_ f = {lo, hi}; return __builtin_bit_cast(unsigned, __builtin_convertvector(f, bf2_)); }
__device__ __forceinline__ void partialSM(f32x16& p0, f32x16& p1, float& m_reg, float& mn, float& alpha) {
  constexpr float C = SCALE * 1.4426950408889634f;
  float pmax = p0[0]; for (int r = 1; r < 16; ++r) pmax = fmaxf(pmax, p0[r]); for (int r = 0; r < 16; ++r) pmax = fmaxf(pmax, p1[r]);
  { auto rr = __builtin_amdgcn_permlane32_swap(__float_as_uint(pmax), __float_as_uint(pmax), false, false);
    pmax = fmaxf(__uint_as_float(rr[0]), __uint_as_float(rr[1])); }
  if (__builtin_expect(__all(pmax - m_reg <= THR / SCALE), 1)) { mn = m_reg; alpha = 1.f; }
  else { mn = fmaxf(m_reg, pmax); alpha = __builtin_amdgcn_exp2f((m_reg - mn) * C); m_reg = mn; }
  float mnC = -mn * C;
  for (int r = 0; r < 16; ++r) p0[r] = fmaf(p0[r], C, mnC); for (int r = 0; r < 16; ++r) p1[r] = fmaf(p1[r], C, mnC);
  for (int r = 0; r < 16; ++r) p0[r] = __builtin_amdgcn_exp2f(p0[r]);
}
__device__ __forceinline__ void finishSM(f32x16& p0, f32x16& p1, float alpha, float& l_reg, bf16x8& pa0, bf16x8& pa1, bf16x8& pa2, bf16x8& pa3) {
  for (int r = 0; r < 16; ++r) p1[r] = __builtin_amdgcn_exp2f(p1[r]);
  float ps = 0; for (int r = 0; r < 16; ++r) ps += p0[r]; for (int r = 0; r < 16; ++r) ps += p1[r];
  { auto rr = __builtin_amdgcn_permlane32_swap(__float_as_uint(ps), __float_as_uint(ps), false, false);
    ps = __uint_as_float(rr[0]) + __uint_as_float(rr[1]); }
  l_reg = l_reg * alpha + ps;
#define PK4(P, BASE, OUT) do { unsigned a0 = cvtpk(P[BASE + 0], P[BASE + 1]), a1 = cvtpk(P[BASE + 2], P[BASE + 3]);   \
    unsigned b0 = cvtpk(P[BASE + 4], P[BASE + 5]), b1 = cvtpk(P[BASE + 6], P[BASE + 7]);                              \
    auto r0 = __builtin_amdgcn_permlane32_swap(a0, b0, false, false); auto r1 = __builtin_amdgcn_permlane32_swap(a1, b1, false, false); \
    u32x4 w = {r0[0], r1[0], r0[1], r1[1]}; OUT = *reinterpret_cast<bf16x8*>(&w); } while (0)
  PK4(p0, 0, pa0); PK4(p0, 8, pa1); PK4(p1, 0, pa2); PK4(p1, 8, pa3);
#undef PK4
}
__device__ __forceinline__ void qkt(f32x16& p0, f32x16& p1, const char* Ks, const bf16x8* qr, const int (&kb4)[4]) {
  p0 = f32x16{}; p1 = f32x16{};
#pragma unroll
  for (int d0 = 0; d0 < 8; ++d0) {
    bf16x8 b0 = *reinterpret_cast<const bf16x8*>(Ks + kb4[d0 & 3] + (d0 >> 2) * 128);
    bf16x8 b1 = *reinterpret_cast<const bf16x8*>(Ks + kb4[d0 & 3] + (d0 >> 2) * 128 + 32 * 256);
    p0 = __builtin_amdgcn_mfma_f32_32x32x16_bf16(b0, qr[d0], p0, 0, 0, 0);
    p1 = __builtin_amdgcn_mfma_f32_32x32x16_bf16(b1, qr[d0], p1, 0, 0, 0); }
}
__device__ __forceinline__ int v_st(int k, int c) { const int kk = (k & ~0xC) | ((k & 4) << 1) | ((k & 8) >> 1); return ((kk >> 3) * 4 + (c >> 5)) * 512 + ((kk & 7) * 32 + (c & 31)) * 2; }
__device__ __forceinline__ int v_rd_base(int lane) { return ((lane & 3) << 3) | (((lane >> 2) & 3) << 6) | (((lane >> 4) & 1) << 5) | (((lane >> 5) & 1) << 8); }
constexpr int v_rd_off(int d0, int ks, int half) { return d0 * 512 + ks * 4096 + half * 2048; }
template <int OFF> __device__ __forceinline__ s16x4 tr_read(int vb) {
  s16x4 r; asm volatile("ds_read_b64_tr_b16 %0, %1 offset:%2" : "=&v"(r) : "v"(vb), "i"(OFF) : "memory"); return r;
}
template <int D0> __device__ __forceinline__ void pv_one(f32x16& od, int vb, bf16x8 pa0, bf16x8 pa1, bf16x8 pa2, bf16x8 pa3) {
  const s16x4 l0 = tr_read<v_rd_off(D0, 0, 0)>(vb), h0 = tr_read<v_rd_off(D0, 0, 1)>(vb), l1 = tr_read<v_rd_off(D0, 1, 0)>(vb), h1 = tr_read<v_rd_off(D0, 1, 1)>(vb);
  const s16x4 l2 = tr_read<v_rd_off(D0, 2, 0)>(vb), h2 = tr_read<v_rd_off(D0, 2, 1)>(vb), l3 = tr_read<v_rd_off(D0, 3, 0)>(vb), h3 = tr_read<v_rd_off(D0, 3, 1)>(vb);
  asm volatile("s_waitcnt lgkmcnt(0)" ::: "memory"); SBAR();
#define PK(L, H) (bf16x8){L[0], L[1], L[2], L[3], H[0], H[1], H[2], H[3]}
  od = __builtin_amdgcn_mfma_f32_32x32x16_bf16(pa0, PK(l0, h0), od, 0, 0, 0);
  od = __builtin_amdgcn_mfma_f32_32x32x16_bf16(pa1, PK(l1, h1), od, 0, 0, 0);
  od = __builtin_amdgcn_mfma_f32_32x32x16_bf16(pa2, PK(l2, h2), od, 0, 0, 0);
  od = __builtin_amdgcn_mfma_f32_32x32x16_bf16(pa3, PK(l3, h3), od, 0, 0, 0);
#undef PK
}
__device__ __forceinline__ void pv_d0(f32x16* o, int vb, bf16x8 pa0, bf16x8 pa1, bf16x8 pa2, bf16x8 pa3) {
  pv_one<0>(o[0], vb, pa0, pa1, pa2, pa3); pv_one<1>(o[1], vb, pa0, pa1, pa2, pa3); pv_one<2>(o[2], vb, pa0, pa1, pa2, pa3); pv_one<3>(o[3], vb, pa0, pa1, pa2, pa3);
}
__device__ __forceinline__ int key0(int j, int qb) { return j < 4 ? qb * 256 + j * 64 : ((j - 4) >> 2) * 256 + ((j - 4) & 3) * 64; }
__device__ __forceinline__ void mask_tile(f32x16& p0, f32x16& p1, int j, unsigned selmask, int rowb, int hi) {
  int rb = rowb; asm volatile("" : "+v"(rb));
  const int lim = (j < 4) ? (rb - 64 * j) : (((selmask >> ((j - 4) >> 2)) & 1u) ? 4096 : -4096);
  if (__all(lim >= 63)) return;
  const int limh = lim - 4 * hi;
#pragma unroll
  for (int r = 0; r < 16; ++r) { const int cr = (r & 3) + 8 * (r >> 2); p0[r] = (cr > limh) ? NEG : p0[r]; p1[r] = (cr + 32 > limh) ? NEG : p1[r]; }
}
__device__ __forceinline__ void moba_unit(const unsigned short* __restrict__ Qb, const unsigned short* __restrict__ Kh, const unsigned short* __restrict__ Vh,
                                          unsigned short* __restrict__ Ob, const float* __restrict__ KS, int qb, char* lds) {
  int tid_ = threadIdx.x; asm volatile("" : "+v"(tid_));
  const int tid = tid_, wid = tid >> 6, lane = tid & 63, r32 = lane & 31, hi = lane >> 5;
  char* V_lds = lds; char* K_lds = lds + 2 * SHM_V;
  float* ws = (float*)(lds + 2 * SHM_V + 2 * SHM_K) + wid * 64; float* li_l = ws; float* al_l = ws + 32;
  float m_reg = NEG, l_reg = 0; f32x16 o[4] = {}; bf16x8 qr[8];
  const unsigned short* Qw = Qb + (long)(wid * QBLK + r32) * LD + hi * 8;
#pragma unroll
  for (int d0 = 0; d0 < 8; ++d0) qr[d0] = *reinterpret_cast<const bf16x8*>(Qw + d0 * 16);
  unsigned selmask = 0u;
  {
    float gate[8];
#pragma unroll
    for (int n = 0; n < 8; ++n) { float g = 0.f;
      if (n < qb) {
#pragma unroll
        for (int d0 = 0; d0 < 8; ++d0) { const float4 k0 = *(const float4*)(KS + n * 128 + d0 * 16 + hi * 8), k1 = *(const float4*)(KS + n * 128 + d0 * 16 + hi * 8 + 4);
          const u32x4 qw = *reinterpret_cast<const u32x4*>(&qr[d0]);
          g += __uint_as_float(qw[0] << 16) * k0.x + __uint_as_float(qw[0] & 0xffff0000u) * k0.y + __uint_as_float(qw[1] << 16) * k0.z + __uint_as_float(qw[1] & 0xffff0000u) * k0.w
             + __uint_as_float(qw[2] << 16) * k1.x + __uint_as_float(qw[2] & 0xffff0000u) * k1.y + __uint_as_float(qw[3] << 16) * k1.z + __uint_as_float(qw[3] & 0xffff0000u) * k1.w; }
        g += __shfl_xor(g, 32); }
      gate[n] = (n < qb) ? g : -INFINITY; }
#pragma unroll
    for (int r = 0; r < 3; ++r) { float best = -INFINITY; int bi = -1;
#pragma unroll
      for (int n = 0; n < 8; ++n) { const bool ok = !((selmask >> n) & 1u) && gate[n] > best; if (ok) { best = gate[n]; bi = n; } }
      if (bi >= 0) selmask |= 1u << bi; }
  }
  const int rowb = wid * QBLK + r32;
  int kb4[4];
#pragma unroll
  for (int q = 0; q < 4; ++q) kb4[q] = r32 * 256 + (((q << 5) | (hi << 4)) ^ ((r32 & 7) << 4));
  const int sr = tid >> 4, sc = (tid & 15) * 8, vst0 = v_st(sr, sc), vst1 = v_st(32 + sr, sc);
  const int vb0 = (int)(uintptr_t)V_lds + v_rd_base(lane);
  struct { bf16x8 vs0, vs1, ks0, ks1; } sr_[1];
  const unsigned voff = (unsigned)((sr * LD + sc) * 2);
#define SLOAD(i, k0) do { const char* vb_ = (const char*)Vh + (size_t)(k0) * (LD * 2); const char* kb_ = (const char*)Kh + (size_t)(k0) * (LD * 2); \
    sr_[i].vs0 = *reinterpret_cast<const bf16x8*>(vb_ + voff); sr_[i].vs1 = *reinterpret_cast<const bf16x8*>(vb_ + 32 * LD * 2 + voff); \
    sr_[i].ks0 = *reinterpret_cast<const bf16x8*>(kb_ + voff); sr_[i].ks1 = *reinterpret_cast<const bf16x8*>(kb_ + 32 * LD * 2 + voff); } while (0)
#define SWRITE(b, i) do { *(bf16x8*)(V_lds + (b) * SHM_V + vst0) = sr_[i].vs0;          \
    *(bf16x8*)(V_lds + (b) * SHM_V + vst1) = sr_[i].vs1; int kc = sc * 2;               \
    *(bf16x8*)(K_lds + (b) * SHM_K + KSWZ(sr, kc)) = sr_[i].ks0;                       \
    *(bf16x8*)(K_lds + (b) * SHM_K + KSWZ(32 + sr, kc)) = sr_[i].ks1; } while (0)
#define SWAIT() asm volatile("s_waitcnt vmcnt(0)" ::: "memory")
#define RESC(a) do { if (__any((a) < 1.f)) { if (hi == 0) al_l[r32] = (a); asm volatile("s_waitcnt lgkmcnt(0)" ::: "memory"); \
    for (int d = 0; d < 4; ++d) for (int r = 0; r < 16; ++r) o[d][r] *= al_l[crow(r, hi)]; } } while (0)
  f32x16 pA0, pA1, pB0, pB1; float mnA, mnB, alA, alB; bf16x8 pa0, pa1, pa2, pa3; const int NT = 4 * (qb + 1);
  constexpr int SE = 0, SO = 0;
  SLOAD(SE, key0(0, qb)); asm volatile("s_waitcnt vmcnt(0)" ::: "memory"); SWRITE(0, SE); __syncthreads();
  qkt(pA0, pA1, K_lds, qr, kb4); mask_tile(pA0, pA1, 0, selmask, rowb, hi); partialSM(pA0, pA1, m_reg, mnA, alA);
  SLOAD(SO, key0(1, qb));
  SWAIT(); SWRITE(1, SO); __syncthreads();
  for (int j = 1; j + 1 < NT; j += 2) {
    SBAR(); qkt(pB0, pB1, K_lds + SHM_K, qr, kb4);
    finishSM(pA0, pA1, alA, l_reg, pa0, pa1, pa2, pa3); SBAR();
    SLOAD(SO, key0(j + 1, qb)); SBAR();
    pv_d0(o, vb0, pa0, pa1, pa2, pa3); mask_tile(pB0, pB1, j, selmask, rowb, hi); partialSM(pB0, pB1, m_reg, mnB, alB);
    __syncthreads(); SWAIT(); SWRITE(0, SE);
    RESC(alB); __syncthreads();
    SBAR(); qkt(pA0, pA1, K_lds, qr, kb4);
    finishSM(pB0, pB1, alB, l_reg, pa0, pa1, pa2, pa3); SBAR();
    SLOAD(SE, key0(j + 2, qb)); SBAR();
    pv_d0(o, vb0 + (int)SHM_V, pa0, pa1, pa2, pa3); mask_tile(pA0, pA1, j + 1, selmask, rowb, hi); partialSM(pA0, pA1, m_reg, mnA, alA);
    __syncthreads(); SWAIT(); SWRITE(1, SO);
    RESC(alA); __syncthreads();
  }
  SBAR(); qkt(pB0, pB1, K_lds + SHM_K, qr, kb4);
  finishSM(pA0, pA1, alA, l_reg, pa0, pa1, pa2, pa3); SBAR();
  pv_d0(o, vb0, pa0, pa1, pa2, pa3); mask_tile(pB0, pB1, NT - 1, selmask, rowb, hi); partialSM(pB0, pB1, m_reg, mnB, alB);
  __syncthreads(); RESC(alB);
  finishSM(pB0, pB1, alB, l_reg, pa0, pa1, pa2, pa3); SBAR();
  pv_d0(o, vb0 + (int)SHM_V, pa0, pa1, pa2, pa3);
  if (hi == 0) li_l[r32] = l_reg; asm volatile("s_waitcnt lgkmcnt(0)" ::: "memory");
  float rli[16];
#pragma unroll
  for (int r = 0; r < 16; ++r) rli[r] = __builtin_amdgcn_rcpf(li_l[crow(r, hi)]);
  unsigned ooff = (unsigned)((wid * QBLK + 4 * hi) * LDO + r32); asm volatile("" : "+v"(ooff));
#pragma unroll
  for (int r = 0; r < 16; ++r) { const int cr = (r & 3) + 8 * (r >> 2);
#pragma unroll
    for (int d0 = 0; d0 < 4; ++d0) { const float v = o[d0][r] * rli[r]; unsigned u = __float_as_uint(v); u = (u + 0x7fffu + ((u >> 16) & 1u)) >> 16; Ob[ooff + (unsigned)(cr * LDO + d0 * 32)] = (unsigned short)u; } }
  asm volatile("s_waitcnt lgkmcnt(0)" ::: "memory"); __syncthreads();
#undef SLOAD
#undef SWRITE
#undef SWAIT
#undef RESC
}
#undef KSWZ
#undef SBAR
}

namespace gf {
typedef short bf16x8 __attribute__((ext_vector_type(8)));
typedef short s16x4 __attribute__((ext_vector_type(4)));
typedef float f32x4 __attribute__((ext_vector_type(4)));
typedef unsigned u32x2 __attribute__((ext_vector_type(2)));
typedef unsigned u32x4 __attribute__((ext_vector_type(4)));
#define GF_LAS __attribute__((address_space(3)))
constexpr int PK = 528, PV = 272, PJ = 144;
constexpr int L_QD = 0, L_KI = 64 * PK, L_VV = 2 * 64 * PK, L_PP = L_VV + 64 * PV, L_DEC = L_PP + 64 * PJ, L_END = L_DEC + 1024;
constexpr int L_SSX = 131072 + 1024, PSX = 144, L_RS = L_SSX + 64 * 144;
static_assert(L_END <= 131072 && L_RS + 256 <= 147456, "fused GLA LDS map");
constexpr float GF_EPS = 1e-6f;
constexpr unsigned GF_SPIN_CAP = 1u << 16;
__device__ __forceinline__ unsigned cvtpk(float lo, float hi) { typedef __bf16 bf2_ __attribute__((ext_vector_type(2))); typedef float f2_ __attribute__((ext_vector_type(2))); const f2_ f = {lo, hi}; return __builtin_bit_cast(unsigned, __builtin_convertvector(f, bf2_)); }
__device__ __forceinline__ s16x4 trrd(int addr) { s16x4 r; asm volatile("ds_read_b64_tr_b16 %0, %1" : "=&v"(r) : "v"(addr) : "memory"); return r; }
template <int OFF> __device__ __forceinline__ s16x4 trrdo(int addr) { static_assert(OFF >= 0 && OFF < 65536, "ds offset"); s16x4 r; asm volatile("ds_read_b64_tr_b16 %0, %1 offset:%2" : "=&v"(r) : "v"(addr), "n"(OFF) : "memory"); return r; }
#define GF_FRAG(base, row, pitch, kbyte) (*(const GF_LAS bf16x8*)((base) + (row) * (pitch) + (kbyte)))

__device__ __forceinline__ void fused_unit(const unsigned short* __restrict__ Qd, const unsigned short* __restrict__ Ki, const unsigned short* __restrict__ V, int ldv,
                                           const unsigned short* __restrict__ SGR, int ldsgr, const float* __restrict__ DEC, const float* __restrict__ gn, unsigned short* __restrict__ Out, int ldo,
                                           float* SSQh, int dvs, GF_LAS unsigned char* lds) {
    int tid = threadIdx.x; asm volatile("" : "+v"(tid));
    const int w = __builtin_amdgcn_readfirstlane(tid >> 6); int lane = tid & 63, l15 = lane & 15, g = lane >> 4;
    const int ldsb = (int)(unsigned)(size_t)lds;
    int tr_r = 8 * g + (l15 >> 2), tr_c = 8 * (l15 & 3);
    f32x4 S[16];
#pragma unroll
    for (int tt = 0; tt < 16; ++tt) S[tt] = (f32x4){0.f, 0.f, 0.f, 0.f};
    const f32x4 g4 = *(const f32x4*)(gn + 16 * w + 4 * g);
    u32x4 rq[4], rk[4], rv[2]; float rd = 0.f;
    unsigned vq = (unsigned)(((tid >> 5) * 2048 + 8 * (tid & 31)) * 2), vv = (unsigned)(((tid >> 4) * ldv + 8 * (tid & 15)) * 2), vs = (unsigned)((l15 * ldsgr + 4 * g) * 2), vo = (unsigned)((l15 * ldo + 4 * g) * 2);
    int lq = (tid >> 5) * PK + 16 * (tid & 31), lv = (tid >> 4) * PV + 16 * (tid & 15);
#define GF_LOAD_Q(c) do { _Pragma("unroll") for (int q = 0; q < 4; ++q) rq[q] = *(const u32x4*)((const char*)Qd + (size_t)((c) * 64 + 16 * q) * 4096 + vq); } while (0)
#define GF_LOAD_K(c) do { _Pragma("unroll") for (int q = 0; q < 4; ++q) rk[q] = *(const u32x4*)((const char*)Ki + (size_t)((c) * 64 + 16 * q) * 4096 + vq); } while (0)
#define GF_LOAD_V(c) do { _Pragma("unroll") for (int q = 0; q < 2; ++q) rv[q] = *(const u32x4*)((const char*)V + (size_t)((c) * 64 + 32 * q) * (size_t)(2 * ldv) + vv); \
        if (tid < 256) rd = *(const float*)((const char*)DEC + (size_t)((c) > 0 ? (c) - 1 : 0) * 8192 + 4u * (unsigned)tid); } while (0)
#define GF_LOAD(c) do { GF_LOAD_Q(c); GF_LOAD_K(c); GF_LOAD_V(c); } while (0)
    u32x2 ovp[4], ovq[4]; float ssp = 0.f, ssq = 0.f, pv = 0.f; unsigned pfa = 0u, pfb = 0u;
#pragma unroll
    for (int it = 0; it < 4; ++it) { ovp[it] = (u32x2){0u, 0u}; ovq[it] = (u32x2){0u, 0u}; }
#define GF_RSTD(CH_) do { const int sl_ = (lane >> 3) & 3, tk_ = 8 * w + (lane & 7); const float* sp_ = SSQh + (size_t)(CH_) * 256 + 64 * sl_ + tk_; float p_ = (sl_ == dvs) ? ssq : pv; \
        for (unsigned n_ = 0; n_ < GF_SPIN_CAP && !(p_ >= 0.f); ++n_) { __builtin_amdgcn_s_sleep(1); p_ = __hip_atomic_load(sp_, __ATOMIC_RELAXED, __HIP_MEMORY_SCOPE_AGENT); } \
        p_ = p_ + __shfl_xor(p_, 8); p_ = p_ + __shfl_xor(p_, 16); \
        if ((lane >> 3) == 0) *(GF_LAS float*)(lds + L_RS + 4 * tk_) = rsqrtf(p_ * (1.f / 512.f) + GF_EPS); } while (0)
#define GF_PUBLISH(CH_) do { if ((lane >> 3) == 0) __hip_atomic_store(SSQh + (size_t)(CH_) * 256 + 64 * dvs + 8 * w + (lane & 7), ssp, __ATOMIC_RELAXED, __HIP_MEMORY_SCOPE_AGENT); } while (0)
#define GF_PEEK(CH_) do { pv = __hip_atomic_load(SSQh + (size_t)(CH_) * 256 + 64 * ((lane >> 3) & 3) + 8 * w + (lane & 7), __ATOMIC_RELAXED, __HIP_MEMORY_SCOPE_AGENT); } while (0)
#define GF_FINAL(CH_) do { _Pragma("unroll") for (int it = 0; it < 4; ++it) { const float rs_ = *(const GF_LAS float*)(lds + L_RS + 4 * (16 * it + l15)); u32x2 o_; \
            o_.x = cvtpk(__uint_as_float(ovq[it].x << 16) * rs_, __uint_as_float(ovq[it].x & 0xffff0000u) * rs_); o_.y = cvtpk(__uint_as_float(ovq[it].y << 16) * rs_, __uint_as_float(ovq[it].y & 0xffff0000u) * rs_); \
            *(u32x2*)((char*)Out + ((size_t)((CH_) * 64 + 16 * it) * ldo + 16 * w) * 2 + vo) = o_; } } while (0)
    GF_LOAD(0);
    for (int c = 0; c < 32; ++c) {
        { int t_ = threadIdx.x; asm volatile("" : "+v"(t_)); tid = t_; lane = t_ & 63; l15 = lane & 15; g = lane >> 4; tr_r = 8 * g + (l15 >> 2); tr_c = 8 * (l15 & 3);
          vq = (unsigned)(((tid >> 5) * 2048 + 8 * (tid & 31)) * 2); vv = (unsigned)(((tid >> 4) * ldv + 8 * (tid & 15)) * 2); vs = (unsigned)((l15 * ldsgr + 4 * g) * 2); vo = (unsigned)((l15 * ldo + 4 * g) * 2);
          lq = (tid >> 5) * PK + 16 * (tid & 31); lv = (tid >> 4) * PV + 16 * (tid & 15); }
        asm volatile("" :: "v"(pfa), "v"(pfb));
#pragma unroll
        for (int q = 0; q < 4; ++q) { *(GF_LAS u32x4*)(lds + L_QD + 16 * q * PK + lq) = rq[q]; *(GF_LAS u32x4*)(lds + L_KI + 16 * q * PK + lq) = rk[q]; }
#pragma unroll
        for (int q = 0; q < 2; ++q) *(GF_LAS u32x4*)(lds + L_VV + 32 * q * PV + lv) = rv[q];
        if (tid < 256) *(GF_LAS float*)(lds + L_DEC + 4 * tid) = rd;
        if (c > 0) GF_PUBLISH(c - 1);
        if (c > 1) GF_RSTD(c - 2);
        u32x2 sg[4];
#pragma unroll
        for (int it = 0; it < 4; ++it) sg[it] = *(const u32x2*)((const char*)SGR + ((size_t)(c * 64 + 16 * it) * ldsgr + 16 * w) * 2 + vs);
        if (c + 1 < 32) GF_LOAD_Q(c + 1);
        asm volatile("s_waitcnt lgkmcnt(0)" ::: "memory"); __syncthreads();
        if (c > 1) GF_FINAL(c - 2);
#pragma unroll
        for (int it = 0; it < 4; ++it) ovq[it] = ovp[it];
        ssq = ssp;
        { const int it = w >> 1; f32x4 pa[2] = {(f32x4){0.f, 0.f, 0.f, 0.f}, (f32x4){0.f, 0.f, 0.f, 0.f}};
          bf16x8 pq[8], pk[8][2];
#define GF_LP(k_) do { pq[k_] = GF_FRAG(lds + L_QD, 16 * it + l15, PK, 64 * (k_) + 16 * g); pk[k_][0] = GF_FRAG(lds + L_KI, 16 * (2 * (w & 1)) + l15, PK, 64 * (k_) + 16 * g); \
              pk[k_][1] = GF_FRAG(lds + L_KI, 16 * (2 * (w & 1) + 1) + l15, PK, 64 * (k_) + 16 * g); } while (0)
          GF_LP(0); GF_LP(1);
#pragma unroll
          for (int ks = 0; ks < 8; ++ks) {
              if (ks + 2 < 8) GF_LP(ks + 2);
              __builtin_amdgcn_sched_barrier(0);
#pragma unroll
              for (int jj = 0; jj < 2; ++jj) pa[jj] = __builtin_amdgcn_mfma_f32_16x16x32_bf16(pk[ks][jj], pq[ks], pa[jj], 0, 0, 0);
              __builtin_amdgcn_sched_barrier(0); }
#undef GF_LP
#pragma unroll
          for (int jj = 0; jj < 2; ++jj) { const int i = 16 * it + l15, j0 = 16 * (2 * (w & 1) + jj) + 4 * g; f32x4 v = pa[jj];
#pragma unroll
              for (int r = 0; r < 4; ++r) v[r] = (j0 + r <= i) ? v[r] : 0.f;
              u32x2 o; o.x = cvtpk(v[0], v[1]); o.y = cvtpk(v[2], v[3]); *(GF_LAS u32x2*)(lds + L_PP + i * PJ + 2 * j0) = o; } }
        if (c + 1 < 32) GF_LOAD_K(c + 1);
        asm volatile("s_waitcnt lgkmcnt(0)" ::: "memory"); __syncthreads();
        bf16x8 vf[2];
        { const int a0 = ldsb + L_VV + tr_r * PV + 2 * (16 * w) + tr_c;
          const s16x4 x0 = trrd(a0), x1 = trrd(a0 + 4 * PV), x2 = trrd(a0 + 32 * PV), x3 = trrd(a0 + 36 * PV);
          asm volatile("s_waitcnt lgkmcnt(0)" ::: "memory"); __builtin_amdgcn_sched_barrier(0);
          vf[0] = (bf16x8){x0[0], x0[1], x0[2], x0[3], x1[0], x1[1], x1[2], x1[3]}; vf[1] = (bf16x8){x2[0], x2[1], x2[2], x2[3], x3[0], x3[1], x3[2], x3[3]}; }
        f32x4 oa[4];
#pragma unroll
        for (int it = 0; it < 4; ++it) oa[it] = (f32x4){0.f, 0.f, 0.f, 0.f};
#pragma unroll
        for (int ks = 0; ks < 2; ++ks)
#pragma unroll
            for (int it = 0; it < 4; ++it) { const bf16x8 pf = GF_FRAG(lds + L_PP, 16 * it + l15, PJ, 64 * ks + 16 * g); oa[it] = __builtin_amdgcn_mfma_f32_16x16x32_bf16(vf[ks], pf, oa[it], 0, 0, 0); }
        if (c + 1 < 32) GF_LOAD_V(c + 1);
        {
          const int c2 = c + 2 < 32 ? c + 2 : 31, la = tid & 255, lb = tid & 127;
          const char* pa_ = (const char*)(tid < 256 ? Qd : Ki) + ((size_t)(c2 * 64 + (la >> 2)) * 2048 + (la & 3) * 64) * 2;
          const bool bv_ = (tid & 255) < 128; const char* pb_ = (const char*)(bv_ ? V : SGR) + ((size_t)(c2 * 64 + (lb >> 1)) * (size_t)(bv_ ? ldv : ldsgr) + (lb & 1) * 64) * 2;
          pfa = *(const unsigned*)pa_; pfb = *(const unsigned*)pb_; }
        { const int cp = c > 0 ? c - 1 : 0; GF_PEEK(cp); }
        if (c > 0) {
            u32x4 qf[8][4];
            f32x4 dq[8][2];
#define GF_LQ(s_) do { _Pragma("unroll") for (int it = 0; it < 4; ++it) { const GF_LAS unsigned char* qp = lds + L_QD + (16 * it + l15) * PK + 2 * (32 * (s_) + 4 * g); \
                const u32x2 q0 = *(const GF_LAS u32x2*)qp, q1 = *(const GF_LAS u32x2*)(qp + 32); qf[s_][it] = (u32x4){q0.x, q0.y, q1.x, q1.y}; } \
                dq[s_][0] = *(const GF_LAS f32x4*)(lds + L_DEC + 4 * (16 * (2 * (s_)) + 4 * g)); dq[s_][1] = *(const GF_LAS f32x4*)(lds + L_DEC + 4 * (16 * (2 * (s_) + 1) + 4 * g)); } while (0)
            GF_LQ(0); GF_LQ(1);
#pragma unroll
            for (int s = 0; s < 8; ++s) {
                if (s + 2 < 8) GF_LQ(s + 2);
                __builtin_amdgcn_sched_barrier(0);
                { float z_ = 0.f; asm volatile("" : "+v"(z_));
                  _Pragma("unroll") for (int h = 0; h < 2; ++h) { f32x4 t = S[2 * s + h]; const f32x4 d = dq[s][h]; t[0] = t[0] * d[0]; t[1] = __builtin_fmaf(t[1], d[1], z_); t[2] = t[2] * d[2]; t[3] = __builtin_fmaf(t[3], d[3], z_); S[2 * s + h] = t; } }
                u32x4 sw; sw.x = cvtpk(S[2 * s][0], S[2 * s][1]); sw.y = cvtpk(S[2 * s][2], S[2 * s][3]); sw.z = cvtpk(S[2 * s + 1][0], S[2 * s + 1][1]); sw.w = cvtpk(S[2 * s + 1][2], S[2 * s + 1][3]);
                const bf16x8 sf = __builtin_bit_cast(bf16x8, sw);
#pragma unroll
                for (int it = 0; it < 4; ++it) oa[it] = __builtin_amdgcn_mfma_f32_16x16x32_bf16(sf, __builtin_bit_cast(bf16x8, qf[s][it]), oa[it], 0, 0, 0);
                __builtin_amdgcn_sched_barrier(0); }
#undef GF_LQ
        }
#define GF_TR4(T4_, U_) x[U_][0] = trrdo<2 * 16 * (4 * T4_ + U_)>(a0); x[U_][1] = trrdo<2 * 16 * (4 * T4_ + U_) + 4 * PK>(a0); x[U_][2] = trrdo<2 * 16 * (4 * T4_ + U_) + 32 * PK>(a0); x[U_][3] = trrdo<2 * 16 * (4 * T4_ + U_) + 36 * PK>(a0);
#define GF_SUPD(T4_) { s16x4 x[4][4]; const int a0 = ldsb + L_KI + tr_r * PK + tr_c;         \
            GF_TR4(T4_, 0) GF_TR4(T4_, 1) GF_TR4(T4_, 2) GF_TR4(T4_, 3) \
            asm volatile("s_waitcnt lgkmcnt(0)" ::: "memory"); __builtin_amdgcn_sched_barrier(0); \
            _Pragma("unroll") for (int u = 0; u < 4; ++u) { const int tt = 4 * T4_ + u; \
                const bf16x8 k0 = (bf16x8){x[u][0][0], x[u][0][1], x[u][0][2], x[u][0][3], x[u][1][0], x[u][1][1], x[u][1][2], x[u][1][3]}, k1 = (bf16x8){x[u][2][0], x[u][2][1], x[u][2][2], x[u][2][3], x[u][3][0], x[u][3][1], x[u][3][2], x[u][3][3]}; \
                f32x4 a = S[tt]; a = __builtin_amdgcn_mfma_f32_16x16x32_bf16(k0, vf[0], a, 0, 0, 0); a = __builtin_amdgcn_mfma_f32_16x16x32_bf16(k1, vf[1], a, 0, 0, 0); S[tt] = a; } }
        GF_SUPD(0) GF_SUPD(1) GF_SUPD(2) GF_SUPD(3)
#undef GF_SUPD
#undef GF_TR4
#pragma unroll
        for (int it = 0; it < 4; ++it) { const f32x4 o = oa[it]; float sq = (o[0] * o[0] + o[1] * o[1]) + (o[2] * o[2] + o[3] * o[3]);
            *(GF_LAS float*)(lds + L_SSX + (16 * it + l15) * PSX + (4 * w + g) * 4) = sq;
            float m0 = __uint_as_float(sg[it].x << 16), m1 = __uint_as_float(sg[it].x & 0xffff0000u), m2 = __uint_as_float(sg[it].y << 16), m3 = __uint_as_float(sg[it].y & 0xffff0000u);
            m0 = m0 * __builtin_amdgcn_rcpf(1.f + __expf(-m0)); m1 = m1 * __builtin_amdgcn_rcpf(1.f + __expf(-m1)); m2 = m2 * __builtin_amdgcn_rcpf(1.f + __expf(-m2)); m3 = m3 * __builtin_amdgcn_rcpf(1.f + __expf(-m3));
            u32x2 ov; ov.x = cvtpk(o[0] * g4[0] * m0, o[1] * g4[1] * m1); ov.y = cvtpk(o[2] * g4[2] * m2, o[3] * g4[3] * m3);
            ovp[it] = ov; }
        asm volatile("s_waitcnt lgkmcnt(0)" ::: "memory"); __syncthreads();
        { float ws[8];
#pragma unroll
            for (int k = 0; k < 8; ++k) { const f32x4 a = *(const GF_LAS f32x4*)(lds + L_SSX + (8 * w + (lane & 7)) * PSX + 16 * k); ws[k] = (a[0] + a[1]) + (a[2] + a[3]); }
            ssp = ((ws[0] + ws[1]) + (ws[2] + ws[3])) + ((ws[4] + ws[5]) + (ws[6] + ws[7])); }
    }
    GF_PUBLISH(31); GF_RSTD(30);
    asm volatile("s_waitcnt lgkmcnt(0)" ::: "memory"); __syncthreads();
    GF_FINAL(30);
#pragma unroll
    for (int it = 0; it < 4; ++it) ovq[it] = ovp[it];
    ssq = ssp; pv = -1.f;
    __syncthreads();
    GF_RSTD(31);
    asm volatile("s_waitcnt lgkmcnt(0)" ::: "memory"); __syncthreads();
    GF_FINAL(31);
    __syncthreads();
#undef GF_RSTD
#undef GF_PUBLISH
#undef GF_PEEK
#undef GF_FINAL
#undef GF_LOAD
#undef GF_LOAD_Q
#undef GF_LOAD_K
#undef GF_LOAD_V
}
#undef GF_FRAG
}

constexpr int D_MODEL = 4096, BATCH = 4, SEQ = 2048, MTOK = BATCH * SEQ;
constexpr int IN_COLS = 26640, IN_PAD = 26624;
constexpr int OFF_MQ = 0, OFF_MK = 2048, OFF_MV = 4096, OFF_GQ = 6144, OFF_GK = 8192, OFF_GV = 10240, OFF_GR = 14336, OFF_SM = 18432, OFF_SG = 22528, GA_SRC = 18432  , GA_ROW = 26624  ;
constexpr int D_FF = 11008;
constexpr float EPS = 1e-6f;
constexpr int NWAVES = 8, NTHR = 512;
constexpr int WD_SPLIT = 256;
constexpr int LDS_BYTES = 147456, MISC_OFF = 131072;

struct Params {
    const float* in[15]; float* out; unsigned char* ws; unsigned* ctl;
    int ph_lo, ph_hi;
};
struct Ctx { int tid, lane, wave, G, bid; LAS unsigned char* lds; };

template <int MODE, int KG = 8> __device__ __forceinline__ void conv_items(const Ctx& c, const float* __restrict__ W, int K, int N, bf16_t* __restrict__ Bt, int row_off, int u_begin = 0, int u_end = 0x7fffffff) {
    LAS unsigned* scr = (LAS unsigned*)(c.lds + c.wave * 8448);
    typedef float f4v_ __attribute__((ext_vector_type(4)));
    const int lane = c.lane, cq = lane & 15, r = lane >> 4; constexpr int NG = 8 / KG; const int nblk = (N + 63) / 64, nbg = (nblk + NG - 1) / NG, nunits_all = nbg * (K / (64 * KG)), nunits = nunits_all < u_end ? nunits_all : u_end;
#define CV_COORD(U_) const int kb_ = ((U_) / nbg) * KG + (c.wave % KG), nb_ = ((U_) % nbg) * NG + (c.wave / KG); const int k0 = kb_ * 64, n0 = nb_ * 64; const bool live = ((U_) < nunits) && (nb_ < nblk); const bool ok = (n0 + 4 * cq) < N;
  \

#define CV_LOAD(v_, U_) do { const int Uc_ = ((U_) < nunits) ? (U_) : nunits - 1; int kb_ = (Uc_ / nbg) * KG + (c.wave % KG), nb_ = (Uc_ % nbg) * NG + (c.wave / KG); nb_ = nb_ < nblk ? nb_ : nblk - 1; \
        const int k0 = kb_ * 64, n0 = nb_ * 64; const bool ok = (n0 + 4 * cq) < N; const int nc_ = ok ? (n0 + 4 * cq) : (N - 4); \
        _Pragma("unroll") for (int i = 0; i < 16; ++i) { const int kk = 8 * (i >> 1) + 2 * r + (i & 1); f4v_ t_ = __builtin_nontemporal_load((const f4v_*)(W + (size_t)(k0 + kk) * N + nc_)); \
            if (!ok) t_ = (f4v_){0.f, 0.f, 0.f, 0.f}; v_[i] = t_; } } while (0)
#define CV_PROC(v_, U_) do { CV_COORD(U_) (void)ok; if (live) { \
        _Pragma("unroll") for (int m = 0; m < 8; ++m) { const int kp = 4 * m + r;         \
            scr[(4 * cq + 0) * 33 + kp] = pk2(v_[2 * m][0], v_[2 * m + 1][0]); scr[(4 * cq + 1) * 33 + kp] = pk2(v_[2 * m][1], v_[2 * m + 1][1]); \
            scr[(4 * cq + 2) * 33 + kp] = pk2(v_[2 * m][2], v_[2 * m + 1][2]); scr[(4 * cq + 3) * 33 + kp] = pk2(v_[2 * m][3], v_[2 * m + 1][3]); } \
        LDS_WAIT(); asm volatile("" ::: "memory"); \
        _Pragma("unroll") for (int ps = 0; ps < 4; ++ps) { const int nn = (lane >> 2) + 16 * ps, q = lane & 3; const LAS unsigned* sp = scr + nn * 33 + 8 * q; \
            uint4 o0, o1; o0.x = sp[0]; o0.y = sp[1]; o0.z = sp[2]; o0.w = sp[3]; o1.x = sp[4]; o1.y = sp[5]; o1.z = sp[6]; o1.w = sp[7]; \
            const int n = n0 + nn; const int drow = (MODE == 0) ? (row_off + n) : (MODE == 1) ? ((n >> 7) * 256 + (n & 127) + row_off) : ((n < 4096) ? ((n & ~127) + 8 * ((n & 63) >> 2) + 4 * ((n >> 6) & 1) + (n & 3)) : (n < GA_SRC) ? n : (n < GA_SRC + 16) ? (GA_ROW + n - GA_SRC) : (n - 16)) + row_off; \
            if (n < N) { uint4* dp = (uint4*)(Bt + (size_t)drow * K + k0 + 16 * q); dp[0] = o0; dp[1] = o1; } } \
        LDS_WAIT(); asm volatile("" ::: "memory"); } } while (0)
    f4v_ va[16], vb[16];
    CV_LOAD(va, u_begin + c.bid);
    for (int U = u_begin + c.bid; U < nunits; U += 2 * c.G) {
        CV_LOAD(vb, U + c.G);
        CV_PROC(va, U);
        CV_LOAD(va, U + 2 * c.G);
        CV_PROC(vb, U + c.G);
    }
#undef CV_COORD
#undef CV_LOAD
#undef CV_PROC
}
__device__ __forceinline__ void rmsnorm_rows_bf16(const Ctx& c, const float* __restrict__ x, const float* __restrict__ g, bf16_t* __restrict__ out) {
    typedef float f4v_ __attribute__((ext_vector_type(4)));
    const int lane = c.lane, stride = c.G * NWAVES; const float4* gr = (const float4*)g + lane;
#define RN_LOAD(v_, row_) do { if ((row_) < MTOK) { const f4v_* xr = (const f4v_*)(x + (size_t)(row_) * D_MODEL) + lane; _Pragma("unroll") for (int j = 0; j < 16; ++j) v_[j] = xr[64 * j]; } } while (0)
#define RN_PROC(v_, row_) do { if ((row_) < MTOK) { float s = 0.f; \
        _Pragma("unroll") for (int j = 0; j < 16; ++j) s += v_[j][0] * v_[j][0] + v_[j][1] * v_[j][1] + v_[j][2] * v_[j][2] + v_[j][3] * v_[j][3]; \
        const float rstd = rsqrtf(wave_sum(s) * (1.f / D_MODEL) + EPS); uint2* o = (uint2*)(out + (size_t)(row_) * D_MODEL) + lane; \
        _Pragma("unroll") for (int j = 0; j < 16; ++j) { const float4 gg = gr[64 * j]; uint2 w; w.x = pk2(v_[j][0] * rstd * gg.x, v_[j][1] * rstd * gg.y); w.y = pk2(v_[j][2] * rstd * gg.z, v_[j][3] * rstd * gg.w); o[64 * j] = w; \
            if ((j & 3) == 3) asm volatile("" ::: "memory"); } } } while (0)
    f4v_ va[16], vb[16];
    const int row0 = c.bid * NWAVES + c.wave; RN_LOAD(va, row0);
    for (int row = row0; row < MTOK; row += 2 * stride) { RN_LOAD(vb, row + stride); RN_PROC(va, row); RN_LOAD(va, row + 2 * stride); RN_PROC(vb, row + stride); }
#undef RN_LOAD
#undef RN_PROC
}
__device__ __forceinline__ void rope_table_phase(const Ctx& c, float* __restrict__ CS, float* __restrict__ SN) {
    for (int i = c.bid * NTHR + c.tid; i < SEQ * 64; i += c.G * NTHR) { const int j = i & 63, pos = i >> 6;
        const float inv_freq = powf(10000.f, -(float)j / 64.f); const float ang = (float)pos * inv_freq; CS[i] = cosf(ang); SN[i] = sinf(ang); }
}
__device__ __forceinline__ void gla_prep_phase(const Ctx& c, const bf16_t* __restrict__ u, const bf16_t* __restrict__ hrows, const bf16_t* __restrict__ wga, const float* __restrict__ up, const float* __restrict__ bias, float* __restrict__ DEC,
                                               bf16_t* __restrict__ Qd, bf16_t* __restrict__ Ki) {
    LAS float* ga = (LAS float*)c.lds; LAS float* gap = ga + 1024;
    for (int item = c.bid; item < (MTOK / 64) * 2; item += c.G) { const int ci = item >> 1, col = (item & 1) * 1024 + 2 * c.tid;
        __syncthreads();
        unsigned qc[16], kc[16], qn[16], kn[16];
#define PREP_LOAD(q_, k_, tb_) do { _Pragma("unroll") for (int i = 0; i < 16; ++i) { const size_t row_ = (size_t)ci * 64 + (tb_) + i; q_[i] = *(const unsigned*)(u + row_ * IN_PAD + OFF_GQ + col); k_[i] = *(const unsigned*)(u + row_ * IN_PAD + OFF_GK + col); } } while (0)
        PREP_LOAD(qc, kc, 0);
        {
            const int mt = c.wave & 3, kh = c.wave >> 2, l15 = c.lane & 15, lq = c.lane >> 4; pg8::f32x4 a4 = {0.f, 0.f, 0.f, 0.f};
            const bf16_t* hp = hrows + (size_t)(ci * 64 + 16 * mt + l15) * 4096 + 2048 * kh + 8 * lq; const bf16_t* wp = wga + (size_t)l15 * 4096 + 2048 * kh + 8 * lq;
#pragma unroll 16
            for (int ks = 0; ks < 64; ++ks) { const pg8::bf16x8 hf = *(const pg8::bf16x8*)(hp + 32 * ks), wf = *(const pg8::bf16x8*)(wp + 32 * ks); a4 = __builtin_amdgcn_mfma_f32_16x16x32_bf16(hf, wf, a4, 0, 0, 0); }
#pragma unroll
            for (int r = 0; r < 4; ++r) gap[kh * 1024 + (16 * mt + 4 * lq + r) * 16 + l15] = a4[r];
            asm volatile("s_waitcnt lgkmcnt(0)" ::: "memory"); __syncthreads();
            ga[c.tid] = gap[c.tid] + gap[1024 + c.tid]; ga[512 + c.tid] = gap[512 + c.tid] + gap[1536 + c.tid]; }
        float up0[16], up1[16];
#pragma unroll
        for (int r = 0; r < 16; ++r) { const float2 v = *(const float2*)(up + r * 2048 + col); up0[r] = v.x; up1[r] = v.y; }
        const float2 bs = *(const float2*)(bias + col);
        asm volatile("s_waitcnt lgkmcnt(0)" ::: "memory"); __syncthreads();
        float bl0 = 0.f, bl1 = 0.f;
        for (int t = 0; t < 64; ++t) { float x0 = bs.x, x1 = bs.y;
#pragma unroll
            for (int r = 0; r < 16; ++r) { const float g = ga[t * 16 + r]; x0 += g * up0[r]; x1 += g * up1[r]; }
            bl0 += (fminf(x0, 0.f) - __logf(1.f + __expf(-fabsf(x0)))) * 0.0625f; bl1 += (fminf(x1, 0.f) - __logf(1.f + __expf(-fabsf(x1)))) * 0.0625f; }
        *(float2*)(DEC + (size_t)ci * 2048 + col) = make_float2(__expf(bl0), __expf(bl1));
        float bc0 = 0.f, bc1 = 0.f;
#pragma unroll 1
        for (int tb = 0; tb < 64; tb += 16) {
            if (tb + 16 < 64) PREP_LOAD(qn, kn, tb + 16);
            asm volatile("" ::: "memory");
#pragma unroll
          for (int i = 0; i < 16; ++i) { const int t = tb + i; float x0 = bs.x, x1 = bs.y; const size_t row = (size_t)ci * 64 + t;
            const unsigned qw = qc[i], kw = kc[i];
#pragma unroll
            for (int r = 0; r < 16; ++r) { const float g = ga[t * 16 + r]; x0 += g * up0[r]; x1 += g * up1[r]; }
            bc0 += (fminf(x0, 0.f) - __logf(1.f + __expf(-fabsf(x0)))) * 0.0625f; bc1 += (fminf(x1, 0.f) - __logf(1.f + __expf(-fabsf(x1)))) * 0.0625f;
            const float q0 = __uint_as_float(qw << 16), q1 = __uint_as_float(qw & 0xffff0000u), k0 = __uint_as_float(kw << 16), k1 = __uint_as_float(kw & 0xffff0000u);
            const float e0 = __expf(bc0), e1 = __expf(bc1);
            *(unsigned*)(Qd + row * 2048 + col) = pk2(q0 * 0.0625f * e0, q1 * 0.0625f * e1);
            *(unsigned*)(Ki + row * 2048 + col) = pk2(k0 * __expf(-bc0), k1 * __expf(-bc1)); }
            asm volatile("" ::: "memory");
#pragma unroll
            for (int i = 0; i < 16; ++i) { qc[i] = qn[i]; kc[i] = kn[i]; }
        }
#undef PREP_LOAD
    }
    __syncthreads();
}
__device__ __forceinline__ void resnorm1_phase(const Ctx& c, const float* __restrict__ x, const bf16_t* y, const float* __restrict__ g1, const float* __restrict__ g2, float* __restrict__ rstd1, bf16_t* __restrict__ h2, bf16_t* x1b) {
    const int lane = c.lane;
    for (int row = c.bid * NWAVES + c.wave; row < MTOK; row += c.G * NWAVES) {
        const uint2* yr = (const uint2*)(y + (size_t)row * D_MODEL) + lane; uint2* x1o = (uint2*)(x1b + (size_t)row * D_MODEL) + lane; const float4* xr = (const float4*)(x + (size_t)row * D_MODEL) + lane;
        uint2 yw[16]; float4 v[16]; float s = 0.f;
#pragma unroll
        for (int j = 0; j < 16; ++j) yw[j] = yr[64 * j];
#pragma unroll
        for (int j = 0; j < 16; ++j) v[j] = xr[64 * j];
        asm volatile("" ::: "memory");
#pragma unroll
        for (int j = 0; j < 16; ++j) { const float a = __uint_as_float(yw[j].x << 16), b = __uint_as_float(yw[j].x & 0xffff0000u), cc = __uint_as_float(yw[j].y << 16), d = __uint_as_float(yw[j].y & 0xffff0000u); s += a * a + b * b + cc * cc + d * d; }
        const float rstd = rsqrtf(wave_sum(s) * (1.f / D_MODEL) + EPS); float s2 = 0.f;
        if (lane == 0) rstd1[row] = rstd;
#pragma unroll
        for (int j = 0; j < 16; ++j) asm volatile("" : "+v"(yw[j].x), "+v"(yw[j].y));
#pragma unroll
        for (int j = 0; j < 16; ++j) { const float4 gg = ((const float4*)g1)[lane + 64 * j];
            v[j].x = v[j].x + __uint_as_float(yw[j].x << 16) * rstd * gg.x; v[j].y = v[j].y + __uint_as_float(yw[j].x & 0xffff0000u) * rstd * gg.y;
            v[j].z = v[j].z + __uint_as_float(yw[j].y << 16) * rstd * gg.z; v[j].w = v[j].w + __uint_as_float(yw[j].y & 0xffff0000u) * rstd * gg.w;
            s2 += v[j].x * v[j].x + v[j].y * v[j].y + v[j].z * v[j].z + v[j].w * v[j].w;
            { uint2 w1; w1.x = pk2(v[j].x, v[j].y); w1.y = pk2(v[j].z, v[j].w); x1o[64 * j] = w1; }
            if ((j & 3) == 3) asm volatile("" ::: "memory"); }
        const float rstd2 = rsqrtf(wave_sum(s2) * (1.f / D_MODEL) + EPS);
        uint2* o = (uint2*)(h2 + (size_t)row * D_MODEL) + lane;
#pragma unroll
        for (int j = 0; j < 16; ++j) { const float4 gg = ((const float4*)g2)[lane + 64 * j]; uint2 w; w.x = pk2(v[j].x * rstd2 * gg.x, v[j].y * rstd2 * gg.y); w.y = pk2(v[j].z * rstd2 * gg.z, v[j].w * rstd2 * gg.w); o[64 * j] = w; if ((j & 3) == 3) asm volatile("" ::: "memory"); }
    }
}
__device__ __forceinline__ void resnorm2_phase(const Ctx& c, const bf16_t* __restrict__ x1b, const bf16_t* __restrict__ y2, const float* __restrict__ g2, float* __restrict__ out) {
    const int lane = c.lane;
    for (int row = c.bid * NWAVES + c.wave; row < MTOK; row += c.G * NWAVES) {
        const uint2* yr = (const uint2*)(y2 + (size_t)row * D_MODEL) + lane; const uint2* xr = (const uint2*)(x1b + (size_t)row * D_MODEL) + lane; float4* xo = (float4*)(out + (size_t)row * D_MODEL) + lane;
        uint2 yw[16], xw[16]; float s = 0.f;
#pragma unroll
        for (int j = 0; j < 16; ++j) yw[j] = yr[64 * j];
#pragma unroll
        for (int j = 0; j < 16; ++j) xw[j] = xr[64 * j];
        asm volatile("" ::: "memory");
#pragma unroll
        for (int j = 0; j < 16; ++j) { const float a = __uint_as_float(yw[j].x << 16), b = __uint_as_float(yw[j].x & 0xffff0000u), cc = __uint_as_float(yw[j].y << 16), d = __uint_as_float(yw[j].y & 0xffff0000u); s += a * a + b * b + cc * cc + d * d; }
        const float rstd = rsqrtf(wave_sum(s) * (1.f / D_MODEL) + EPS);
#pragma unroll
        for (int j = 0; j < 16; ++j) asm volatile("" : "+v"(yw[j].x), "+v"(yw[j].y));
#pragma unroll
        for (int j = 0; j < 16; ++j) { const float4 gg = ((const float4*)g2)[lane + 64 * j]; const uint2 xq = xw[j], y2q = yw[j];
            float4 o;
            o.x = __uint_as_float(xq.x << 16) + __uint_as_float(y2q.x << 16) * rstd * gg.x; o.y = __uint_as_float(xq.x & 0xffff0000u) + __uint_as_float(y2q.x & 0xffff0000u) * rstd * gg.y;
            o.z = __uint_as_float(xq.y << 16) + __uint_as_float(y2q.y << 16) * rstd * gg.z; o.w = __uint_as_float(xq.y & 0xffff0000u) + __uint_as_float(y2q.y & 0xffff0000u) * rstd * gg.w;
            xo[64 * j] = o; if ((j & 3) == 3) asm volatile("" ::: "memory"); }
    }
}

__device__ __forceinline__ void gla_norm_apply_phase(const Ctx& c, bf16_t* __restrict__ A, const float* __restrict__ SSQ) {
    const int lane = c.lane, stride = c.G * NWAVES;
    for (int row0 = c.bid * NWAVES + c.wave; row0 < MTOK; row0 += 4 * stride) {
        uint4 v[4][8]; float sq[4];
#pragma unroll
        for (int q = 0; q < 4; ++q) { const int row = row0 + q * stride; sq[q] = 0.f;
            if (row < MTOK) { const uint4* ar = (const uint4*)(A + (size_t)row * 4096) + lane;
#pragma unroll
                for (int j = 0; j < 8; ++j) v[q][j] = ar[64 * j];
                sq[q] = SSQ[(size_t)row * 32 + (lane & 31)]; } }
        asm volatile("" ::: "memory");
#pragma unroll
        for (int q = 0; q < 4; ++q) { const int row = row0 + q * stride;
            if (row < MTOK) { uint4* ar = (uint4*)(A + (size_t)row * 4096) + lane;
                float t = sq[q]; t += __shfl_xor(t, 1); t += __shfl_xor(t, 2); const float rr = rsqrtf(t * (1.f / 512.f) + EPS);
#pragma unroll
                for (int j = 0; j < 8; ++j) { const float rj = __int_as_float(__builtin_amdgcn_readlane(__float_as_int(rr), 4 * j)); uint4 o; const unsigned w4[4] = {v[q][j].x, v[q][j].y, v[q][j].z, v[q][j].w}; unsigned o4[4];
#pragma unroll
                    for (int e = 0; e < 4; ++e) o4[e] = pk2(__uint_as_float(w4[e] << 16) * rj, __uint_as_float(w4[e] & 0xffff0000u) * rj);
                    o.x = o4[0]; o.y = o4[1]; o.z = o4[2]; o.w = o4[3]; ar[64 * j] = o; } } }
    }
}

constexpr size_t MiB = 1u << 20;
constexpr size_t WS_CTL = 0, CTL_ZERO_BYTES = 512 * 1024;
constexpr size_t WS_KS = 128 * 1024, WS_CS = 512 * 1024;
constexpr int CW_BAR = 0, CW_QHEAD = 8192, CW_QCONV = 8192 + 64;
constexpr size_t WS_WM = 1 * MiB;
constexpr size_t WS_WG = WS_WM + (size_t)4096 * 2048 * 2;
constexpr size_t WS_WO = WS_WG + (size_t)4096 * 4096 * 2;
constexpr size_t WS_WGU = WS_WO + (size_t)4096 * 4096 * 2;
constexpr size_t WS_WD = WS_WGU + (size_t)22016 * 4096 * 2;
constexpr size_t WS_RA = WS_WD + (size_t)4096 * 11008 * 2;
constexpr size_t RA_BYTES = (size_t)IN_COLS * 4096 * 2;
constexpr size_t WS_RU = WS_RA + RA_BYTES;
constexpr size_t RU_BYTES = (size_t)MTOK * IN_PAD * 2;
constexpr size_t WS_RH = WS_RU + RU_BYTES;
constexpr size_t WS_RO = WS_RH + (size_t)MTOK * 4096 * 2;
constexpr size_t WS_AM = WS_RO + (size_t)MTOK * 4096 * 4;
constexpr size_t WS_AG = WS_AM + (size_t)MTOK * 2048 * 2;
constexpr size_t WS_MG = WS_AG + (size_t)MTOK * 4096 * 2;
constexpr size_t WS_KM = WS_MG + (size_t)MTOK * 4096 * 2;
constexpr size_t WS_HID = WS_KM + 1 * MiB;
constexpr size_t WS_ST = WS_HID;
constexpr size_t WS_END = WS_ST + (size_t)BATCH * 8 * 32 * 512 * 256 * 2;

template <class Epi> __device__ __forceinline__ void gemm_run(const Ctx& c, const bf16_t* A, const bf16_t* Bt, int M, int N, int K, const Epi& E) {
    pg8::Gemm g{A, Bt, M, N, K}; pg8::StaticOrder S; S.init(M, N, c.G, c.bid);
    pg8::gemm_phase<Epi, pg8::StaticOrder, true, true>(c.lds, g, S, E);
}
template <int EPI> __device__ __forceinline__ void gemm_call(const Ctx& c, const bf16_t* A, const bf16_t* Bt, void* C, int M, int N, int K, int ldc) {
    if constexpr (EPI == 0) { pg8::EpiBf16Plain E{(bf16_t*)C, ldc}; gemm_run(c, A, Bt, M, N, K, E); }
    else { pg8::EpiF32 E{(float*)C, ldc, nullptr}; gemm_run(c, A, Bt, M, N, K, E); }
}

__global__ void __launch_bounds__(NTHR, 2) mk_fwd(Params p) {
    extern __shared__ __attribute__((aligned(16))) unsigned char lds_raw[];
    Ctx c; c.lds = (LAS unsigned char*)lds_raw; c.tid = threadIdx.x; c.lane = c.tid & 63; c.wave = __builtin_amdgcn_readfirstlane(c.tid >> 6); c.G = gridDim.x; c.bid = blockIdx.x;
    volatile LAS unsigned* MISC = (volatile LAS unsigned*)(c.lds + MISC_OFF);
    if (c.tid < 64) MISC[c.tid] = 0u;
    __syncthreads();
    XcdBarrier bar = xcd_barrier_post(p.ctl + CW_BAR, MISC + 8);
    const int lo = p.ph_lo, hi = p.ph_hi;
#define IN(k) (lo <= (k) && (k) < hi)
#define FRESH() do { int t_ = threadIdx.x; asm volatile("" : "+v"(t_)); c.tid = t_; c.lane = t_ & 63; c.wave = __builtin_amdgcn_readfirstlane(t_ >> 6); { size_t wso_ = 0; asm volatile("" : "+s"(wso_)); ws = p.ws + wso_; } } while (0)
#define SEAM(k) do { if (IN(k)) xcd_barrier(bar); } while (0)
    unsigned char* ws = p.ws;
#define xin ((const float*)p.in[0])
#define g_premix ((const float*)p.in[1])
#define w_in ((const float*)p.in[2])
#define gate_up ((const float*)p.in[3])
#define gate_bias ((const float*)p.in[4])
#define g_glanorm ((const float*)p.in[5])
#define w_bm ((const float*)p.in[6])
#define w_bg ((const float*)p.in[7])
#define w_out ((const float*)p.in[8])
#define g_postmix ((const float*)p.in[9])
#define g_preffn ((const float*)p.in[10])
#define w_fg ((const float*)p.in[11])
#define w_fu ((const float*)p.in[12])
#define w_fd ((const float*)p.in[13])
#define g_postffn ((const float*)p.in[14])
#define outp (p.out)
#define WmT ((bf16_t*)(ws + WS_WM))
#define WgT ((bf16_t*)(ws + WS_WG))
#define WoT ((bf16_t*)(ws + WS_WO))
#define WguT ((bf16_t*)(ws + WS_WGU))
#define WdT ((bf16_t*)(ws + WS_WD))
#define WinT ((bf16_t*)(ws + WS_RA))
#define MQ ((bf16_t*)(ws + WS_RA))
#define MK (MQ + (size_t)MTOK * 2048)
#define MV (MQ + (size_t)MTOK * 2048 * 2)
#define BC ((float*)(MQ + (size_t)MTOK * 2048 * 3))
#define ymoba ((bf16_t*)(ws + WS_RA + 2 * MiB))
#define ybuf ((bf16_t*)(ws + WS_RA + 2 * MiB))
#define ubuf ((bf16_t*)(ws + WS_RU))
#define gu ((bf16_t*)(ws + WS_RU))
#define hbuf ((bf16_t*)(ws + WS_RH))
#define h2 ((bf16_t*)(ws + WS_RH))
#define Qd ((bf16_t*)(ws + WS_RO))
#define Ki (Qd + (size_t)MTOK * 2048)
#define Ke (Qd + (size_t)MTOK * 2048 * 2)
#define ygla ((float*)(ws + WS_RO))
#define y2 ((bf16_t*)(ws + WS_RO))
#define ST ((bf16_t*)(ws + WS_ST))
#define Am ((bf16_t*)(ws + WS_AM))
#define Ag ((bf16_t*)(ws + WS_AG))
#define mg ((bf16_t*)(ws + WS_MG))
#define KS ((float*)(ws + WS_KS))
#define SSQb ((float*)(ws + WS_RO + 100 * MiB))
#define RS1 ((float*)(ws + WS_KM + 524288))
#define CSt ((float*)(ws + WS_CS))
#define SNt ((float*)(ws + WS_KM))
#define DEC ((float*)(ws + WS_RA))
#define hid ((bf16_t*)(ws + WS_HID))

    if (IN(0)) { FRESH(); } if (IN(0)) {
        conv_items<2>(c, w_in, 4096, IN_COLS, WinT, 0);
        conv_items<0, 4>(c, w_fd, D_FF, 4096, WdT, 0, 0, WD_SPLIT);
        rmsnorm_rows_bf16(c, xin, g_premix, hbuf);
        rope_table_phase(c, CSt, SNt);
    }
    SEAM(0);
    if (IN(1)) { FRESH(); } if (IN(1)) { pg8::EpiIn E{ubuf, IN_PAD, CSt, SNt, KS}; gemm_run(c, hbuf, WinT, MTOK, IN_PAD, 4096, E); }
    SEAM(1);
    if (IN(2)) { FRESH(); } if (IN(2)) { gla_prep_phase(c, ubuf, hbuf, WinT + (size_t)GA_ROW * 4096, gate_up, gate_bias, DEC, Qd, Ki);
        for (int i = c.bid * NTHR + c.tid; i < MTOK * 32; i += c.G * NTHR) __hip_atomic_store(SSQb + i, -1.f, __ATOMIC_RELAXED, __HIP_MEMORY_SCOPE_AGENT); }
    SEAM(2);
    if (IN(4)) { FRESH(); } if (IN(4)) {
        const int half = c.G >> 1;
        if (c.bid < half) {
            for (int it = c.bid; it < BATCH * 8 * 4; it += half) { const int hh = it & 7, dvs = (it >> 3) & 3, b = it >> 5; const size_t t0 = (size_t)(b * SEQ);
                gf::fused_unit(Qd + t0 * 2048 + hh * 256, Ki + t0 * 2048 + hh * 256, ubuf + t0 * IN_PAD + OFF_GV + hh * 512 + dvs * 128, IN_PAD,
                               ubuf + t0 * IN_PAD + OFF_GR + hh * 512 + dvs * 128, IN_PAD, DEC + (size_t)(b * 32) * 2048 + hh * 256, g_glanorm + dvs * 128,
                               Ag + t0 * 4096 + hh * 512 + dvs * 128, 4096, SSQb + (size_t)((b * 8 + hh) * 32) * 256, dvs, c.lds); }
        }
        if (c.bid >= half) { FRESH(); Ctx c2 = c; c2.bid = c.bid - half; c2.G = c.G - half;
            conv_items<0>(c2, w_bg, 4096, 4096, WgT, 0); conv_items<0>(c2, w_out, 4096, 4096, WoT, 0); }
        else if (half > 0) { FRESH(); Ctx c2 = c; c2.G = half; conv_items<0>(c2, w_bm, 2048, 4096, WmT, 0); }
        for (;;) { __syncthreads(); if (c.tid == 0) *(volatile LAS unsigned*)(c.lds + MISC_OFF + 64) = atomicAdd(p.ctl + CW_QCONV, 1u); __syncthreads();
            const int q = (int)__builtin_amdgcn_readfirstlane(*(volatile LAS unsigned*)(c.lds + MISC_OFF + 64)); if (q >= 2 * 344) break;
            FRESH(); Ctx c1 = c; c1.bid = 0; c1.G = 1; const int up = q >= 344, u0 = 4 * (up ? q - 344 : q);
            if (up) conv_items<1>(c1, w_fu, 4096, D_FF, WguT, 128, u0, u0 + 4); else conv_items<1>(c1, w_fg, 4096, D_FF, WguT, 0, u0, u0 + 4); }
        for (;;) { __syncthreads(); if (c.tid == 0) *(volatile LAS unsigned*)(c.lds + MISC_OFF + 64) = atomicAdd(p.ctl + CW_QHEAD, 1u); __syncthreads();
            const int it = (int)__builtin_amdgcn_readfirstlane(*(volatile LAS unsigned*)(c.lds + MISC_OFF + 64)); if (it >= BATCH * 16 * 8) break;
            const int qb = 7 - (it >> 6), hd = it & 15, b = (it >> 4) & 3;
            const size_t q0 = (size_t)(b * SEQ + qb * 256) * IN_PAD + hd * 128, k0 = (size_t)(b * SEQ) * IN_PAD + hd * 128;
            mb::moba_unit(ubuf + OFF_MQ + q0, ubuf + OFF_MK + k0, ubuf + OFF_MV + k0, Am + (size_t)(b * SEQ + qb * 256) * 2048 + hd * 128, KS + (size_t)((b * 16 + hd) * 8) * 128, qb, (char*)lds_raw); }
    }
    SEAM(4);
    if (IN(6)) { FRESH(); } if (IN(6)) {
        { pg8::EpiGateF32 E{ymoba, 4096, ubuf + OFF_SM, IN_PAD}; gemm_run(c, Am, WmT, MTOK, 4096, 2048, E); }
        { pg8::EpiMergeBf16 E{mg, 4096, ymoba, ubuf + OFF_SG, IN_PAD}; gemm_run(c, Ag, WgT, MTOK, 4096, 4096, E); } }
    SEAM(6);
    if (IN(8)) { FRESH(); } if (IN(8)) gemm_call<0>(c, mg, WoT, ybuf, MTOK, 4096, 4096, 4096);
    SEAM(8);
    if (IN(9)) { FRESH(); } if (IN(9)) resnorm1_phase(c, xin, ybuf, g_postmix, g_preffn, RS1, h2, ybuf);
    SEAM(9);
    if (IN(10)) { FRESH(); } if (IN(10)) { pg8::EpiSwiGLU E{hid, D_FF}; gemm_run(c, h2, WguT, MTOK, 2 * D_FF, 4096, E);
        const int nun = (MTOK / 256) * (2 * D_FF / 256), full = nun / c.G, rem = nun - full * c.G;
        if (rem > 0 && c.bid >= rem) { FRESH(); Ctx c2 = c; c2.bid = c.bid - rem; c2.G = c.G - rem; __syncthreads(); conv_items<0, 4>(c2, w_fd, D_FF, 4096, WdT, 0, WD_SPLIT); }
        else if (rem == 0) { conv_items<0, 4>(c, w_fd, D_FF, 4096, WdT, 0, WD_SPLIT); } }
    SEAM(10);
    if (IN(12)) { FRESH(); } if (IN(12)) gemm_call<0>(c, hid, WdT, y2, MTOK, 4096, D_FF, 4096);
    SEAM(12);
    if (IN(13)) { FRESH(); } if (IN(13)) resnorm2_phase(c, ybuf, y2, g_postffn, outp);
#undef IN
#undef SEAM
}
#undef xin
#undef g_premix
#undef w_in
#undef gate_up
#undef gate_bias
#undef g_glanorm
#undef w_bm
#undef w_bg
#undef w_out
#undef g_postmix
#undef g_preffn
#undef w_fg
#undef w_fu
#undef w_fd
#undef g_postffn
#undef outp
#undef WmT
#undef WgT
#undef WoT
#undef WguT
#undef WdT
#undef WinT
#undef MQ
#undef MK
#undef MV
#undef BC
#undef ymoba
#undef ybuf
#undef ubuf
#undef gu
#undef hbuf
#undef h2
#undef Qd
#undef Ki
#undef Ke
#undef ygla
#undef y2
#undef ST
#undef Am
#undef Ag
#undef mg
#undef KS
#undef SSQb
#undef RS1
#undef CSt
#undef SNt
#undef DEC
#undef hid


extern "C" void kernel_launch(void* const* d_in, const int* in_sizes, int n_in, void* d_out, int out_size, void* d_ws, size_t ws_size, hipStream_t stream) {
    static int grid = 0;
    if (grid == 0) {
        if (n_in != 15 || in_sizes[0] != MTOK * D_MODEL || out_size != MTOK * D_MODEL || ws_size < WS_END) {
            fprintf(stderr, "kernel_launch: shape/ws mismatch n_in %d in0 %d out %d ws %zu need %zu\n", n_in, n_in > 0 ? in_sizes[0] : -1, out_size, ws_size, (size_t)WS_END); grid = -1; return; }
        if (hipFuncSetAttribute((const void*)mk_fwd, hipFuncAttributeMaxDynamicSharedMemorySize, LDS_BYTES) != hipSuccess) { fprintf(stderr, "kernel_launch: hipFuncSetAttribute failed\n"); grid = -1; return; }
        int dev = 0, cus = 0, per_cu = 0;
        if (hipGetDevice(&dev) != hipSuccess || hipDeviceGetAttribute(&cus, hipDeviceAttributeMultiprocessorCount, dev) != hipSuccess) { grid = -1; return; }
        if (hipOccupancyMaxActiveBlocksPerMultiprocessor(&per_cu, (const void*)mk_fwd, NTHR, LDS_BYTES) != hipSuccess || per_cu < 1) { fprintf(stderr, "kernel_launch: occupancy query says %d blocks/CU\n", per_cu); grid = -1; (void)hipGetLastError(); return; }
        grid = cus;
    }
    if (grid < 0) return;
    (void)hipMemsetAsync((char*)d_ws + WS_CTL, 0, CTL_ZERO_BYTES, stream);
    Params p; memset(&p, 0, sizeof(p));
    for (int i = 0; i < 15; ++i) p.in[i] = (const float*)d_in[i];
    p.out = (float*)d_out; p.ws = (unsigned char*)d_ws; p.ctl = (unsigned*)((char*)d_ws + WS_CTL); p.ph_lo = 0; p.ph_hi = 14;
    hipLaunchKernelGGL(mk_fwd, dim3(grid), dim3(NTHR), LDS_BYTES, stream, p);
    const hipError_t le = hipPeekAtLastError();
    if (le != hipSuccess) fprintf(stderr, "kernel_launch: launch failed: %s\n", hipGetErrorName(le));
}
```
